# Optimizing an MI355X kernel written in HIP

```python
import jax, jax.numpy as jnp
from jax import lax
import numpy as np

D_MODEL = 2048
BATCH = 4
SEQ = 2048
DEPTH = 1

CHUNK = 128
GMLP_GROUPS = 8
GMLP_GROUP_DIM = 128
GMLP_WIDTH = GMLP_GROUPS * GMLP_GROUP_DIM
ATTN_HEADS = 8
HEAD_DIM = 128
ATTN_WIDTH = ATTN_HEADS * HEAD_DIM
Q_BLOCK = 128
D_FF = 5632
CONV_WIDTH = 3
PLE_DIM = 256
N_BRANCH = 2
EPS = 1e-6
IN_COLS = 2 * GMLP_WIDTH + 3 * ATTN_WIDTH + ATTN_HEADS + N_BRANCH * D_MODEL

kernel_name = "hybrid_gmlp_fox_convffn_ple_block"


def _rms_norm(x, g):
    xf = x.astype(jnp.float32)
    y = xf * lax.rsqrt(jnp.mean(xf * xf, axis=-1, keepdims=True) + EPS)
    return (y * g.astype(jnp.float32)).astype(x.dtype)


def _layer_norm(x, g, b):
    xf = x.astype(jnp.float32)
    mu = jnp.mean(xf, axis=-1, keepdims=True)
    xc = xf - mu
    y = xc * lax.rsqrt(jnp.mean(xc * xc, axis=-1, keepdims=True) + EPS)
    return (y * g.astype(jnp.float32) + b.astype(jnp.float32)).astype(x.dtype)


def _spatial_gating(u, v, ln_g, ln_b, w_s, b_s):
    B, S, _ = v.shape
    n_chunks = S // CHUNK
    v = _layer_norm(v, ln_g, ln_b)
    vc = v.reshape(B, n_chunks, CHUNK, GMLP_GROUPS, GMLP_GROUP_DIM)
    causal = jnp.tril(jnp.ones((CHUNK, CHUNK), dtype=bool))
    w = jnp.where(causal[None], w_s, jnp.zeros((), w_s.dtype))
    mixed = jnp.einsum('gts,bcsgd->bctgd', w, vc) + b_s.T[None, None, :, :, None]
    return u * mixed.reshape(B, S, GMLP_WIDTH)


def _forgetting_attention(q, k, v, f_logit, q_norm_g, k_norm_g):
    B, S = q.shape[0], q.shape[1]
    q = _rms_norm(q, q_norm_g).transpose(0, 2, 1, 3)
    k = _rms_norm(k, k_norm_g).transpose(0, 2, 1, 3)
    v = v.transpose(0, 2, 1, 3)
    log_f = jax.nn.log_sigmoid(f_logit.astype(jnp.float32))
    cum = jnp.cumsum(log_f, axis=1).transpose(0, 2, 1)
    scale = HEAD_DIM ** -0.5
    outs = []
    for blk in range(S // Q_BLOCK):
        q0 = blk * Q_BLOCK
        q1 = q0 + Q_BLOCK
        qb = q[:, :, q0:q1]
        kb = k[:, :, :q1]
        vb = v[:, :, :q1]
        s = jnp.einsum('bhqd,bhkd->bhqk', qb, kb).astype(jnp.float32) * scale
        s = s + cum[:, :, q0:q1, None] - cum[:, :, None, :q1]
        causal = jnp.arange(q0, q1)[:, None] >= jnp.arange(q1)[None, :]
        s = jnp.where(causal, s, -jnp.inf)
        pr = jax.nn.softmax(s, axis=-1).astype(v.dtype)
        outs.append(jnp.einsum('bhqk,bhkd->bhqd', pr, vb))
    o = jnp.concatenate(outs, axis=2)
    return o.transpose(0, 2, 1, 3).reshape(B, S, ATTN_WIDTH)


def _conv_ffn(h, w_up, conv_w, conv_b, w_down):
    S = h.shape[1]
    up = h @ w_up
    a, b = jnp.split(up, 2, axis=-1)
    ap = jnp.pad(a, ((0, 0), (CONV_WIDTH - 1, 0), (0, 0)))
    conv = conv_b
    for j in range(CONV_WIDTH):
        conv = conv + ap[:, j:j + S] * conv_w[j]
    return (jax.nn.gelu(conv, approximate=True) * b) @ w_down


def setup_inputs(seed: int = 0) -> dict:
    key = jax.random.key(seed)
    ks = jax.random.split(key, 24)
    f32 = jnp.float32
    n = lambda k, shape, s: jax.random.normal(k, shape, f32) * s
    gain = lambda k, shape: 1.0 + 0.05 * jax.random.normal(k, shape, f32)
    return {
        "x": jax.random.normal(ks[0], (BATCH, SEQ, D_MODEL), f32),
        "p": jax.random.normal(ks[1], (DEPTH, BATCH, SEQ, PLE_DIM), f32),
        "norm_mix_g": gain(ks[2], (DEPTH, D_MODEL)),
        "w_in": n(ks[3], (DEPTH, D_MODEL, IN_COLS), D_MODEL ** -0.5),
        "gmlp_ln_g": gain(ks[4], (DEPTH, GMLP_WIDTH)),
        "gmlp_ln_b": n(ks[5], (DEPTH, GMLP_WIDTH), 0.02),
        "gmlp_w_s": n(ks[6], (DEPTH, GMLP_GROUPS, CHUNK, CHUNK), 0.5 * CHUNK ** -0.5),
        "gmlp_b_s": 1.0 + n(ks[7], (DEPTH, GMLP_GROUPS, CHUNK), 0.1),
        "fox_b_f": jax.random.uniform(ks[8], (DEPTH, ATTN_HEADS), f32, 1.0, 4.0),
        "q_norm_g": gain(ks[9], (DEPTH, HEAD_DIM)),
        "k_norm_g": gain(ks[10], (DEPTH, HEAD_DIM)),
        "w_branch_a": n(ks[11], (DEPTH, GMLP_WIDTH, D_MODEL), GMLP_WIDTH ** -0.5),
        "w_branch_b": n(ks[12], (DEPTH, ATTN_WIDTH, D_MODEL), ATTN_WIDTH ** -0.5),
        "w_out": n(ks[13], (DEPTH, D_MODEL, D_MODEL), D_MODEL ** -0.5),
        "norm_ffn_g": gain(ks[14], (DEPTH, D_MODEL)),
        "w_up": n(ks[15], (DEPTH, D_MODEL, 2 * D_FF), D_MODEL ** -0.5),
        "conv_w": n(ks[16], (DEPTH, CONV_WIDTH, D_FF), CONV_WIDTH ** -0.5),
        "conv_b": n(ks[17], (DEPTH, D_FF), 0.02),
        "w_down": n(ks[18], (DEPTH, D_FF, D_MODEL), D_FF ** -0.5),
        "ple_proj": n(ks[19], (DEPTH, PLE_DIM, D_MODEL), PLE_DIM ** -0.5),
        "ple_norm_g": gain(ks[20], (DEPTH, D_MODEL)),
        "ple_gate_norm_g": gain(ks[21], (DEPTH, D_MODEL)),
        "w_ple_gate": n(ks[22], (DEPTH, D_MODEL, D_MODEL), D_MODEL ** -0.5),
    }


def reference(x, p, norm_mix_g, w_in, gmlp_ln_g, gmlp_ln_b, gmlp_w_s, gmlp_b_s, fox_b_f,
              q_norm_g, k_norm_g, w_branch_a, w_branch_b, w_out, norm_ffn_g, w_up,
              conv_w, conv_b, w_down, ple_proj, ple_norm_g, ple_gate_norm_g, w_ple_gate):
    B, S, _ = x.shape
    sizes = [GMLP_WIDTH, GMLP_WIDTH, ATTN_WIDTH, ATTN_WIDTH, ATTN_WIDTH, ATTN_HEADS,
             D_MODEL, D_MODEL]
    points = []
    acc = 0
    for sz in sizes[:-1]:
        acc += sz
        points.append(acc)
    for i in range(DEPTH):
        h = _rms_norm(x, norm_mix_g[i])
        z = h @ w_in[i]
        u, v, q, k, vv, f, g_a, g_b = jnp.split(z, points, axis=-1)
        o_a = _spatial_gating(jax.nn.gelu(u, approximate=False), jax.nn.gelu(v, approximate=False),
                              gmlp_ln_g[i], gmlp_ln_b[i], gmlp_w_s[i], gmlp_b_s[i])
        o_b = _forgetting_attention(q.reshape(B, S, ATTN_HEADS, HEAD_DIM),
                                    k.reshape(B, S, ATTN_HEADS, HEAD_DIM),
                                    vv.reshape(B, S, ATTN_HEADS, HEAD_DIM),
                                    f + fox_b_f[i], q_norm_g[i], k_norm_g[i])
        y = jax.nn.sigmoid(g_a) * (o_a @ w_branch_a[i]) + jax.nn.sigmoid(g_b) * (o_b @ w_branch_b[i])
        x = x + y @ w_out[i]
        x = x + _conv_ffn(_rms_norm(x, norm_ffn_g[i]), w_up[i], conv_w[i], conv_b[i], w_down[i])
        e = _rms_norm(p[i] @ ple_proj[i], ple_norm_g[i])
        gate = jax.nn.sigmoid(_rms_norm(x, ple_gate_norm_g[i]) @ w_ple_gate[i])
        x = x + gate * e
    return x
```

```cpp
#include <hip/hip_runtime.h>
#include <cstdio>
#include <cstdint>

#ifndef MK_N_LAUNCHES
#define MK_N_LAUNCHES 1
#endif

namespace pg8 {
#define PG8_LAS __attribute__((address_space(3)))
typedef unsigned short bf16_t;
typedef short bf16x8 __attribute__((ext_vector_type(8)));
typedef float f32x4 __attribute__((ext_vector_type(4)));
typedef float f32x2 __attribute__((ext_vector_type(2)));
typedef unsigned u32x4 __attribute__((ext_vector_type(4)));
constexpr int BM = 256, BK = 64, HALF = 128, HTB = HALF * BK * 2, STAGE_BYTES = 8 * HTB, NXCD = 8, WGM = 8;

__host__ __device__ __forceinline__ int lds_byte(int r, int c) { const int st = (r >> 4) * 2 + (c >> 5), rr = r & 15, cc = c & 31, ob = rr * 64 + cc * 2; return st * 1024 + (ob ^ (((ob >> 9) & 1) << 5)); }
__host__ __device__ __forceinline__ void stage_rc(int b, int& R, int& C) { const int st = b / 1024, sb = b % 1024, swz = sb ^ (((sb >> 9) & 1) << 5); R = (st >> 1) * 16 + swz / 64; C = (st & 1) * 32 + (swz % 64) / 2; }
__host__ __device__ __forceinline__ int perm32(int rho) { const int n = rho >> 4, i = rho & 15; return 8 * (i >> 2) + 4 * n + (i & 3); }

struct Unit { int pm, pn; };
struct Gemm { const bf16_t* A; const bf16_t* Bt; int M, N, K; };

struct StaticOrder {
    int nM, nN, nwg, G, c;
    __host__ __device__ void init(int M, int N, int G_, int c_) { nM = M / BM; nN = N / BM; nwg = nM * nN; G = G_; c = c_; }
    __host__ __device__ bool next(int i, Unit& u) const {
        const long L = (long)i * G + c; if (L >= nwg) return false;
        int wgid = (int)L; { const int q = nwg / NXCD, r = nwg % NXCD, xcd = wgid % NXCD, off = wgid / NXCD; wgid = (xcd < r ? xcd * (q + 1) : r * (q + 1) + (xcd - r) * q) + off; }
        const int nig = WGM * nN, gid = wgid / nig, fm = gid * WGM, gsz = (nM - fm) < WGM ? (nM - fm) : WGM;
        u.pm = fm + ((wgid % nig) % gsz); u.pn = (wgid % nig) / gsz; return true;
    }
    __device__ __forceinline__ void a_ready(const Unit&) const {}
    __device__ __forceinline__ void done(const Unit&) const {}
};

__device__ __forceinline__ unsigned cvt_pk_bf16(float lo, float hi) { unsigned r; asm volatile("v_cvt_pk_bf16_f32 %0, %1, %2" : "=v"(r) : "v"(lo), "v"(hi)); return r; }
__device__ __forceinline__ float bf_lo(unsigned w) { return __uint_as_float(w << 16); }
__device__ __forceinline__ float bf_hi(unsigned w) { return __uint_as_float(w & 0xffff0000u); }
__device__ __forceinline__ f32x2 gelu_pk(f32x2 v) {
    const f32x2 av = __builtin_elementwise_abs(v), d = av * 0.2316418882f + 1.0f;
    f32x2 t; t.x = __builtin_amdgcn_rcpf(d.x); t.y = __builtin_amdgcn_rcpf(d.y);
    f32x2 q = t * 0.5307027145f + (-0.7265760135f); q = q * t + 0.7107068705f; q = q * t + (-0.142248368f); q = q * t + 0.127414796f; q = q * t;
    const f32x2 s = (v * v) * (-0.72134752044f);
    f32x2 e; e.x = __builtin_amdgcn_exp2f(s.x); e.y = __builtin_amdgcn_exp2f(s.y);
    const f32x2 m = v * (q * e), r = v - m;
    f32x2 o; o.x = v.x < 0.f ? m.x : r.x; o.y = v.y < 0.f ? m.y : r.y; return o;
}
__device__ __forceinline__ float sigmoid_f(float x) { return __builtin_amdgcn_rcpf(1.0f + __builtin_amdgcn_exp2f(-1.4426950408889634f * x)); }
__device__ __forceinline__ f32x4 gelu4(f32x4 v) { f32x2 a = gelu_pk((f32x2){v[0], v[1]}), b = gelu_pk((f32x2){v[2], v[3]}); return (f32x4){a.x, a.y, b.x, b.y}; }
__device__ __forceinline__ f32x4 sigm4(f32x4 v) { return (f32x4){sigmoid_f(v[0]), sigmoid_f(v[1]), sigmoid_f(v[2]), sigmoid_f(v[3])}; }
__device__ __forceinline__ u32x4 pack8(f32x4 a, f32x4 b) { u32x4 w; w.x = cvt_pk_bf16(a[0], a[1]); w.y = cvt_pk_bf16(a[2], a[3]); w.z = cvt_pk_bf16(b[0], b[1]); w.w = cvt_pk_bf16(b[2], b[3]); return w; }

typedef f32x4 Acc[2][2][4][2];
#define EPI_LOOP_ROWS for (int ai = 0; ai < 2; ++ai) _Pragma("unroll") for (int m = 0; m < 4; ++m)

constexpr int ZLD = 9216;
struct EpiZ {
    static constexpr bool PERM = true, AFTER_DRAIN = false, MIDK = false;
    bf16_t* Z;
    __device__ __forceinline__ void mid(Acc&, const Unit&, int, int, int, int) const {}
    __device__ __forceinline__ void operator()(const Acc& acc, const Unit& u, int wr, int wc, int fr, int fq) const {
        const int mode = u.pn < 8 ? 1 : (u.pn < 20 ? 0 : 2);
        const int row0 = u.pm * BM + wr * 64 + fr, col0 = u.pn * BM + wc * 32 + 8 * fq;
#pragma unroll
        EPI_LOOP_ROWS { bf16_t* rowp = Z + (size_t)(row0 + ai * HALF + m * 16) * ZLD + col0;
#pragma unroll
            for (int bj = 0; bj < 2; ++bj) { f32x4 v0 = acc[ai][bj][m][0], v1 = acc[ai][bj][m][1];
                if (mode == 1) { v0 = gelu4(v0); v1 = gelu4(v1); } else if (mode == 2) { v0 = sigm4(v0); v1 = sigm4(v1); }
                *(u32x4*)(rowp + bj * HALF) = pack8(v0, v1); } }
    }
};
struct EpiY {
    static constexpr bool PERM = true, AFTER_DRAIN = false, MIDK = true;
    const bf16_t* Z; bf16_t* Y;
    __device__ __forceinline__ void mid(Acc& acc, const Unit& u, int wr, int wc, int fr, int fq) const {
        int opq; asm volatile("v_mov_b32 %0, 0" : "=v"(opq));
        const int row0 = u.pm * BM + wr * 64 + fr + opq, col0 = u.pn * BM + wc * 32 + 8 * fq;
#pragma unroll
        EPI_LOOP_ROWS { const bf16_t* rowp = Z + (size_t)(row0 + ai * HALF + m * 16) * ZLD + 5120 + col0;
#pragma unroll
            for (int bj = 0; bj < 2; ++bj) { const u32x4 a = *(const u32x4*)(rowp + bj * HALF), b = *(const u32x4*)(rowp + 2048 + bj * HALF);
                f32x4 r0, r1;
                r0[0] = bf_lo(a.x) * __builtin_amdgcn_rcpf(bf_lo(b.x)); r0[1] = bf_hi(a.x) * __builtin_amdgcn_rcpf(bf_hi(b.x));
                r0[2] = bf_lo(a.y) * __builtin_amdgcn_rcpf(bf_lo(b.y)); r0[3] = bf_hi(a.y) * __builtin_amdgcn_rcpf(bf_hi(b.y));
                r1[0] = bf_lo(a.z) * __builtin_amdgcn_rcpf(bf_lo(b.z)); r1[1] = bf_hi(a.z) * __builtin_amdgcn_rcpf(bf_hi(b.z));
                r1[2] = bf_lo(a.w) * __builtin_amdgcn_rcpf(bf_lo(b.w)); r1[3] = bf_hi(a.w) * __builtin_amdgcn_rcpf(bf_hi(b.w));
                acc[ai][bj][m][0] *= r0; acc[ai][bj][m][1] *= r1; }
            if (m & 1) asm volatile("" ::: "memory"); }
    }
    __device__ __forceinline__ void operator()(const Acc& acc, const Unit& u, int wr, int wc, int fr, int fq) const {
        int opq; asm volatile("v_mov_b32 %0, 0" : "=v"(opq));
        const int row0 = u.pm * BM + wr * 64 + fr + opq, col0 = u.pn * BM + wc * 32 + 8 * fq;
#pragma unroll
        EPI_LOOP_ROWS { const int row = row0 + ai * HALF + m * 16; const bf16_t* rowp = Z + (size_t)row * ZLD + 7168 + col0;
#pragma unroll
            for (int bj = 0; bj < 2; ++bj) { const u32x4 b = *(const u32x4*)(rowp + bj * HALF);
                const f32x4 s0 = (f32x4){bf_lo(b.x), bf_hi(b.x), bf_lo(b.y), bf_hi(b.y)}, s1 = (f32x4){bf_lo(b.z), bf_hi(b.z), bf_lo(b.w), bf_hi(b.w)};
                *(u32x4*)(Y + (size_t)row * 2048 + col0 + bj * HALF) = pack8(acc[ai][bj][m][0] * s0, acc[ai][bj][m][1] * s1); }
            if (m & 1) asm volatile("" ::: "memory"); }
    }
};
struct EpiRes {
    static constexpr bool PERM = true, AFTER_DRAIN = false, MIDK = false;
    const float* base; float* xo; bf16_t* an; const float* g; float* ssq;
    __device__ __forceinline__ void mid(Acc&, const Unit&, int, int, int, int) const {}
    __device__ __forceinline__ void operator()(const Acc& acc, const Unit& u, int wr, int wc, int fr, int fq) const {
        const int row0 = u.pm * BM + wr * 64 + fr, col0 = u.pn * BM + wc * 32 + 8 * fq;
        f32x4 gv[2][2];
#pragma unroll
        for (int bj = 0; bj < 2; ++bj) { gv[bj][0] = *(const f32x4*)(g + col0 + bj * HALF); gv[bj][1] = *(const f32x4*)(g + col0 + bj * HALF + 4); }
#pragma unroll
        EPI_LOOP_ROWS { const int row = row0 + ai * HALF + m * 16; const size_t off = (size_t)row * 2048 + col0; float s = 0.f;
#pragma unroll
            for (int bj = 0; bj < 2; ++bj) { const f32x4 b0 = *(const f32x4*)(base + off + bj * HALF), b1 = *(const f32x4*)(base + off + bj * HALF + 4);
                const f32x4 x0 = b0 + acc[ai][bj][m][0], x1 = b1 + acc[ai][bj][m][1];
                *(f32x4*)(xo + off + bj * HALF) = x0; *(f32x4*)(xo + off + bj * HALF + 4) = x1;
                s += (x0[0] * x0[0] + x0[1] * x0[1]) + (x0[2] * x0[2] + x0[3] * x0[3]) + (x1[0] * x1[0] + x1[1] * x1[1]) + (x1[2] * x1[2] + x1[3] * x1[3]);
                *(u32x4*)(an + off + bj * HALF) = pack8(x0 * gv[bj][0], x1 * gv[bj][1]); }
            s += __shfl_xor(s, 16); s += __shfl_xor(s, 32);
            if (fq == 0) atomicAdd(ssq + row, s); }
    }
};
struct EpiUp {
    static constexpr bool PERM = true, AFTER_DRAIN = false, MIDK = false;
    bf16_t* O; int ldc; const float* ssq;
    __device__ __forceinline__ void mid(Acc&, const Unit&, int, int, int, int) const {}
    __device__ __forceinline__ void operator()(const Acc& acc, const Unit& u, int wr, int wc, int fr, int fq) const {
        const int row0 = u.pm * BM + wr * 64 + fr, col0 = u.pn * BM + wc * 32 + 8 * fq;
#pragma unroll
        EPI_LOOP_ROWS { const int row = row0 + ai * HALF + m * 16; const float r = 1.0f / sqrtf(ssq[row] * (1.0f / 2048.0f) + 1e-6f);
            bf16_t* rowp = O + (size_t)row * ldc + col0;
#pragma unroll
            for (int bj = 0; bj < 2; ++bj) *(u32x4*)(rowp + bj * HALF) = pack8(acc[ai][bj][m][0] * r, acc[ai][bj][m][1] * r); }
    }
};
struct EpiE {
    static constexpr bool PERM = true, AFTER_DRAIN = false, MIDK = false;
    bf16_t* O; float* ssq;
    __device__ __forceinline__ void mid(Acc&, const Unit&, int, int, int, int) const {}
    __device__ __forceinline__ void operator()(const Acc& acc, const Unit& u, int wr, int wc, int fr, int fq) const {
        const int row0 = u.pm * BM + wr * 64 + fr, col0 = u.pn * BM + wc * 32 + 8 * fq;
#pragma unroll
        EPI_LOOP_ROWS { const int row = row0 + ai * HALF + m * 16; float s = 0.f; bf16_t* rowp = O + (size_t)row * 2048 + col0;
#pragma unroll
            for (int bj = 0; bj < 2; ++bj) { const f32x4 x0 = acc[ai][bj][m][0], x1 = acc[ai][bj][m][1];
                s += (x0[0] * x0[0] + x0[1] * x0[1]) + (x0[2] * x0[2] + x0[3] * x0[3]) + (x1[0] * x1[0] + x1[1] * x1[1]) + (x1[2] * x1[2] + x1[3] * x1[3]);
                *(u32x4*)(rowp + bj * HALF) = pack8(x0, x1); }
            s += __shfl_xor(s, 16); s += __shfl_xor(s, 32);
            if (fq == 0) atomicAdd(ssq + row, s); }
    }
};
struct EpiFinal {
    static constexpr bool PERM = true, AFTER_DRAIN = false, MIDK = false;
    float* out; const bf16_t* E; const float* gp; const float* ssq2; const float* ssqE;
    __device__ __forceinline__ void mid(Acc&, const Unit&, int, int, int, int) const {}
    __device__ __forceinline__ void operator()(const Acc& acc, const Unit& u, int wr, int wc, int fr, int fq) const {
        const int row0 = u.pm * BM + wr * 64 + fr, col0 = u.pn * BM + wc * 32 + 8 * fq;
        f32x4 gv[2][2];
#pragma unroll
        for (int bj = 0; bj < 2; ++bj) { gv[bj][0] = *(const f32x4*)(gp + col0 + bj * HALF); gv[bj][1] = *(const f32x4*)(gp + col0 + bj * HALF + 4); }
#pragma unroll
        EPI_LOOP_ROWS { const int row = row0 + ai * HALF + m * 16; const size_t off = (size_t)row * 2048 + col0;
            const float r2 = 1.0f / sqrtf(ssq2[row] * (1.0f / 2048.0f) + 1e-6f), rE = 1.0f / sqrtf(ssqE[row] * (1.0f / 2048.0f) + 1e-6f);
#pragma unroll
            for (int bj = 0; bj < 2; ++bj) { const f32x4 b0 = *(const f32x4*)(out + off + bj * HALF), b1 = *(const f32x4*)(out + off + bj * HALF + 4);
                const u32x4 e = *(const u32x4*)(E + off + bj * HALF);
                const f32x4 e0 = (f32x4){bf_lo(e.x), bf_hi(e.x), bf_lo(e.y), bf_hi(e.y)}, e1 = (f32x4){bf_lo(e.z), bf_hi(e.z), bf_lo(e.w), bf_hi(e.w)};
                const f32x4 g0 = sigm4(acc[ai][bj][m][0] * r2), g1 = sigm4(acc[ai][bj][m][1] * r2);
                *(f32x4*)(out + off + bj * HALF) = b0 + g0 * (e0 * rE * gv[bj][0]); *(f32x4*)(out + off + bj * HALF + 4) = b1 + g1 * (e1 * rE * gv[bj][1]); } }
    }
};

template <class Epi, class Sched, bool ALIGN_EPI = false, bool SP2 = false>
__device__ __forceinline__ void gemm_phase(PG8_LAS unsigned char* lds, const Gemm g, const Sched& S, const Epi& E) {
    const int tid = threadIdx.x, wid = __builtin_amdgcn_readfirstlane(tid >> 6), lane = tid & 63, wr = wid >> 2, wc = wid & 3, fr = lane & 15, fq = lane >> 4;
    const int K = g.K, nt = K / BK;
    unsigned voffA[2], voffB[2];
#pragma unroll
    for (int i = 0; i < 2; ++i) { int R, C; stage_rc(tid * 16 + i * 8192, R, C); const int Rb = Epi::PERM ? ((R & ~31) + perm32(R & 31)) : R;
        voffA[i] = (unsigned)(R * K + C) * 2u; voffB[i] = (unsigned)(Rb * K + C) * 2u; }
    const size_t kstep = (size_t)(BK * 2);
    const size_t hstep = (size_t)HALF * K * 2;
    const size_t tstep = 2 * hstep;
    const unsigned ldsw = (unsigned)wid * 1024u;
    const int aoff = lds_byte(wr * 64 + fr, fq * 8), boff = lds_byte(wc * 32 + fr, fq * 8);
#define PG8_SA(b, h) (((b) * 2 + (h)) * HTB)
#define PG8_SB(b, h) ((4 + (b) * 2 + (h)) * HTB)
#define PG8_STAGE(bufoff, gbase, voff) do { _Pragma("unroll") for (int _i = 0; _i < 2; ++_i) \
        __builtin_amdgcn_global_load_lds((const unsigned*)((const char*)(gbase) + (voff)[_i]), (PG8_LAS unsigned*)(lds + (bufoff) + ldsw + _i * 8192), 16, 0, 0); } while (0)
#define PG8_LDA(dst, b, h) do { _Pragma("unroll") for (int m = 0; m < 4; ++m) _Pragma("unroll") for (int k = 0; k < 2; ++k) dst[m][k] = *(const PG8_LAS bf16x8*)(lds + PG8_SA(b, h) + aoff + m * 2048 + k * 1024); } while (0)
#define PG8_LDB(dst, b, h) do { _Pragma("unroll") for (int n = 0; n < 2; ++n) _Pragma("unroll") for (int k = 0; k < 2; ++k) dst[n][k] = *(const PG8_LAS bf16x8*)(lds + PG8_SB(b, h) + boff + n * 2048 + k * 1024); } while (0)
#define PG8_MMA(ai, bj, At, Bt) do { __builtin_amdgcn_s_setprio(1); _Pragma("unroll") for (int m = 0; m < 4; ++m) _Pragma("unroll") for (int n = 0; n < 2; ++n) _Pragma("unroll") for (int k = 0; k < 2; ++k) \
        acc[ai][bj][m][n] = __builtin_amdgcn_mfma_f32_16x16x32_bf16(Bt[n][k], At[m][k], acc[ai][bj][m][n], 0, 0, 0); __builtin_amdgcn_s_setprio(0); } while (0)
#define PG8_WAIT_V(n) asm volatile("s_waitcnt vmcnt(" #n ")" ::: "memory")
#define PG8_WAIT_L(n) asm volatile("s_waitcnt lgkmcnt(" #n ")" ::: "memory")
#define PG8_BAR __builtin_amdgcn_s_barrier()
#define PG8_SCHED __builtin_amdgcn_sched_barrier(0)
    Unit cur, nxt; int ui = 0;
    if (!S.next(0, cur)) return;
    f32x4 acc[2][2][4][2];
#pragma unroll
    for (int a = 0; a < 2; ++a)
#pragma unroll
        for (int b = 0; b < 2; ++b)
#pragma unroll
            for (int m = 0; m < 4; ++m)
#pragma unroll
                for (int n = 0; n < 2; ++n) acc[a][b][m][n] = (f32x4){0.f, 0.f, 0.f, 0.f};
    bf16x8 At[4][2], B0[2][2], B1[2][2];
    const char* cA = (const char*)g.A + (size_t)cur.pm * tstep; const char* cB = (const char*)g.Bt + (size_t)cur.pn * tstep;
    S.a_ready(cur);
    if constexpr (SP2) {
        PG8_STAGE(PG8_SB(0, 0), cB, voffB); PG8_STAGE(PG8_SB(0, 1), cB + hstep, voffB); PG8_STAGE(PG8_SA(0, 0), cA, voffA); PG8_STAGE(PG8_SA(0, 1), cA + hstep, voffA);
        if (wr == 1) PG8_BAR;
        PG8_WAIT_V(2); PG8_BAR;
        PG8_STAGE(PG8_SB(1, 0), cB + kstep, voffB); PG8_STAGE(PG8_SA(1, 0), cA + kstep, voffA); PG8_STAGE(PG8_SB(1, 1), cB + hstep + kstep, voffB);
        PG8_WAIT_V(6); PG8_BAR;
    } else {
        PG8_STAGE(PG8_SB(0, 0), cB, voffB); PG8_STAGE(PG8_SA(0, 0), cA, voffA); PG8_STAGE(PG8_SB(0, 1), cB + hstep, voffB); PG8_STAGE(PG8_SA(0, 1), cA + hstep, voffA);
        if (wr == 1) PG8_BAR;
        PG8_WAIT_V(4); PG8_BAR;
        PG8_STAGE(PG8_SB(1, 0), cB + kstep, voffB); PG8_STAGE(PG8_SA(1, 0), cA + kstep, voffA); PG8_STAGE(PG8_SB(1, 1), cB + hstep + kstep, voffB);
        PG8_WAIT_V(6); PG8_BAR;
    }
    for (;;) {
        const bool has_next = S.next(ui + 1, nxt);
        const char* nA = has_next ? (const char*)g.A + (size_t)nxt.pm * tstep : cA; const char* nB = has_next ? (const char*)g.Bt + (size_t)nxt.pn * tstep : cB;
        constexpr int NSEG = Epi::MIDK ? 2 : 1;
#pragma unroll 1
        for (int seg = 0; seg < NSEG; ++seg) {
        if constexpr (Epi::MIDK) { if (seg == 1) E.mid(acc, cur, wr, wc, fr, fq); }
        const int t_hi = (NSEG == 2 && seg == 0) ? (nt >> 1) : nt;
#pragma unroll 1
        for (int t = (NSEG == 2 && seg == 1) ? (nt >> 1) : 0; t < t_hi; t += 2) {
            const bool last = (t == nt - 2);
            const char* a1 = cA + (size_t)(t + 1) * kstep;
            const char* a2 = last ? nA : cA + (size_t)(t + 2) * kstep; const char* b2 = last ? nB : cB + (size_t)(t + 2) * kstep;
            const char* a3 = a2 + kstep; const char* b3 = b2 + kstep;
            if (last && has_next) S.a_ready(nxt);
            if constexpr (SP2) {
            PG8_LDB(B0, 0, 0); PG8_LDB(B1, 0, 1); PG8_SCHED; PG8_LDA(At, 0, 0); PG8_STAGE(PG8_SA(1, 1), a1 + hstep, voffA);
            PG8_WAIT_V(8); PG8_WAIT_L(0); PG8_BAR; PG8_MMA(0, 0, At, B0); PG8_MMA(0, 1, At, B1); PG8_BAR; PG8_SCHED;
            PG8_LDA(At, 0, 1); PG8_STAGE(PG8_SB(0, 0), b2, voffB); PG8_STAGE(PG8_SB(0, 1), b2 + hstep, voffB); PG8_STAGE(PG8_SA(0, 0), a2, voffA);
            PG8_WAIT_V(8); PG8_WAIT_L(0); PG8_BAR; PG8_MMA(1, 0, At, B0); PG8_MMA(1, 1, At, B1); PG8_BAR; PG8_SCHED;
            PG8_LDB(B0, 1, 0); PG8_LDB(B1, 1, 1); PG8_SCHED; PG8_LDA(At, 1, 0); PG8_STAGE(PG8_SA(0, 1), a2 + hstep, voffA);
            PG8_WAIT_V(8); PG8_WAIT_L(0); PG8_BAR; PG8_MMA(0, 0, At, B0); PG8_MMA(0, 1, At, B1); PG8_BAR; PG8_SCHED;
            PG8_LDA(At, 1, 1); PG8_STAGE(PG8_SB(1, 0), b3, voffB); PG8_STAGE(PG8_SB(1, 1), b3 + hstep, voffB); PG8_STAGE(PG8_SA(1, 0), a3, voffA);
            PG8_WAIT_V(8); PG8_WAIT_L(0); PG8_BAR; PG8_MMA(1, 0, At, B0); PG8_MMA(1, 1, At, B1); PG8_BAR; PG8_SCHED;
            } else {
            PG8_LDB(B0, 0, 0); PG8_SCHED; PG8_LDA(At, 0, 0); PG8_STAGE(PG8_SA(1, 1), a1 + hstep, voffA);
            PG8_WAIT_L(8); PG8_BAR; PG8_WAIT_L(0); PG8_MMA(0, 0, At, B0); PG8_BAR; PG8_SCHED;
            PG8_LDB(B1, 0, 1); PG8_STAGE(PG8_SB(0, 0), b2, voffB);
            PG8_BAR; PG8_WAIT_L(0); PG8_MMA(0, 1, At, B1); PG8_BAR;
            PG8_LDA(At, 0, 1); PG8_STAGE(PG8_SA(0, 0), a2, voffA);
            PG8_BAR; PG8_WAIT_L(0); PG8_MMA(1, 0, At, B0); PG8_BAR; PG8_SCHED;
            PG8_STAGE(PG8_SB(0, 1), b2 + hstep, voffB);
            PG8_WAIT_V(6); PG8_BAR; PG8_MMA(1, 1, At, B1); PG8_BAR;
            PG8_LDB(B0, 1, 0); PG8_SCHED; PG8_LDA(At, 1, 0); PG8_STAGE(PG8_SA(0, 1), a2 + hstep, voffA);
            PG8_WAIT_L(8); PG8_BAR; PG8_WAIT_L(0); PG8_MMA(0, 0, At, B0); PG8_BAR; PG8_SCHED;
            PG8_LDB(B1, 1, 1); PG8_STAGE(PG8_SB(1, 0), b3, voffB);
            PG8_BAR; PG8_WAIT_L(0); PG8_MMA(0, 1, At, B1); PG8_BAR;
            PG8_LDA(At, 1, 1); PG8_STAGE(PG8_SA(1, 0), a3, voffA);
            PG8_BAR; PG8_WAIT_L(0); PG8_MMA(1, 0, At, B0); PG8_BAR; PG8_SCHED;
            PG8_STAGE(PG8_SB(1, 1), b3 + hstep, voffB);
            PG8_WAIT_V(6); PG8_BAR; PG8_MMA(1, 1, At, B1); PG8_BAR;
            }
        }
        }
        if constexpr (ALIGN_EPI) { if (wr == 0) PG8_BAR; }
        if constexpr (!Epi::AFTER_DRAIN) { E(acc, cur, wr, wc, fr, fq); S.done(cur); }
        if (!has_next) break;
#pragma unroll
        for (int a = 0; a < 2; ++a)
#pragma unroll
            for (int b = 0; b < 2; ++b)
#pragma unroll
                for (int m = 0; m < 4; ++m)
#pragma unroll
                    for (int n = 0; n < 2; ++n) acc[a][b][m][n] = (f32x4){0.f, 0.f, 0.f, 0.f};
        cur = nxt; cA = nA; cB = nB; ++ui;
        if constexpr (ALIGN_EPI) { if (wr == 1) PG8_BAR; }
    }
    PG8_WAIT_V(0);
    if constexpr (!ALIGN_EPI) { if (wr == 0) PG8_BAR; }
    PG8_BAR;
#undef PG8_SA
#undef PG8_SB
#undef PG8_STAGE
#undef PG8_LDA
#undef PG8_LDB
#undef PG8_MMA
#undef PG8_WAIT_V
#undef PG8_WAIT_L
#undef PG8_BAR
#undef PG8_SCHED
}
}

namespace fox {
typedef unsigned short bf16_t;
typedef short bf16x8 __attribute__((ext_vector_type(8)));
typedef short s16x4 __attribute__((ext_vector_type(4)));
typedef float f32x16 __attribute__((ext_vector_type(16)));
typedef float f32x4 __attribute__((ext_vector_type(4)));
typedef unsigned u32x4 __attribute__((ext_vector_type(4)));
constexpr int D = 128, NW = 8, QBLK = 32, KVBLK = 64, QB = NW * QBLK;
constexpr int SHM_V = KVBLK * D * 2, SHM_K = KVBLK * D * 2;
constexpr int LDS_WS = 2 * SHM_V + 2 * SHM_K;
constexpr int LDS_CUM = LDS_WS + NW * 64 * 4;
constexpr int LDS_BYTES = LDS_CUM + 2048 * 4;
constexpr int QS = 9216, OS = 2048;
constexpr float SCALE = 0.08838834764831845f;
constexpr float THR = 8.f;
constexpr unsigned WBIG = 0x40000000u;

#define KSWZ(row, colB) ((row) * 256 + ((colB) ^ (((row) & 7) << 4)))
#define SBAR() __builtin_amdgcn_sched_barrier(0)
__device__ __forceinline__ int v_st(int k, int c) { const int kk = (k & ~0xC) | ((k & 4) << 1) | ((k & 8) >> 1); return ((kk >> 3) * 4 + (c >> 5)) * 512 + ((kk & 7) * 32 + (c & 31)) * 2; }
__device__ __forceinline__ int v_rd_base(int lane) { return ((lane & 3) << 3) | (((lane >> 2) & 3) << 6) | (((lane >> 4) & 1) << 5) | (((lane >> 5) & 1) << 8); }
constexpr int v_rd_off(int d0, int ks, int half) { return d0 * 512 + ks * 4096 + half * 2048; }
__device__ __forceinline__ int crow(int r, int hi) { return (r & 3) + 8 * (r >> 2) + 4 * hi; }
__device__ __forceinline__ unsigned cvtpk(float lo, float hi) { unsigned r; asm volatile("v_cvt_pk_bf16_f32 %0, %1, %2" : "=v"(r) : "v"(lo), "v"(hi)); return r; }
__device__ __forceinline__ bf16x8 load8(const bf16_t* p) { return *reinterpret_cast<const bf16x8*>(p); }
__device__ __forceinline__ void mask_tile(f32x16& p0, f32x16& p1, int dq) {
    const float NEG = -__builtin_inff();
#pragma unroll
    for (int r = 0; r < 16; ++r) {
        const int c = (r & 3) + 8 * (r >> 2);
        if ((unsigned)(dq - c) >= WBIG) p0[r] = NEG;
        if ((unsigned)(dq - c - 32) >= WBIG) p1[r] = NEG;
    }
}
__device__ __forceinline__ void partialSM(f32x16& p0, f32x16& p1, float& m_reg, float& mn, float& alpha) {
    float pmax = p0[0]; for (int r = 1; r < 16; ++r) pmax = fmaxf(pmax, p0[r]); for (int r = 0; r < 16; ++r) pmax = fmaxf(pmax, p1[r]);
    { auto rr = __builtin_amdgcn_permlane32_swap(__float_as_uint(pmax), __float_as_uint(pmax), false, false);
      pmax = fmaxf(__uint_as_float(rr[0]), __uint_as_float(rr[1])); }
    constexpr float C2 = 1.4426950408889634f * SCALE;
    if (__builtin_expect(__all((pmax - m_reg) * SCALE <= THR), 1)) { mn = m_reg; alpha = 1.f; }
    else { mn = fmaxf(m_reg, pmax); alpha = __builtin_amdgcn_exp2f((m_reg - mn) * C2); m_reg = mn; }
    const float mnL = -mn * C2;
    for (int r = 0; r < 16; ++r) p0[r] = fmaf(p0[r], C2, mnL); for (int r = 0; r < 16; ++r) p1[r] = fmaf(p1[r], C2, mnL);
    for (int r = 0; r < 16; ++r) p0[r] = __builtin_amdgcn_exp2f(p0[r]);
}
__device__ __forceinline__ void finishSM(f32x16& p0, f32x16& p1, float alpha, float& l_reg, bf16x8& pa0, bf16x8& pa1, bf16x8& pa2, bf16x8& pa3) {
    for (int r = 0; r < 16; ++r) p1[r] = __builtin_amdgcn_exp2f(p1[r]);
    float ps = 0; for (int r = 0; r < 16; ++r) ps += p0[r]; for (int r = 0; r < 16; ++r) ps += p1[r];
    { auto rr = __builtin_amdgcn_permlane32_swap(__float_as_uint(ps), __float_as_uint(ps), false, false);
      ps = __uint_as_float(rr[0]) + __uint_as_float(rr[1]); }
    l_reg = l_reg * alpha + ps;
#define PK4(P, B_, OUT) do { unsigned a0 = cvtpk(P[B_+0], P[B_+1]), a1 = cvtpk(P[B_+2], P[B_+3]);                          \
        unsigned b0 = cvtpk(P[B_+4], P[B_+5]), b1 = cvtpk(P[B_+6], P[B_+7]);                                             \
        auto r0 = __builtin_amdgcn_permlane32_swap(a0, b0, false, false); auto r1 = __builtin_amdgcn_permlane32_swap(a1, b1, false, false); \
        u32x4 w = {r0[0], r1[0], r0[1], r1[1]}; OUT = *reinterpret_cast<bf16x8*>(&w); } while (0)
    PK4(p0, 0, pa0); PK4(p0, 8, pa1); PK4(p1, 0, pa2); PK4(p1, 8, pa3);
#undef PK4
}
template <int KB>
__device__ __forceinline__ void qkt(f32x16& p0, f32x16& p1, const char* K_lds, int r32, int hi, const bf16x8* qr, const float* cl) {
#pragma unroll
    for (int g = 0; g < 4; ++g) { const f32x4 c0 = *(const f32x4*)(cl + 8 * g), c1 = *(const f32x4*)(cl + 32 + 8 * g);
#pragma unroll
        for (int i = 0; i < 4; ++i) { p0[4 * g + i] = c0[i]; p1[4 * g + i] = c1[i]; } }
    const char* kb[4];
#pragma unroll
    for (int dd = 0; dd < 4; ++dd) kb[dd] = K_lds + KB * SHM_K + KSWZ(r32, (dd * 16 + hi * 8) * 2);
#pragma unroll
    for (int d0 = 0; d0 < 8; ++d0) { const char* a = kb[d0 & 3] + (d0 >> 2) * 128;
        bf16x8 b0 = *reinterpret_cast<const bf16x8*>(a);
        bf16x8 b1 = *reinterpret_cast<const bf16x8*>(a + 32 * 256);
        p0 = __builtin_amdgcn_mfma_f32_32x32x16_bf16(b0, qr[d0], p0, 0, 0, 0);
        p1 = __builtin_amdgcn_mfma_f32_32x32x16_bf16(b1, qr[d0], p1, 0, 0, 0); }
}
#define TRRD(dst, base, off) asm volatile("ds_read_b64_tr_b16 %0, %1 offset:%2" : "=&v"(dst) : "v"(base), "i"(off) : "memory")
template <int VB>
__device__ __forceinline__ void pv_tile(f32x16* o, int vb0, bf16x8 pa0, bf16x8 pa1, bf16x8 pa2, bf16x8 pa3) {
#define PV_D0(d0) do { s16x4 l0, l1, l2, l3, h0, h1, h2, h3; constexpr int b_ = VB * SHM_V + v_rd_off(d0, 0, 0); \
        TRRD(l0, vb0, b_); TRRD(h0, vb0, b_ + 2048); TRRD(l1, vb0, b_ + 4096); TRRD(h1, vb0, b_ + 6144); TRRD(l2, vb0, b_ + 8192); TRRD(h2, vb0, b_ + 10240); TRRD(l3, vb0, b_ + 12288); TRRD(h3, vb0, b_ + 14336); \
        asm volatile("s_waitcnt lgkmcnt(0)" ::: "memory"); SBAR();   \
        o[d0] = __builtin_amdgcn_mfma_f32_32x32x16_bf16(pa0, (bf16x8){l0[0], l0[1], l0[2], l0[3], h0[0], h0[1], h0[2], h0[3]}, o[d0], 0, 0, 0);   \
        o[d0] = __builtin_amdgcn_mfma_f32_32x32x16_bf16(pa1, (bf16x8){l1[0], l1[1], l1[2], l1[3], h1[0], h1[1], h1[2], h1[3]}, o[d0], 0, 0, 0);   \
        o[d0] = __builtin_amdgcn_mfma_f32_32x32x16_bf16(pa2, (bf16x8){l2[0], l2[1], l2[2], l2[3], h2[0], h2[1], h2[2], h2[3]}, o[d0], 0, 0, 0);   \
        o[d0] = __builtin_amdgcn_mfma_f32_32x32x16_bf16(pa3, (bf16x8){l3[0], l3[1], l3[2], l3[3], h3[0], h3[1], h3[2], h3[3]}, o[d0], 0, 0, 0); } while (0)
    PV_D0(0); PV_D0(1); PV_D0(2); PV_D0(3);
#undef PV_D0
}

struct BlockRef { const bf16_t* Q; const bf16_t* K; const bf16_t* V; bf16_t* O; int P0; };
struct Seam { bf16x8 qr[8]; bf16x8 st_v0, st_v1, st_k0, st_k1; };
#define ROW(p, k0, rr) ((p) + (size_t)((k0) + (rr)) * QS + sc)
#define VMW() asm volatile("s_waitcnt vmcnt(0)" ::: "memory")
#define VMWN(n) asm volatile("s_waitcnt vmcnt(%0)" :: "i"(n) : "memory")
#define SLOAD_H(Kp, Vp, k0) do { S.st_v0 = load8(ROW(Vp, k0, sr)); S.st_v1 = load8(ROW(Vp, k0, 32 + sr));              \
                         S.st_k0 = load8(ROW(Kp, k0, sr)); S.st_k1 = load8(ROW(Kp, k0, 32 + sr)); } while (0)
#define SWRITE_HK(bf) do { *(bf16x8*)(K_lds + (bf) * SHM_K + kws) = S.st_k0; *(bf16x8*)(K_lds + (bf) * SHM_K + kws + 32 * 256) = S.st_k1; } while (0)
#define SWRITE_HV(bf) do { *(bf16x8*)(V_lds + (bf) * SHM_V + vst0) = S.st_v0; *(bf16x8*)(V_lds + (bf) * SHM_V + vst1) = S.st_v1; } while (0)
#define SWRITE_H(bf) do { SWRITE_HV(bf); SWRITE_HK(bf); } while (0)
__device__ __forceinline__ void fox_prime(const BlockRef& cur, char* lds, Seam& S) {
    const int tid = threadIdx.x, wid = __builtin_amdgcn_readfirstlane(tid >> 6), lane = tid & 63, r32 = lane & 31, hi = lane >> 5;
    const int sr = tid >> 4, sc = (tid & 15) * 8, kws = KSWZ(sr, sc * 2); char* K_lds = lds + 2 * SHM_V;
#pragma unroll
    for (int d0 = 0; d0 < 8; ++d0) S.qr[d0] = load8(cur.Q + (size_t)(wid * QBLK + r32) * QS + d0 * 16 + hi * 8);
    SLOAD_H(cur.K, cur.V, 0); VMW(); SWRITE_HK(0);
    __syncthreads();
}
__device__ __forceinline__ void fox_block(const BlockRef& cur, const BlockRef& nxt, char* lds, Seam& S, const float* cumL) {
    const int tid = threadIdx.x, wid = __builtin_amdgcn_readfirstlane(tid >> 6), lane = tid & 63, r32 = lane & 31, hi = lane >> 5;
    const int NT = (cur.P0 + QB) / KVBLK;
    const int kbn = 0;
    const int qlo = cur.P0 + wid * QBLK, qm = qlo + r32 - 4 * hi;
    char* V_lds = lds; char* K_lds = lds + 2 * SHM_V;
    float* ws = (float*)(lds + LDS_WS) + wid * 64; float* li_l = ws, * al_l = ws + 32;
    float m_reg = -1e30f, l_reg = 0; f32x16 o[4] = {};
    const int sr = tid >> 4, sc = (tid & 15) * 8, vst0 = v_st(sr, sc), vst1 = v_st(32 + sr, sc), kws = KSWZ(sr, sc * 2);
    const int vb0 = (int)(uintptr_t)V_lds + v_rd_base(lane);
    const bf16_t* Kh = cur.K; const bf16_t* Vh = cur.V;
    const float* clb = cumL + 4 * hi;
#define RESC(a) do { if (__any((a) < 1.f)) { if (hi == 0) al_l[r32] = (a); asm volatile("s_waitcnt lgkmcnt(0)" ::: "memory");              \
                     for (int d_ = 0; d_ < 4; ++d_) for (int r = 0; r < 16; ++r) o[d_][r] *= al_l[crow(r, hi)]; } } while (0)
#define KBASE(t) ((t) * KVBLK)
#define MASKT(P0_, P1_, t) do { const int kb_ = KBASE(t); if (kb_ + KVBLK - 1 > qlo) mask_tile(P0_, P1_, qm - kb_); } while (0)
    constexpr int NQL = 8;
#define SEAM_K0() do { VMWN(NQL); SWRITE_HK(0); SBAR(); } while (0)
    f32x16 pA0, pA1, pB0, pB1; float mnA, mnB, alA, alB; bf16x8 pa0, pa1, pa2, pa3;
    SWRITE_HV(0); SBAR();
    if (NT > 1) { SLOAD_H(Kh, Vh, KBASE(1)); }
    SBAR(); qkt<0>(pA0, pA1, K_lds, r32, hi, S.qr, clb + KBASE(0));
    MASKT(pA0, pA1, 0); partialSM(pA0, pA1, m_reg, mnA, alA);
    if (NT > 1) { VMW(); SWRITE_H(1); }
    __syncthreads();
#define HALF_STEP(PX0, PX1, mnX, alX, PY0, PY1, alY, t, KB, VB, SB) do {                                                      \
        SBAR(); qkt<KB>(PX0, PX1, K_lds, r32, hi, S.qr, clb + KBASE(t));                                                  \
        finishSM(PY0, PY1, alY, l_reg, pa0, pa1, pa2, pa3); SBAR();                                                           \
        if ((t) + 1 < NT) { SLOAD_H(Kh, Vh, KBASE((t) + 1)); SBAR(); }                                                        \
        pv_tile<VB>(o, vb0, pa0, pa1, pa2, pa3); MASKT(PX0, PX1, (t)); partialSM(PX0, PX1, m_reg, mnX, alX);                   \
        __syncthreads();                                                                                                      \
        if ((t) + 1 < NT) { VMW(); SWRITE_H(SB); }                                                                            \
        RESC(alX); __syncthreads(); } while (0)
    for (int t = 1; t + 1 < NT; t += 2) {
        HALF_STEP(pB0, pB1, mnB, alB, pA0, pA1, alA, t, 1, 0, 0);
        HALF_STEP(pA0, pA1, mnA, alA, pB0, pB1, alB, t + 1, 0, 1, 1);
    }
    const bool even = (NT & 1) == 0;
    if (even) { SBAR(); qkt<1>(pB0, pB1, K_lds, r32, hi, S.qr, clb + KBASE(NT - 1)); SBAR(); }
    SLOAD_H(nxt.K, nxt.V, kbn); SBAR();
#pragma unroll
    for (int d0 = 0; d0 < 8; ++d0) S.qr[d0] = load8(nxt.Q + (size_t)(wid * QBLK + r32) * QS + d0 * 16 + hi * 8);
    SBAR();
    finishSM(pA0, pA1, alA, l_reg, pa0, pa1, pa2, pa3); SBAR();
    pv_tile<0>(o, vb0, pa0, pa1, pa2, pa3);
    if (even) { MASKT(pB0, pB1, NT - 1); partialSM(pB0, pB1, m_reg, mnB, alB); __syncthreads(); RESC(alB);
        finishSM(pB0, pB1, alB, l_reg, pa0, pa1, pa2, pa3); SBAR(); pv_tile<1>(o, vb0, pa0, pa1, pa2, pa3); }
    SBAR(); SEAM_K0();
    if (hi == 0) li_l[r32] = l_reg; asm volatile("s_waitcnt lgkmcnt(0)" ::: "memory");
    float rli[16];
#pragma unroll
    for (int r = 0; r < 16; ++r) rli[r] = __builtin_amdgcn_rcpf(li_l[crow(r, hi)]);
    bf16_t* Ow = cur.O + (size_t)(wid * QBLK) * OS;
#pragma unroll
    for (int r = 0; r < 16; ++r) { const int orow = crow(r, hi);
#pragma unroll
        for (int d0 = 0; d0 < 4; ++d0) { const float v = o[d0][r] * rli[r];
            const float vn = __shfl_xor(v, 1);
            if ((r32 & 1) == 0) *(unsigned*)(Ow + (size_t)orow * OS + d0 * 32 + r32) = cvtpk(v, vn); } }
    __syncthreads();
#undef RESC
#undef KBASE
#undef MASKT
#undef SEAM_K0
#undef HALF_STEP
}
#undef ROW
#undef VMWN
#undef SLOAD_H
#undef SWRITE_HK
#undef SWRITE_HV
#undef SWRITE_H

__device__ __forceinline__ void gmlp_unit(char* lds, int idx, const bf16_t* Z, const bf16_t* Wb, const float* b_s, bf16_t* OAB) {
    const int tid = threadIdx.x, wid = __builtin_amdgcn_readfirstlane(tid >> 6), lane = tid & 63, r32 = lane & 31, hi = lane >> 5;
    const int g = idx & 7, row0 = (idx >> 3) * 128;
    char* V_lds = lds;
    const int sr = tid >> 4, sc = (tid & 15) * 8;
#pragma unroll
    for (int q = 0; q < 4; ++q) { const int s = q * 32 + sr;
        const bf16x8 v = load8(Z + (size_t)(row0 + s) * QS + 1024 + g * 128 + sc);
        *(bf16x8*)(V_lds + (q >> 1) * SHM_V + v_st((q & 1) * 32 + sr, sc)) = v; }
    __syncthreads();
    const int rg = wid & 3, dh = wid >> 2;
    f32x16 o0 = {}, o1 = {};
    const bf16_t* wrow = Wb + (size_t)(g * 128 + 32 * rg + r32) * 128 + 8 * hi;
    const int vb = (int)(uintptr_t)V_lds + v_rd_base(lane) + dh * 1024;
    const int nks = 2 * (rg + 1);
#define GM_STEP(ks) do { if ((ks) < nks) { const bf16x8 a = load8(wrow + 16 * (ks)); s16x4 l0, h0, l1, h1; constexpr int b_ = ((ks) >> 2) * SHM_V + v_rd_off(0, (ks) & 3, 0); \
        TRRD(l0, vb, b_); TRRD(h0, vb, b_ + 2048); TRRD(l1, vb, b_ + 512); TRRD(h1, vb, b_ + 512 + 2048); \
        asm volatile("s_waitcnt lgkmcnt(0)" ::: "memory"); SBAR(); \
        o0 = __builtin_amdgcn_mfma_f32_32x32x16_bf16(a, (bf16x8){l0[0], l0[1], l0[2], l0[3], h0[0], h0[1], h0[2], h0[3]}, o0, 0, 0, 0); \
        o1 = __builtin_amdgcn_mfma_f32_32x32x16_bf16(a, (bf16x8){l1[0], l1[1], l1[2], l1[3], h1[0], h1[1], h1[2], h1[3]}, o1, 0, 0, 0); } } while (0)
    GM_STEP(0); GM_STEP(1); GM_STEP(2); GM_STEP(3); GM_STEP(4); GM_STEP(5); GM_STEP(6); GM_STEP(7);
#undef GM_STEP
#pragma unroll
    for (int r = 0; r < 16; ++r) { const int t = 32 * rg + crow(r, hi); const float bias = b_s[g * 128 + t];
        const size_t zoff = (size_t)(row0 + t) * QS + g * 128, ooff = (size_t)(row0 + t) * OS + g * 128;
#pragma unroll
        for (int dd = 0; dd < 2; ++dd) { const int d = (2 * dh + dd) * 32 + r32;
            const float uu = __uint_as_float((unsigned)Z[zoff + d] << 16);
            const float v = uu * ((dd ? o1[r] : o0[r]) + bias);
            const float vn = __shfl_xor(v, 1);
            if ((r32 & 1) == 0) *(unsigned*)(OAB + ooff + d) = cvtpk(v, vn); } }
    __syncthreads();
}
#undef TRRD
#undef SBAR
#undef VMW
}

constexpr int NWAVES = 8;
constexpr int N_LAUNCHES = MK_N_LAUNCHES;
constexpr int N_PHASES = 10;
constexpr int M = 8192, DM = 2048, SEQ = 2048, NZ = 9216, DFF = 5632, NUP = 2 * DFF, PLE = 256, INC = 9224;
constexpr float EPS = 1e-6f;
constexpr size_t MiB = 1u << 20;
constexpr size_t WS_CTL = 0, CTL_ZERO_BYTES = 1 * MiB;
constexpr size_t WS_F = 1 * MiB;
constexpr size_t WS_CUM = WS_F + 512 * 1024;
constexpr size_t WS_WSB = 2 * MiB;
constexpr size_t WS_Z = 4 * MiB;
constexpr size_t WS_Y = 148 * MiB;
constexpr size_t WS_UP = 4 * MiB;
constexpr size_t WS_E = 4 * MiB;
constexpr size_t WS_A2 = 36 * MiB;
constexpr size_t WS_WUP = 180 * MiB, WS_WDOWN = 224 * MiB, WS_WGATE = 246 * MiB, WS_WPLE = 254 * MiB, WS_PB = 255 * MiB;
constexpr size_t WS_H = 259 * MiB;
constexpr size_t WS_WIN = 291 * MiB, WS_WAB = 327 * MiB, WS_WOUT = 335 * MiB;
constexpr size_t WS_HM = 259 * MiB;
constexpr size_t WS_END = 347 * MiB;
constexpr int CW_BAR = 4096, CW_GQ = 8192, CW_SSQ1 = 16384, CW_SSQ2 = 24576, CW_SSQE = 32768;

constexpr int RING_BYTES = 131072;
constexpr int LDSCTL_OFF = 143360, MISC_OFF = LDSCTL_OFF + 320;
constexpr int LDS_BYTES = 147456;
constexpr int P0_WF_OFF = 67584;
static_assert(P0_WF_OFF + 65536 <= LDSCTL_OFF && fox::LDS_BYTES <= RING_BYTES && MISC_OFF + 128 <= LDS_BYTES, "LDS map");

#define GAS __attribute__((address_space(1)))
#define LAS __attribute__((address_space(3)))
typedef unsigned short bf16;
typedef unsigned v4u __attribute__((ext_vector_type(4)));
typedef float f32x4 __attribute__((ext_vector_type(4)));
#define RLX_AGENT __ATOMIC_RELAXED, __HIP_MEMORY_SCOPE_AGENT
#define LDS_WAIT() asm volatile("s_waitcnt lgkmcnt(0)" ::: "memory")
__device__ __forceinline__ unsigned f2bf(float f) { unsigned u = __builtin_bit_cast(unsigned, f); return (u + 0x7fffu + ((u >> 16) & 1u)) >> 16; }
__device__ __forceinline__ unsigned pk2(float lo, float hi) { return f2bf(lo) | (f2bf(hi) << 16); }
__device__ __forceinline__ float bflo(unsigned w) { return __uint_as_float(w << 16); }
__device__ __forceinline__ float bfhi(unsigned w) { return __uint_as_float(w & 0xffff0000u); }

#define XB_TMO      128
#define XB_XCNT(j)  (256  + 64 * (j))
#define XB_XSUB(j)  (1280 + 64 * (j))
#define XB_XGEN(j)  (2304 + 64 * (j))
#define XB_TOP      3328
#define XB_TOPGEN   3392
#define XCD_BAR_WORDS 3456
#define XB_SPIN_CAP (1u << 18)
__device__ __forceinline__ unsigned xb_ld(unsigned* p)              { return __hip_atomic_load(p, __ATOMIC_RELAXED, __HIP_MEMORY_SCOPE_AGENT); }
__device__ __forceinline__ unsigned xb_add(unsigned* p, unsigned v) { return __hip_atomic_fetch_add(p, v, __ATOMIC_RELAXED, __HIP_MEMORY_SCOPE_AGENT); }
__device__ __forceinline__ unsigned xb_xcc_id() { return (unsigned)__builtin_amdgcn_s_getreg((3 << 11) | 20) & 0xFu; }
#define XB_SPIN(cond, bar) do { unsigned _sp = 0; while (cond) { __builtin_amdgcn_s_sleep(1); \
    if ((++_sp & 255u) == 0u) { if (xb_ld(&(bar)[XB_TMO])) break; if (_sp > XB_SPIN_CAP) { atomicAdd(&(bar)[XB_TMO], 1u); break; } } } } while (0)
struct XcdBarrier { unsigned* bar; unsigned x; volatile LAS unsigned* st; };
__device__ __forceinline__ XcdBarrier xcd_barrier_post(unsigned* bar, volatile LAS unsigned* st) {
    XcdBarrier b; b.bar = bar; b.x = xb_xcc_id(); b.st = st;
    if (threadIdx.x == 0) (void)xb_add(&bar[XB_XCNT(b.x)], 1u);
    return b;
}
__device__ __forceinline__ void xcd_barrier_complete(unsigned* bar, unsigned x, unsigned& nloc, unsigned& nx) {
    const unsigned G = gridDim.x * gridDim.y * gridDim.z;
    unsigned sum, cnt, mine, sp = 0u;
    for (;;) {
        sum = 0u; cnt = 0u; mine = 0u;
#pragma unroll
        for (unsigned j = 0; j < 16; ++j) { const unsigned c = xb_ld(&bar[XB_XCNT(j)]); sum += c; cnt += (c > 0u) ? 1u : 0u; mine = (j == x) ? c : mine; }
        if (sum == G) break;
        __builtin_amdgcn_s_sleep(1);
        if ((++sp & 255u) == 0u) { if (xb_ld(&bar[XB_TMO])) break; if (sp > XB_SPIN_CAP) { atomicAdd(&bar[XB_TMO], 1u); break; } }
    }
    nloc = mine > 0u ? mine : 1u; nx = cnt > 0u ? cnt : 1u;
}
__device__ __forceinline__ void xcd_barrier(const XcdBarrier& b) {
    asm volatile("s_waitcnt vmcnt(0)" ::: "memory");
    __syncthreads();
    if (threadIdx.x == 0) {
        unsigned* bar = b.bar;
        __builtin_amdgcn_s_waitcnt(0);
        unsigned nloc = b.st[0], nx = b.st[1];
        if (nloc == 0u) { xcd_barrier_complete(bar, b.x, nloc, nx); b.st[0] = nloc; b.st[1] = nx; }
        const unsigned old = xb_add(&bar[XB_XSUB(b.x)], 1u);
        const unsigned gen = old / nloc;
        if (old + 1u == (gen + 1u) * nloc) {
            __builtin_amdgcn_fence(__ATOMIC_RELEASE, "agent");
            asm volatile("s_waitcnt vmcnt(0)" ::: "memory");
            const unsigned og = xb_add(&bar[XB_TOP], 1u);
            const unsigned tg = og / nx;
            if (og + 1u == (tg + 1u) * nx) xb_add(&bar[XB_TOPGEN], 1u);
            else XB_SPIN(xb_ld(&bar[XB_TOPGEN]) == tg, bar);
            __builtin_amdgcn_fence(__ATOMIC_ACQUIRE, "agent");
            xb_add(&bar[XB_XGEN(b.x)], 1u);
            asm volatile("s_waitcnt vmcnt(0)" ::: "memory");
        } else {
            XB_SPIN(xb_ld(&bar[XB_XGEN(b.x)]) == gen, bar);
            __builtin_amdgcn_fence(__ATOMIC_ACQUIRE, "agent");
            asm volatile("s_waitcnt vmcnt(0)" ::: "memory");
        }
    }
    __syncthreads();
}

__device__ __forceinline__ float wave_sum(float v) {
#pragma unroll
    for (int o = 1; o < 64; o <<= 1) v += __shfl_xor(v, o);
    return v;
}
__device__ __forceinline__ void p0_transpose_item(const float* W, int ldw, int k0, int scol, bf16* WT, int ldk, int drow, int dk0, LAS float* scr, int lane) {
#pragma unroll 8
    for (int i = 0; i < 32; ++i) { const int kk = 2 * i + (lane >> 5); scr[kk * 33 + (lane & 31)] = W[(size_t)(k0 + kk) * ldw + scol + (lane & 31)]; }
    LDS_WAIT(); asm volatile("" ::: "memory");
    const int c = lane & 7;
#pragma unroll
    for (int j = 0; j < 4; ++j) { const int n = (lane >> 3) + 8 * j; const LAS float* s = scr + (8 * c) * 33 + n;
        v4u o; o.x = pk2(s[0 * 33], s[1 * 33]); o.y = pk2(s[2 * 33], s[3 * 33]); o.z = pk2(s[4 * 33], s[5 * 33]); o.w = pk2(s[6 * 33], s[7 * 33]);
        *(GAS v4u*)(WT + (size_t)(drow + n) * ldk + dk0 + 8 * c) = o; }
    LDS_WAIT(); asm volatile("" ::: "memory");
}

struct Args { const float* in[23]; float* out; unsigned char* ws; int ph_lo, ph_hi, one, pad; };

__global__ void __launch_bounds__(NWAVES * 64, 2) mega_fwd(Args args) {
    extern __shared__ __attribute__((aligned(16))) unsigned char lds[];
    LAS unsigned char* ldsL = (LAS unsigned char*)lds;
    volatile LAS unsigned* MISC = (volatile LAS unsigned*)(ldsL + MISC_OFF);
    const int tid = threadIdx.x, lane = tid & 63, wave = __builtin_amdgcn_readfirstlane(tid >> 6);
    const int G = gridDim.x; const int bx = blockIdx.x; const int vcu = (G % 8 == 0) ? (bx % 8) * (G / 8) + bx / 8 : bx;
    unsigned char* ws = args.ws;
    unsigned* ctl = (unsigned*)(ws + WS_CTL);
    const float* x = args.in[0]; const float* pin = args.in[1]; const float* norm_mix_g = args.in[2]; const float* w_in = args.in[3];
    const float* gmlp_ln_g = args.in[4]; const float* gmlp_ln_b = args.in[5]; const float* gmlp_w_s = args.in[6]; const float* gmlp_b_s = args.in[7];
    const float* fox_b_f = args.in[8]; const float* q_norm_g = args.in[9]; const float* k_norm_g = args.in[10];
    const float* w_branch_a = args.in[11]; const float* w_branch_b = args.in[12]; const float* w_out = args.in[13]; const float* norm_ffn_g = args.in[14];
    const float* w_up = args.in[15]; const float* conv_w = args.in[16]; const float* conv_b = args.in[17]; const float* w_down = args.in[18];
    const float* ple_proj = args.in[19]; const float* ple_norm_g = args.in[20]; const float* ple_gate_norm_g = args.in[21]; const float* w_ple_gate = args.in[22];
    float* out = args.out;
    float* Fb = (float*)(ws + WS_F); float* CUM = (float*)(ws + WS_CUM); bf16* WSB = (bf16*)(ws + WS_WSB);
    bf16* Z = (bf16*)(ws + WS_Z); bf16* Y = (bf16*)(ws + WS_Y); bf16* UP = (bf16*)(ws + WS_UP); bf16* EB = (bf16*)(ws + WS_E); bf16* A2 = (bf16*)(ws + WS_A2);
    bf16* WUP = (bf16*)(ws + WS_WUP); bf16* WDOWN = (bf16*)(ws + WS_WDOWN); bf16* WGATE = (bf16*)(ws + WS_WGATE); bf16* WPLE = (bf16*)(ws + WS_WPLE);
    bf16* PB = (bf16*)(ws + WS_PB); bf16* H = (bf16*)(ws + WS_H); bf16* WIN = (bf16*)(ws + WS_WIN); bf16* WAB = (bf16*)(ws + WS_WAB); bf16* WOUT = (bf16*)(ws + WS_WOUT);
    bf16* HM = (bf16*)(ws + WS_HM); bf16* OAB = (bf16*)out;
    float* SSQ1 = (float*)(ctl + CW_SSQ1); float* SSQ2 = (float*)(ctl + CW_SSQ2); float* SSQE = (float*)(ctl + CW_SSQE);

    for (int u = tid; u < (LDS_BYTES - LDSCTL_OFF) / 4; u += NWAVES * 64) ((LAS unsigned*)(ldsL + LDSCTL_OFF))[u] = 0u;
    __syncthreads();
    XcdBarrier bar; bar.bar = ctl + CW_BAR; bar.x = 0; bar.st = nullptr;
    if (args.one) bar = xcd_barrier_post(ctl + CW_BAR, MISC + 8);
    const int lo = args.ph_lo, hi = args.ph_hi;
#ifndef PH_MASK
#define PH_MASK 0x3ff
#endif
#define IN(k) ((((PH_MASK) >> (k)) & 1) && lo <= (k) && (k) < hi)
#define GRID_BAR(k) do { if (IN(k) && IN((k) + 1)) xcd_barrier(bar); } while (0)
    const int gw = vcu * NWAVES + wave, NGW = G * NWAVES;
    const int gt = vcu * (NWAVES * 64) + tid, NGT = G * NWAVES * 64;

    if (IN(0)) {
        { LAS float* wf = (LAS float*)(ldsL + P0_WF_OFF);
          for (int k = tid; k < DM; k += NWAVES * 64) { const f32x4 a = *(const f32x4*)(w_in + (size_t)k * INC + 5120), b = *(const f32x4*)(w_in + (size_t)k * INC + 5124);
              wf[0 * DM + k] = a[0]; wf[1 * DM + k] = a[1]; wf[2 * DM + k] = a[2]; wf[3 * DM + k] = a[3]; wf[4 * DM + k] = b[0]; wf[5 * DM + k] = b[1]; wf[6 * DM + k] = b[2]; wf[7 * DM + k] = b[3]; }
          __syncthreads(); }
        { const LAS float* wf = (const LAS float*)(ldsL + P0_WF_OFF);
          for (int m = gw; m < M; m += NGW) {
            const GAS f32x4* xr = (const GAS f32x4*)(x + (size_t)m * DM) + lane; f32x4 v[8]; float s = 0.f;
#pragma unroll
            for (int j = 0; j < 8; ++j) { v[j] = xr[64 * j]; s += (v[j].x * v[j].x + v[j].y * v[j].y) + (v[j].z * v[j].z + v[j].w * v[j].w); }
            const float rstd = 1.0f / sqrtf(wave_sum(s) * (1.0f / DM) + EPS);
            float fa[8];
#pragma unroll
            for (int f = 0; f < 8; ++f) fa[f] = 0.f;
            GAS unsigned long long* o8 = (GAS unsigned long long*)(H + (size_t)m * DM) + lane;
#pragma unroll
            for (int j = 0; j < 8; ++j) { const f32x4 g4 = *((const GAS f32x4*)norm_mix_g + lane + 64 * j); const f32x4 h4 = v[j] * rstd * g4;
                o8[64 * j] = (unsigned long long)pk2(h4.x, h4.y) | ((unsigned long long)pk2(h4.z, h4.w) << 32);
#pragma unroll
                for (int f = 0; f < 8; ++f) { const f32x4 w4 = *(const LAS f32x4*)(wf + f * DM + 256 * j + 4 * lane); fa[f] += (h4.x * w4.x + h4.y * w4.y) + (h4.z * w4.z + h4.w * w4.w); }
                asm volatile("" ::: "memory"); }
#pragma unroll
            for (int f = 0; f < 8; ++f) fa[f] = wave_sum(fa[f]);
            if (lane == 0) { *(f32x4*)(Fb + (size_t)m * 8) = (f32x4){fa[0], fa[1], fa[2], fa[3]}; *(f32x4*)(Fb + (size_t)m * 8 + 4) = (f32x4){fa[4], fa[5], fa[6], fa[7]}; }
          } }
        for (int i = gt; i < M * PLE / 8; i += NGT) { const f32x4 a = *(const f32x4*)(pin + (size_t)i * 8), b = *(const f32x4*)(pin + (size_t)i * 8 + 4);
            v4u o; o.x = pk2(a.x, a.y); o.y = pk2(a.z, a.w); o.z = pk2(b.x, b.y); o.w = pk2(b.z, b.w); *(v4u*)(PB + (size_t)i * 8) = o; }
        for (int i = gt; i < 8 * 128 * 128 / 8; i += NGT) { const int e = i * 8, t = (e >> 7) & 127, s0 = e & 127; const f32x4 a = *(const f32x4*)(gmlp_w_s + e), b = *(const f32x4*)(gmlp_w_s + e + 4);
            float w[8] = {a.x, a.y, a.z, a.w, b.x, b.y, b.z, b.w};
#pragma unroll
            for (int q = 0; q < 8; ++q) if (s0 + q > t) w[q] = 0.f;
            v4u o; o.x = pk2(w[0], w[1]); o.y = pk2(w[2], w[3]); o.z = pk2(w[4], w[5]); o.w = pk2(w[6], w[7]); *(v4u*)(WSB + e) = o; }
        __syncthreads();
        { LAS float* scr = (LAS float*)(ldsL + wave * 8448);
          constexpr int I1 = 32 * 160, I2 = 32 * 128, I3 = 16 * 64, I4 = 16 * 64, I5 = 32 * 64, I6 = 32 * 352, I7 = 88 * 64, I8 = 32 * 64, I9 = 4 * 64;
          constexpr int NITEMS = I1 + I2 + I3 + I4 + I5 + I6 + I7 + I8 + I9;
          for (int it = gw; it < NITEMS; it += NGW) {
            int r = it;
            if (r < I1) { const int kb = r / 160, nb = r % 160; p0_transpose_item(w_in, INC, 64 * kb, 32 * nb, WIN, DM, 32 * nb, 64 * kb, scr, lane); continue; } r -= I1;
            if (r < I2) { const int kb = r / 128, nb = r % 128; p0_transpose_item(w_in, INC, 64 * kb, 5128 + 32 * nb, WIN, DM, 5120 + 32 * nb, 64 * kb, scr, lane); continue; } r -= I2;
            if (r < I3) { const int kb = r / 64, nb = r % 64; p0_transpose_item(w_branch_a, DM, 64 * kb, 32 * nb, WAB, 2048, 32 * nb, 64 * kb, scr, lane); continue; } r -= I3;
            if (r < I4) { const int kb = r / 64, nb = r % 64; p0_transpose_item(w_branch_b, DM, 64 * kb, 32 * nb, WAB, 2048, 32 * nb, 1024 + 64 * kb, scr, lane); continue; } r -= I4;
            if (r < I5) { const int kb = r / 64, nb = r % 64; p0_transpose_item(w_out, DM, 64 * kb, 32 * nb, WOUT, DM, 32 * nb, 64 * kb, scr, lane); continue; } r -= I5;
            if (r < I6) { const int kb = r / 352, nb = r % 352; const int sc = 32 * nb; const int mm = sc < DFF ? sc : sc - DFF; const int drow = 256 * (mm >> 7) + (mm & 127) + (sc < DFF ? 0 : 128);
                          p0_transpose_item(w_up, NUP, 64 * kb, sc, WUP, DM, drow, 64 * kb, scr, lane); continue; } r -= I6;
            if (r < I7) { const int kb = r / 64, nb = r % 64; p0_transpose_item(w_down, DM, 64 * kb, 32 * nb, WDOWN, DFF, 32 * nb, 64 * kb, scr, lane); continue; } r -= I7;
            if (r < I8) { const int kb = r / 64, nb = r % 64; p0_transpose_item(w_ple_gate, DM, 64 * kb, 32 * nb, WGATE, DM, 32 * nb, 64 * kb, scr, lane); continue; } r -= I8;
            { const int kb = r / 64, nb = r % 64; p0_transpose_item(ple_proj, DM, 64 * kb, 32 * nb, WPLE, PLE, 32 * nb, 64 * kb, scr, lane); }
          } }
        __syncthreads();
    }
    GRID_BAR(0);

    if (IN(1)) {
        pg8::Gemm g{H, WIN, M, NZ, DM}; pg8::StaticOrder S; S.init(M, NZ, G, bx);
        pg8::EpiZ E{Z};
        pg8::gemm_phase<pg8::EpiZ, pg8::StaticOrder, true, true>(ldsL, g, S, E);
    }
    GRID_BAR(1);

    if (IN(2)) {
        if (vcu < 32) {
            const int bh = vcu, b = bh >> 3, h = bh & 7; const float bf = fox_b_f[h];
            LAS float* wsum = (LAS float*)ldsL;
            float v[4];
#pragma unroll
            for (int i = 0; i < 4; ++i) { const float xx = Fb[(size_t)(b * SEQ + 4 * tid + i) * 8 + h] + bf; v[i] = fminf(xx, 0.f) - log1pf(expf(-fabsf(xx))); }
            v[1] += v[0]; v[2] += v[1]; v[3] += v[2];
            const float tot = v[3]; float incl = tot;
#pragma unroll
            for (int o = 1; o < 64; o <<= 1) { const float t = __shfl_up(incl, o); if (lane >= o) incl += t; }
            if (lane == 63) wsum[wave] = incl;
            __syncthreads();
            float off = incl - tot;
            for (int w = 0; w < wave; ++w) off += wsum[w];
            const float isc = 11.313708498984761f;
            *(f32x4*)(CUM + (size_t)bh * SEQ + 4 * tid) = (f32x4){(v[0] + off) * isc, (v[1] + off) * isc, (v[2] + off) * isc, (v[3] + off) * isc};
            __syncthreads();
        }
        for (int m = gw; m < M; m += NGW) {
            bf16* zr = Z + (size_t)m * NZ;
            { v4u raw[2]; float xv[16]; float s = 0.f;
#pragma unroll
              for (int j = 0; j < 2; ++j) { raw[j] = *(const v4u*)(zr + 1024 + 8 * lane + 512 * j);
                  xv[8 * j + 0] = bflo(raw[j].x); xv[8 * j + 1] = bfhi(raw[j].x); xv[8 * j + 2] = bflo(raw[j].y); xv[8 * j + 3] = bfhi(raw[j].y);
                  xv[8 * j + 4] = bflo(raw[j].z); xv[8 * j + 5] = bfhi(raw[j].z); xv[8 * j + 6] = bflo(raw[j].w); xv[8 * j + 7] = bfhi(raw[j].w); }
#pragma unroll
              for (int i = 0; i < 16; ++i) s += xv[i];
              const float mean = wave_sum(s) * (1.0f / 1024.0f); float s2 = 0.f;
#pragma unroll
              for (int i = 0; i < 16; ++i) { xv[i] -= mean; s2 += xv[i] * xv[i]; }
              const float rstd = 1.0f / sqrtf(wave_sum(s2) * (1.0f / 1024.0f) + EPS);
#pragma unroll
              for (int j = 0; j < 2; ++j) { const int c = 8 * lane + 512 * j; const f32x4 g0 = *(const f32x4*)(gmlp_ln_g + c), g1 = *(const f32x4*)(gmlp_ln_g + c + 4), b0 = *(const f32x4*)(gmlp_ln_b + c), b1 = *(const f32x4*)(gmlp_ln_b + c + 4);
                  v4u o; o.x = pk2(xv[8 * j + 0] * rstd * g0.x + b0.x, xv[8 * j + 1] * rstd * g0.y + b0.y); o.y = pk2(xv[8 * j + 2] * rstd * g0.z + b0.z, xv[8 * j + 3] * rstd * g0.w + b0.w);
                  o.z = pk2(xv[8 * j + 4] * rstd * g1.x + b1.x, xv[8 * j + 5] * rstd * g1.y + b1.y); o.w = pk2(xv[8 * j + 6] * rstd * g1.z + b1.z, xv[8 * j + 7] * rstd * g1.w + b1.w);
                  *(v4u*)(zr + 1024 + c) = o; } }
#pragma unroll
            for (int qk = 0; qk < 2; ++qk) { const float* gn = qk ? k_norm_g : q_norm_g; bf16* base = zr + 2048 + 1024 * qk;
                const int d0 = (8 * lane) & 127; const f32x4 g0 = *(const f32x4*)(gn + d0), g1 = *(const f32x4*)(gn + d0 + 4);
#pragma unroll
                for (int j = 0; j < 2; ++j) { const v4u raw = *(const v4u*)(base + 8 * lane + 512 * j);
                    float xv[8] = {bflo(raw.x), bfhi(raw.x), bflo(raw.y), bfhi(raw.y), bflo(raw.z), bfhi(raw.z), bflo(raw.w), bfhi(raw.w)};
                    float s = 0.f;
#pragma unroll
                    for (int i = 0; i < 8; ++i) s += xv[i] * xv[i];
                    s += __shfl_xor(s, 1); s += __shfl_xor(s, 2); s += __shfl_xor(s, 4); s += __shfl_xor(s, 8);
                    const float r = 1.0f / sqrtf(s * (1.0f / 128.0f) + EPS);
                    v4u o; o.x = pk2(xv[0] * r * g0.x, xv[1] * r * g0.y); o.y = pk2(xv[2] * r * g0.z, xv[3] * r * g0.w); o.z = pk2(xv[4] * r * g1.x, xv[5] * r * g1.y); o.w = pk2(xv[6] * r * g1.z, xv[7] * r * g1.w);
                    *(v4u*)(base + 8 * lane + 512 * j) = o; } }
        }
    }
    GRID_BAR(2);

    if (IN(3)) {
        for (int item = vcu; item < 256; item += G) {
            const int bh = item >> 3, qb = item & 7, b = bh >> 3, h = bh & 7;
            const size_t rowb = (size_t)b * SEQ;
            fox::BlockRef cur; cur.P0 = qb * 256;
            cur.Q = Z + (rowb + cur.P0) * NZ + 2048 + h * 128; cur.K = Z + rowb * NZ + 3072 + h * 128; cur.V = Z + rowb * NZ + 4096 + h * 128;
            cur.O = OAB + (rowb + cur.P0) * 2048 + 1024 + h * 128;
            float* cumL = (float*)(lds + fox::LDS_CUM);
            { const int nk = cur.P0 + 256; if (4 * tid < nk) *(f32x4*)(cumL + 4 * tid) = -*(const f32x4*)(CUM + (size_t)bh * SEQ + 4 * tid); }
            fox::Seam S;
            fox::fox_prime(cur, (char*)lds, S);
            fox::fox_block(cur, cur, (char*)lds, S, cumL);
        }
        for (;;) {
            if (tid == 0) MISC[16] = atomicAdd(ctl + CW_GQ, 1u);
            __syncthreads();
            const unsigned idx = MISC[16];
            __syncthreads();
            if (idx >= 512u) break;
            fox::gmlp_unit((char*)lds, (int)idx, Z, WSB, gmlp_b_s, OAB);
        }
    }
    GRID_BAR(3);

    if (IN(4)) {
        pg8::Gemm g{OAB, WAB, M, DM, 2048}; pg8::StaticOrder S; S.init(M, DM, G, bx);
        pg8::EpiY E{Z, Y};
        pg8::gemm_phase<pg8::EpiY, pg8::StaticOrder, true, true>(ldsL, g, S, E);
    }
    GRID_BAR(4);

    if (IN(5)) {
        pg8::Gemm g{Y, WOUT, M, DM, DM}; pg8::StaticOrder S; S.init(M, DM, G, bx);
        pg8::EpiRes E{x, out, H, norm_ffn_g, SSQ1};
        pg8::gemm_phase<pg8::EpiRes, pg8::StaticOrder, true, true>(ldsL, g, S, E);
    }
    GRID_BAR(5);

    if (IN(6)) {
        pg8::Gemm g{H, WUP, M, NUP, DM}; pg8::StaticOrder S; S.init(M, NUP, G, bx);
        pg8::EpiUp E{UP, NUP, SSQ1};
        pg8::gemm_phase<pg8::EpiUp, pg8::StaticOrder, true, true>(ldsL, g, S, E);
    }
    GRID_BAR(6);

    if (IN(7)) {
        constexpr int NCH = DFF / 8, RB = 16;
        for (int it = gt; it < (M / RB) * NCH; it += NGT) {
            const int rb = it / NCH, ch = it - rb * NCH, c = ch * 8, colA = 256 * (c >> 7) + (c & 127);
            const int t0 = rb * RB;
            float w0[8], w1[8], w2[8], cb[8];
            { const f32x4 a = *(const f32x4*)(conv_w + c), b = *(const f32x4*)(conv_w + c + 4); w0[0] = a.x; w0[1] = a.y; w0[2] = a.z; w0[3] = a.w; w0[4] = b.x; w0[5] = b.y; w0[6] = b.z; w0[7] = b.w; }
            { const f32x4 a = *(const f32x4*)(conv_w + DFF + c), b = *(const f32x4*)(conv_w + DFF + c + 4); w1[0] = a.x; w1[1] = a.y; w1[2] = a.z; w1[3] = a.w; w1[4] = b.x; w1[5] = b.y; w1[6] = b.z; w1[7] = b.w; }
            { const f32x4 a = *(const f32x4*)(conv_w + 2 * DFF + c), b = *(const f32x4*)(conv_w + 2 * DFF + c + 4); w2[0] = a.x; w2[1] = a.y; w2[2] = a.z; w2[3] = a.w; w2[4] = b.x; w2[5] = b.y; w2[6] = b.z; w2[7] = b.w; }
            { const f32x4 a = *(const f32x4*)(conv_b + c), b = *(const f32x4*)(conv_b + c + 4); cb[0] = a.x; cb[1] = a.y; cb[2] = a.z; cb[3] = a.w; cb[4] = b.x; cb[5] = b.y; cb[6] = b.z; cb[7] = b.w; }
            float am2[8], am1[8];
            if ((t0 & (SEQ - 1)) == 0) {
#pragma unroll
                for (int q = 0; q < 8; ++q) { am2[q] = 0.f; am1[q] = 0.f; }
            } else {
                const v4u r2 = *(const v4u*)(UP + (size_t)(t0 - 2) * NUP + colA), r1 = *(const v4u*)(UP + (size_t)(t0 - 1) * NUP + colA);
                am2[0] = bflo(r2.x); am2[1] = bfhi(r2.x); am2[2] = bflo(r2.y); am2[3] = bfhi(r2.y); am2[4] = bflo(r2.z); am2[5] = bfhi(r2.z); am2[6] = bflo(r2.w); am2[7] = bfhi(r2.w);
                am1[0] = bflo(r1.x); am1[1] = bfhi(r1.x); am1[2] = bflo(r1.y); am1[3] = bfhi(r1.y); am1[4] = bflo(r1.z); am1[5] = bfhi(r1.z); am1[6] = bflo(r1.w); am1[7] = bfhi(r1.w);
            }
#pragma unroll 4
            for (int i = 0; i < RB; ++i) {
                const v4u ra = *(const v4u*)(UP + (size_t)(t0 + i) * NUP + colA), rbv = *(const v4u*)(UP + (size_t)(t0 + i) * NUP + colA + 128);
                float a[8] = {bflo(ra.x), bfhi(ra.x), bflo(ra.y), bfhi(ra.y), bflo(ra.z), bfhi(ra.z), bflo(ra.w), bfhi(ra.w)};
                float bb[8] = {bflo(rbv.x), bfhi(rbv.x), bflo(rbv.y), bfhi(rbv.y), bflo(rbv.z), bfhi(rbv.z), bflo(rbv.w), bfhi(rbv.w)};
                float o[8];
#pragma unroll
                for (int q = 0; q < 8; ++q) { const float cv = cb[q] + w0[q] * am2[q] + w1[q] * am1[q] + w2[q] * a[q];
                    const float inner = cv + 0.044715f * cv * cv * cv;
                    const float ge = cv * __builtin_amdgcn_rcpf(1.0f + __builtin_amdgcn_exp2f(-2.3022081986f * inner));
                    o[q] = ge * bb[q]; am2[q] = am1[q]; am1[q] = a[q]; }
                v4u ov; ov.x = pk2(o[0], o[1]); ov.y = pk2(o[2], o[3]); ov.z = pk2(o[4], o[5]); ov.w = pk2(o[6], o[7]);
                *(v4u*)(HM + (size_t)(t0 + i) * DFF + c) = ov;
            }
        }
    }
    GRID_BAR(7);

    if (IN(8)) {
        { pg8::Gemm g{HM, WDOWN, M, DM, DFF}; pg8::StaticOrder S; S.init(M, DM, G, bx);
          pg8::EpiRes E{out, out, A2, ple_gate_norm_g, SSQ2};
          pg8::gemm_phase<pg8::EpiRes, pg8::StaticOrder, true, true>(ldsL, g, S, E); }
        { pg8::Gemm g{PB, WPLE, M, DM, PLE}; pg8::StaticOrder S; S.init(M, DM, G, bx);
          pg8::EpiE E{EB, SSQE};
          pg8::gemm_phase<pg8::EpiE, pg8::StaticOrder, true, true>(ldsL, g, S, E); }
    }
    GRID_BAR(8);

    if (IN(9)) {
        pg8::Gemm g{A2, WGATE, M, DM, DM}; pg8::StaticOrder S; S.init(M, DM, G, bx);
        pg8::EpiFinal E{out, EB, ple_norm_g, SSQ2, SSQE};
        pg8::gemm_phase<pg8::EpiFinal, pg8::StaticOrder, true, true>(ldsL, g, S, E);
    }
#undef IN
#undef GRID_BAR
}

extern "C" void kernel_launch(void* const* d_in, const int* in_sizes, int n_in, void* d_out, int out_size, void* d_ws, size_t ws_size, hipStream_t stream) {
    static int grid = 0;
    if (grid == 0) {
        if (n_in != 23 || out_size != M * DM || ws_size < WS_END) { fprintf(stderr, "kernel_launch: unexpected shapes (n_in %d, out %d, ws %zu)\n", n_in, out_size, ws_size); grid = -1; return; }
        int dev = 0, cus = 0, per_cu = 0;
        if (hipGetDevice(&dev) != hipSuccess || hipDeviceGetAttribute(&cus, hipDeviceAttributeMultiprocessorCount, dev) != hipSuccess) { grid = -1; return; }
        if (hipFuncSetAttribute((const void*)mega_fwd, hipFuncAttributeMaxDynamicSharedMemorySize, LDS_BYTES) != hipSuccess) { fprintf(stderr, "kernel_launch: hipFuncSetAttribute failed\n"); grid = -1; return; }
        if (hipOccupancyMaxActiveBlocksPerMultiprocessor(&per_cu, (const void*)mega_fwd, NWAVES * 64, LDS_BYTES) != hipSuccess || per_cu < 1) { fprintf(stderr, "kernel_launch: occupancy query says %d\n", per_cu); (void)hipGetLastError(); per_cu = 1; }
        grid = cus * (per_cu < 1 ? 1 : 1);
    }
    if (grid < 0) return;
    (void)hipMemsetAsync((char*)d_ws + WS_CTL, 0, CTL_ZERO_BYTES, stream);
    Args a{};
    for (int i = 0; i < 23; ++i) a.in[i] = (const float*)d_in[i];
    a.out = (float*)d_out; a.ws = (unsigned char*)d_ws;
    if (N_LAUNCHES == 1) {
        a.ph_lo = 0; a.ph_hi = N_PHASES; a.one = 1;
        void* kargs[] = {&a};
        hipError_t e = hipLaunchCooperativeKernel((const void*)mega_fwd, dim3(grid), dim3(NWAVES * 64), kargs, LDS_BYTES, stream);
        if (e != hipSuccess) fprintf(stderr, "kernel_launch: cooperative launch failed: %s (grid %d)\n", hipGetErrorString(e), grid);
    } else {
        for (int p = 0; p < N_PHASES; ++p) { a.ph_lo = p; a.ph_hi = p + 1; a.one = 0;
            hipLaunchKernelGGL(mega_fwd, dim3(grid), dim3(NWAVES * 64), LDS_BYTES, stream, a); }
    }
}
```

```cpp
#include <hip/hip_runtime.h>
#include <cstdio>
#include <cstdint>

#ifndef MK_N_LAUNCHES
#define MK_N_LAUNCHES 1
#endif

namespace pg8 {
#define PG8_LAS __attribute__((address_space(3)))
typedef unsigned short bf16_t;
typedef short bf16x8 __attribute__((ext_vector_type(8)));
typedef float f32x4 __attribute__((ext_vector_type(4)));
typedef float f32x2 __attribute__((ext_vector_type(2)));
typedef unsigned u32x4 __attribute__((ext_vector_type(4)));
constexpr int BM = 256, BK = 64, HALF = 128, HTB = HALF * BK * 2, STAGE_BYTES = 8 * HTB, NXCD = 8, WGM = 8;

__host__ __device__ __forceinline__ int lds_byte(int r, int c) { const int st = (r >> 4) * 2 + (c >> 5), rr = r & 15, cc = c & 31, ob = rr * 64 + cc * 2; return st * 1024 + (ob ^ (((ob >> 9) & 1) << 5)); }
__host__ __device__ __forceinline__ void stage_rc(int b, int& R, int& C) { const int st = b / 1024, sb = b % 1024, swz = sb ^ (((sb >> 9) & 1) << 5); R = (st >> 1) * 16 + swz / 64; C = (st & 1) * 32 + (swz % 64) / 2; }
__host__ __device__ __forceinline__ int perm32(int rho) { const int n = rho >> 4, i = rho & 15; return 8 * (i >> 2) + 4 * n + (i & 3); }

struct Unit { int pm, pn; };
struct Gemm { const bf16_t* A; const bf16_t* Bt; int M, N, K; };

struct StaticOrder {
    int nM, nN, nwg, G, c;
    __host__ __device__ __forceinline__ void init(int M, int N, int G_, int c_) { nM = M / BM; nN = N / BM; nwg = nM * nN; G = G_; c = c_; }
    __host__ __device__ __forceinline__ bool next(int i, Unit& u) const {
        const long L = (long)i * G + c; if (L >= nwg) return false;
        int wgid = (int)L; { const int q = nwg / NXCD, r = nwg % NXCD, xcd = wgid % NXCD, off = wgid / NXCD; wgid = (xcd < r ? xcd * (q + 1) : r * (q + 1) + (xcd - r) * q) + off; }
        const int nig = WGM * nN, gid = wgid / nig, fm = gid * WGM, gsz = (nM - fm) < WGM ? (nM - fm) : WGM;
        u.pm = fm + ((wgid % nig) % gsz); u.pn = (wgid % nig) / gsz; return true;
    }
    __device__ __forceinline__ void a_ready(const Unit&) const {}
    __device__ __forceinline__ void done(const Unit&) const {}
};

__device__ __forceinline__ unsigned cvt_pk_bf16(float lo, float hi) { unsigned r; asm volatile("v_cvt_pk_bf16_f32 %0, %1, %2" : "=v"(r) : "v"(lo), "v"(hi)); return r; }
__device__ __forceinline__ float xsum_fq(float x) {
    { auto r = __builtin_amdgcn_permlane16_swap(__float_as_uint(x), __float_as_uint(x), false, false); x = __uint_as_float(r[0]) + __uint_as_float(r[1]); }
    { auto r = __builtin_amdgcn_permlane32_swap(__float_as_uint(x), __float_as_uint(x), false, false); x = __uint_as_float(r[0]) + __uint_as_float(r[1]); }
    return x;
}
__device__ __forceinline__ float bf_lo(unsigned w) { return __uint_as_float(w << 16); }
__device__ __forceinline__ float bf_hi(unsigned w) { return __uint_as_float(w & 0xffff0000u); }
__device__ __forceinline__ f32x2 gelu_pk(f32x2 v) {
    const f32x2 av = __builtin_elementwise_abs(v), d = av * 0.2316418882f + 1.0f;
    f32x2 t; t.x = __builtin_amdgcn_rcpf(d.x); t.y = __builtin_amdgcn_rcpf(d.y);
    f32x2 q = t * 0.5307027145f + (-0.7265760135f); q = q * t + 0.7107068705f; q = q * t + (-0.142248368f); q = q * t + 0.127414796f; q = q * t;
    const f32x2 s = (v * v) * (-0.72134752044f);
    f32x2 e; e.x = __builtin_amdgcn_exp2f(s.x); e.y = __builtin_amdgcn_exp2f(s.y);
    const f32x2 m = v * (q * e), r = v - m;
    f32x2 o; o.x = v.x < 0.f ? m.x : r.x; o.y = v.y < 0.f ? m.y : r.y; return o;
}
__device__ __forceinline__ float sigmoid_f(float x) { return __builtin_amdgcn_rcpf(1.0f + __builtin_amdgcn_exp2f(-1.4426950408889634f * x)); }
__device__ __forceinline__ f32x4 gelu4(f32x4 v) { f32x2 a = gelu_pk((f32x2){v[0], v[1]}), b = gelu_pk((f32x2){v[2], v[3]}); return (f32x4){a.x, a.y, b.x, b.y}; }
__device__ __forceinline__ f32x4 sigm4(f32x4 v) { return (f32x4){sigmoid_f(v[0]), sigmoid_f(v[1]), sigmoid_f(v[2]), sigmoid_f(v[3])}; }
__device__ __forceinline__ u32x4 pack8(f32x4 a, f32x4 b) { u32x4 w; w.x = cvt_pk_bf16(a[0], a[1]); w.y = cvt_pk_bf16(a[2], a[3]); w.z = cvt_pk_bf16(b[0], b[1]); w.w = cvt_pk_bf16(b[2], b[3]); return w; }

typedef f32x4 Acc[2][2][4][2];
#define EPI_LOOP_ROWS for (int ai = 0; ai < 2; ++ai) _Pragma("unroll") for (int m = 0; m < 4; ++m)

constexpr int ZLD = 9216;
struct EpiZ {
    static constexpr bool PERM = true, AFTER_DRAIN = false, MIDK = false;
    bf16_t* Z; float* vs1; float* vs2; const float* gq; const float* gk; PG8_LAS float* red;
    __device__ __forceinline__ void mid(Acc&, const Unit&, int, int, int, int) const {}
    __device__ __forceinline__ void operator()(const Acc& acc, const Unit& u, int wr, int wc, int fr, int fq) const {
        const int mode = u.pn < 8 ? 1 : (u.pn < 20 ? 0 : 2); const bool isv = (u.pn >= 4 && u.pn < 8);
        const int row0 = u.pm * BM + wr * 64 + fr, col0 = u.pn * BM + wc * 32 + 8 * fq;
        if (u.pn >= 8 && u.pn < 16) {
            const float* gn = u.pn < 12 ? gq : gk;
            const f32x4 g0 = *(const f32x4*)(gn + wc * 32 + 8 * fq), g1 = *(const f32x4*)(gn + wc * 32 + 8 * fq + 4);
#pragma unroll
            EPI_LOOP_ROWS {
#pragma unroll
                for (int bj = 0; bj < 2; ++bj) { const f32x4 v0 = acc[ai][bj][m][0], v1 = acc[ai][bj][m][1];
                    float q2 = (v0[0] * v0[0] + v0[1] * v0[1]) + (v0[2] * v0[2] + v0[3] * v0[3]) + (v1[0] * v1[0] + v1[1] * v1[1]) + (v1[2] * v1[2] + v1[3] * v1[3]);
                    q2 = xsum_fq(q2);
                    if (fq == 0) red[(ai * HALF + wr * 64 + m * 16 + fr) * 8 + bj * 4 + wc] = q2; } }
            asm volatile("s_waitcnt lgkmcnt(0)" ::: "memory"); __builtin_amdgcn_s_barrier(); asm volatile("" ::: "memory");
#pragma unroll
            EPI_LOOP_ROWS { bf16_t* rowp = Z + (size_t)(row0 + ai * HALF + m * 16) * ZLD + col0;
#pragma unroll
                for (int bj = 0; bj < 2; ++bj) { const f32x4 p = *(const PG8_LAS f32x4*)(red + (ai * HALF + wr * 64 + m * 16 + fr) * 8 + bj * 4);
                    const float r = 1.0f / sqrtf(((p[0] + p[1]) + (p[2] + p[3])) * (1.0f / 128.0f) + 1e-6f);
                    *(u32x4*)(rowp + bj * HALF) = pack8(acc[ai][bj][m][0] * r * g0, acc[ai][bj][m][1] * r * g1); } }
            return;
        }
        if (mode == 2) {
#pragma unroll
            EPI_LOOP_ROWS { bf16_t* rowp = Z + (size_t)(row0 + ai * HALF + m * 16) * ZLD + col0;
                f32x4 rt[2], sb[2];
#pragma unroll
                for (int n = 0; n < 2; ++n) { const f32x4 ga = acc[ai][0][m][n] * (-1.4426950408889634f), gb = acc[ai][1][m][n] * (-1.4426950408889634f);
#pragma unroll
                    for (int i = 0; i < 4; ++i) { const float da = 1.0f + __builtin_amdgcn_exp2f(ga[i]), db = 1.0f + __builtin_amdgcn_exp2f(gb[i]);
                        sb[n][i] = __builtin_amdgcn_rcpf(db); rt[n][i] = db * __builtin_amdgcn_rcpf(da); } }
                *(u32x4*)rowp = pack8(rt[0], rt[1]); *(u32x4*)(rowp + HALF) = pack8(sb[0], sb[1]); }
            return;
        }
#pragma unroll
        EPI_LOOP_ROWS { bf16_t* rowp = Z + (size_t)(row0 + ai * HALF + m * 16) * ZLD + col0;
            float s1 = 0.f, s2 = 0.f;
#pragma unroll
            for (int bj = 0; bj < 2; ++bj) { f32x4 v0 = acc[ai][bj][m][0], v1 = acc[ai][bj][m][1];
                if (mode == 1) { v0 = gelu4(v0); v1 = gelu4(v1); } else if (mode == 2) { v0 = sigm4(v0); v1 = sigm4(v1); }
                if (isv) { s1 += (v0[0] + v0[1]) + (v0[2] + v0[3]) + (v1[0] + v1[1]) + (v1[2] + v1[3]);
                           s2 += (v0[0] * v0[0] + v0[1] * v0[1]) + (v0[2] * v0[2] + v0[3] * v0[3]) + (v1[0] * v1[0] + v1[1] * v1[1]) + (v1[2] * v1[2] + v1[3] * v1[3]); }
                *(u32x4*)(rowp + bj * HALF) = pack8(v0, v1); }
            if (isv) { s1 = xsum_fq(s1); s2 = xsum_fq(s2);
                       if (fq == 0) { atomicAdd(vs1 + row0 + ai * HALF + m * 16, s1); atomicAdd(vs2 + row0 + ai * HALF + m * 16, s2); } } }
    }
};
struct EpiY {
    static constexpr bool PERM = true, AFTER_DRAIN = false, MIDK = true;
    const bf16_t* Z; bf16_t* Y;
    __device__ __forceinline__ void mid(Acc& acc, const Unit& u, int wr, int wc, int fr, int fq) const {
        int opq; asm volatile("v_mov_b32 %0, 0" : "=v"(opq));
        const int row0 = u.pm * BM + wr * 64 + fr + opq, gc0 = 5120 + u.pn * 512 + wc * 32 + 8 * fq;
#pragma unroll
        EPI_LOOP_ROWS { const bf16_t* rowp = Z + (size_t)(row0 + ai * HALF + m * 16) * ZLD + gc0;
#pragma unroll
            for (int bj = 0; bj < 2; ++bj) { const u32x4 a = *(const u32x4*)(rowp + bj * 256);
                acc[ai][bj][m][0] *= (f32x4){bf_lo(a.x), bf_hi(a.x), bf_lo(a.y), bf_hi(a.y)}; acc[ai][bj][m][1] *= (f32x4){bf_lo(a.z), bf_hi(a.z), bf_lo(a.w), bf_hi(a.w)}; }
            if (m == 3) asm volatile("" ::: "memory"); }
    }
    __device__ __forceinline__ void operator()(const Acc& acc, const Unit& u, int wr, int wc, int fr, int fq) const {
        int opq; asm volatile("v_mov_b32 %0, 0" : "=v"(opq));
        const int row0 = u.pm * BM + wr * 64 + fr + opq, col0 = u.pn * BM + wc * 32 + 8 * fq, gc0 = 5120 + u.pn * 512 + wc * 32 + 8 * fq + 128;
#pragma unroll
        EPI_LOOP_ROWS { const int row = row0 + ai * HALF + m * 16; const bf16_t* rowp = Z + (size_t)row * ZLD + gc0;
#pragma unroll
            for (int bj = 0; bj < 2; ++bj) { const u32x4 b = *(const u32x4*)(rowp + bj * 256);
                const f32x4 s0 = (f32x4){bf_lo(b.x), bf_hi(b.x), bf_lo(b.y), bf_hi(b.y)}, s1 = (f32x4){bf_lo(b.z), bf_hi(b.z), bf_lo(b.w), bf_hi(b.w)};
                *(u32x4*)(Y + (size_t)row * 2048 + col0 + bj * HALF) = pack8(acc[ai][bj][m][0] * s0, acc[ai][bj][m][1] * s1); }
            if (m & 1) asm volatile("" ::: "memory"); }
    }
};
template <bool BASE_F32> struct EpiRes {
    static constexpr bool PERM = true, AFTER_DRAIN = false, MIDK = false;
    const void* base; bf16_t* xn; float* ssq;
    __device__ __forceinline__ void mid(Acc&, const Unit&, int, int, int, int) const {}
    __device__ __forceinline__ void operator()(const Acc& acc, const Unit& u, int wr, int wc, int fr, int fq) const {
        const int row0 = u.pm * BM + wr * 64 + fr, col0 = u.pn * BM + wc * 32 + 8 * fq;
#pragma unroll
        EPI_LOOP_ROWS { const int row = row0 + ai * HALF + m * 16; const size_t off = (size_t)row * 2048 + col0; float s = 0.f;
#pragma unroll
            for (int bj = 0; bj < 2; ++bj) { f32x4 b0, b1;
                if (BASE_F32) { b0 = *(const f32x4*)((const float*)base + off + bj * HALF); b1 = *(const f32x4*)((const float*)base + off + bj * HALF + 4); }
                else { const u32x4 w = *(const u32x4*)((const bf16_t*)base + off + bj * HALF); b0 = (f32x4){bf_lo(w.x), bf_hi(w.x), bf_lo(w.y), bf_hi(w.y)}; b1 = (f32x4){bf_lo(w.z), bf_hi(w.z), bf_lo(w.w), bf_hi(w.w)}; }
                const f32x4 x0 = b0 + acc[ai][bj][m][0], x1 = b1 + acc[ai][bj][m][1];
                s += (x0[0] * x0[0] + x0[1] * x0[1]) + (x0[2] * x0[2] + x0[3] * x0[3]) + (x1[0] * x1[0] + x1[1] * x1[1]) + (x1[2] * x1[2] + x1[3] * x1[3]);
                *(u32x4*)(xn + off + bj * HALF) = pack8(x0, x1); }
            s = xsum_fq(s);
            if (fq == 0) atomicAdd(ssq + row, s); }
    }
};
struct EpiUpConv {
    static constexpr bool PERM = true, AFTER_DRAIN = false, MIDK = false;
    bf16_t* HM; const float* ssq; const float* cw; const float* cb; float* HALO; float* FA; float* FB; PG8_LAS float* hl;
    __device__ __forceinline__ void mid(Acc&, const Unit&, int, int, int, int) const {}
    __device__ __forceinline__ static float gelu_t(float cv) { const float inner = cv + 0.044715f * cv * cv * cv; return cv * __builtin_amdgcn_rcpf(1.0f + __builtin_amdgcn_exp2f(-2.3022081986f * inner)); }
    __device__ __forceinline__ void operator()(const Acc& acc, const Unit& u, int wr, int wc, int fr, int fq) const {
        int opq; asm volatile("v_mov_b32 %0, 0" : "=v"(opq));
        const int lane = (int)(threadIdx.x & 63);
        const int cl = wc * 32 + 8 * fq, c0 = u.pn * 128 + cl + opq;
        const int rowg = u.pm * BM + wr * 64 + fr;
        float rr[2][4];
#pragma unroll
        for (int ai = 0; ai < 2; ++ai)
#pragma unroll
            for (int m = 0; m < 4; ++m) rr[ai][m] = 1.0f / sqrtf(ssq[rowg + ai * HALF + m * 16] * (1.0f / 2048.0f) + 1e-6f);
#pragma unroll
        for (int ai = 0; ai < 2; ++ai) if (fr >= 14) { const float r = rr[ai][3]; const f32x4 x0 = acc[ai][0][3][0] * r, x1 = acc[ai][0][3][1] * r;
            PG8_LAS float* d = hl + ((2 * ai + wr) * 2 + (fr - 14)) * 128 + cl; *(PG8_LAS f32x4*)d = x0; *(PG8_LAS f32x4*)(d + 4) = x1;
            if (ai == 1 && wr == 1) { float* gp = HALO + (size_t)(u.pm * 2 + (fr - 14)) * 5632 + c0; *(f32x4*)gp = x0; *(f32x4*)(gp + 4) = x1; } }
        if (wr == 0 && fr < 2) { const float r = rr[0][0]; float* ga = FA + (size_t)(u.pm * 2 + fr) * 5632 + c0; float* gb = FB + (size_t)(u.pm * 2 + fr) * 5632 + c0;
            *(f32x4*)ga = acc[0][0][0][0] * r; *(f32x4*)(ga + 4) = acc[0][0][0][1] * r; *(f32x4*)gb = acc[0][1][0][0] * r; *(f32x4*)(gb + 4) = acc[0][1][0][1] * r; }
        f32x2 w0[4], w1[4], w2[4], cbv[4];
        { const f32x4 a = *(const f32x4*)(cw + c0), b = *(const f32x4*)(cw + c0 + 4); w0[0] = (f32x2){a[0], a[1]}; w0[1] = (f32x2){a[2], a[3]}; w0[2] = (f32x2){b[0], b[1]}; w0[3] = (f32x2){b[2], b[3]}; }
        { const f32x4 a = *(const f32x4*)(cw + 5632 + c0), b = *(const f32x4*)(cw + 5632 + c0 + 4); w1[0] = (f32x2){a[0], a[1]}; w1[1] = (f32x2){a[2], a[3]}; w1[2] = (f32x2){b[0], b[1]}; w1[3] = (f32x2){b[2], b[3]}; }
        { const f32x4 a = *(const f32x4*)(cw + 11264 + c0), b = *(const f32x4*)(cw + 11264 + c0 + 4); w2[0] = (f32x2){a[0], a[1]}; w2[1] = (f32x2){a[2], a[3]}; w2[2] = (f32x2){b[0], b[1]}; w2[3] = (f32x2){b[2], b[3]}; }
        { const f32x4 a = *(const f32x4*)(cb + c0), b = *(const f32x4*)(cb + c0 + 4); cbv[0] = (f32x2){a[0], a[1]}; cbv[1] = (f32x2){a[2], a[3]}; cbv[2] = (f32x2){b[0], b[1]}; cbv[3] = (f32x2){b[2], b[3]}; }
        asm volatile("s_waitcnt lgkmcnt(0)" ::: "memory"); __builtin_amdgcn_s_barrier(); asm volatile("" ::: "memory");
        const bool f15 = fr == 15, f14 = fr >= 14;
#pragma unroll
        for (int ai = 0; ai < 2; ++ai) {
            f32x2 xp[4];
            { const int g = 2 * ai + wr;
              if (g > 0 && fr >= 14) { const PG8_LAS float* d = hl + ((g - 1) * 2 + (fr - 14)) * 128 + cl; const f32x4 h0 = *(const PG8_LAS f32x4*)d, h1 = *(const PG8_LAS f32x4*)(d + 4);
                  xp[0] = (f32x2){h0[0], h0[1]}; xp[1] = (f32x2){h0[2], h0[3]}; xp[2] = (f32x2){h1[0], h1[1]}; xp[3] = (f32x2){h1[2], h1[3]}; }
              else {
#pragma unroll
                  for (int j = 0; j < 4; ++j) xp[j] = (f32x2){0.f, 0.f}; } }
#pragma unroll
            for (int m = 0; m < 4; ++m) { const float r = rr[ai][m]; const int row = rowg + ai * HALF + m * 16;
                f32x2 o[4];
#pragma unroll
                for (int j = 0; j < 4; ++j) {
                    const f32x4 av = acc[ai][0][m][j >> 1], bv = acc[ai][1][m][j >> 1];
                    const f32x2 x = (f32x2){av[(j & 1) * 2], av[(j & 1) * 2 + 1]} * r, bb = (f32x2){bv[(j & 1) * 2], bv[(j & 1) * 2 + 1]} * r;
                    const f32x2 s1 = f15 ? xp[j] : x, s2 = f14 ? xp[j] : x;
                    f32x2 p1, p2;
                    p1.x = __int_as_float(__builtin_amdgcn_update_dpp(0, __float_as_int(s1.x), 0x121, 0xf, 0xf, false)); p1.y = __int_as_float(__builtin_amdgcn_update_dpp(0, __float_as_int(s1.y), 0x121, 0xf, 0xf, false));
                    p2.x = __int_as_float(__builtin_amdgcn_update_dpp(0, __float_as_int(s2.x), 0x122, 0xf, 0xf, false)); p2.y = __int_as_float(__builtin_amdgcn_update_dpp(0, __float_as_int(s2.y), 0x122, 0xf, 0xf, false));
                    const f32x2 cv = ((cbv[j] + w0[j] * p2) + w1[j] * p1) + w2[j] * x;
                    const f32x2 arg = (cv * (cv * cv * 0.044715f + 1.0f)) * (-2.3022081986f);
                    f32x2 e; e.x = __builtin_amdgcn_exp2f(arg.x); e.y = __builtin_amdgcn_exp2f(arg.y);
                    const f32x2 d = e + 1.0f; f32x2 rc; rc.x = __builtin_amdgcn_rcpf(d.x); rc.y = __builtin_amdgcn_rcpf(d.y);
                    o[j] = (cv * rc) * bb; xp[j] = x; }
                *(u32x4*)(HM + (size_t)row * 5632 + c0) = pack8((f32x4){o[0].x, o[0].y, o[1].x, o[1].y}, (f32x4){o[2].x, o[2].y, o[3].x, o[3].y}); }
        }
    }
};
struct EpiE {
    static constexpr bool PERM = true, AFTER_DRAIN = false, MIDK = false;
    bf16_t* O; float* ssq;
    __device__ __forceinline__ void mid(Acc&, const Unit&, int, int, int, int) const {}
    __device__ __forceinline__ void operator()(const Acc& acc, const Unit& u, int wr, int wc, int fr, int fq) const {
        const int row0 = u.pm * BM + wr * 64 + fr, col0 = u.pn * BM + wc * 32 + 8 * fq;
#pragma unroll
        EPI_LOOP_ROWS { const int row = row0 + ai * HALF + m * 16; float s = 0.f; bf16_t* rowp = O + (size_t)row * 2048 + col0;
#pragma unroll
            for (int bj = 0; bj < 2; ++bj) { const f32x4 x0 = acc[ai][bj][m][0], x1 = acc[ai][bj][m][1];
                s += (x0[0] * x0[0] + x0[1] * x0[1]) + (x0[2] * x0[2] + x0[3] * x0[3]) + (x1[0] * x1[0] + x1[1] * x1[1]) + (x1[2] * x1[2] + x1[3] * x1[3]);
                *(u32x4*)(rowp + bj * HALF) = pack8(x0, x1); }
            s = xsum_fq(s);
            if (fq == 0) atomicAdd(ssq + row, s); }
    }
};
struct EpiFinal {
    static constexpr bool PERM = true, AFTER_DRAIN = false, MIDK = false;
    float* out; const bf16_t* xb; const bf16_t* E; const float* gp; const float* ssq2; const float* ssqE;
    __device__ __forceinline__ void mid(Acc&, const Unit&, int, int, int, int) const {}
    __device__ __forceinline__ void operator()(const Acc& acc, const Unit& u, int wr, int wc, int fr, int fq) const {
        const int row0 = u.pm * BM + wr * 64 + fr, col0 = u.pn * BM + wc * 32 + 8 * fq;
        f32x4 gv[2][2];
#pragma unroll
        for (int bj = 0; bj < 2; ++bj) { gv[bj][0] = *(const f32x4*)(gp + col0 + bj * HALF); gv[bj][1] = *(const f32x4*)(gp + col0 + bj * HALF + 4); }
#pragma unroll
        EPI_LOOP_ROWS { const int row = row0 + ai * HALF + m * 16; const size_t off = (size_t)row * 2048 + col0;
            const float r2 = 1.0f / sqrtf(ssq2[row] * (1.0f / 2048.0f) + 1e-6f), rE = 1.0f / sqrtf(ssqE[row] * (1.0f / 2048.0f) + 1e-6f);
#pragma unroll
            for (int bj = 0; bj < 2; ++bj) { const u32x4 xw = *(const u32x4*)(xb + off + bj * HALF);
                const f32x4 b0 = (f32x4){bf_lo(xw.x), bf_hi(xw.x), bf_lo(xw.y), bf_hi(xw.y)}, b1 = (f32x4){bf_lo(xw.z), bf_hi(xw.z), bf_lo(xw.w), bf_hi(xw.w)};
                const u32x4 e = *(const u32x4*)(E + off + bj * HALF);
                const f32x4 e0 = (f32x4){bf_lo(e.x), bf_hi(e.x), bf_lo(e.y), bf_hi(e.y)}, e1 = (f32x4){bf_lo(e.z), bf_hi(e.z), bf_lo(e.w), bf_hi(e.w)};
                const f32x4 g0 = sigm4(acc[ai][bj][m][0] * r2), g1 = sigm4(acc[ai][bj][m][1] * r2);
                *(f32x4*)(out + off + bj * HALF) = b0 + g0 * (e0 * rE * gv[bj][0]); *(f32x4*)(out + off + bj * HALF + 4) = b1 + g1 * (e1 * rE * gv[bj][1]); } }
    }
};

template <class Epi, class Sched, bool ALIGN_EPI = false, bool SP2 = false>
__device__ __forceinline__ void gemm_phase(PG8_LAS unsigned char* lds, const Gemm g, const Sched& S, const Epi& E) {
    const int tid = threadIdx.x, wid = __builtin_amdgcn_readfirstlane(tid >> 6), lane = tid & 63, wr = wid >> 2, wc = wid & 3, fr = lane & 15, fq = lane >> 4;
    const int K = g.K, nt = K / BK;
    unsigned voffA[2], voffB[2];
#pragma unroll
    for (int i = 0; i < 2; ++i) { int R, C; stage_rc(tid * 16 + i * 8192, R, C); const int Rb = Epi::PERM ? ((R & ~31) + perm32(R & 31)) : R;
        voffA[i] = (unsigned)(R * K + C) * 2u; voffB[i] = (unsigned)(Rb * K + C) * 2u; }
    const size_t kstep = (size_t)(BK * 2);
    const size_t hstep = (size_t)HALF * K * 2;
    const size_t tstep = 2 * hstep;
    const unsigned ldsw = (unsigned)wid * 1024u;
    const int aoff = lds_byte(wr * 64 + fr, fq * 8), boff = lds_byte(wc * 32 + fr, fq * 8);
#define PG8_SA(b, h) (((b) * 2 + (h)) * HTB)
#define PG8_SB(b, h) ((4 + (b) * 2 + (h)) * HTB)
#define PG8_STAGE(bufoff, gbase, voff) do { _Pragma("unroll") for (int _i = 0; _i < 2; ++_i) \
        __builtin_amdgcn_global_load_lds((const unsigned*)((const char*)(gbase) + (voff)[_i]), (PG8_LAS unsigned*)(lds + (bufoff) + ldsw + _i * 8192), 16, 0, 0); } while (0)
#define PG8_LDA(dst, b, h) do { _Pragma("unroll") for (int m = 0; m < 4; ++m) _Pragma("unroll") for (int k = 0; k < 2; ++k) dst[m][k] = *(const PG8_LAS bf16x8*)(lds + PG8_SA(b, h) + aoff + m * 2048 + k * 1024); } while (0)
#define PG8_LDB(dst, b, h) do { _Pragma("unroll") for (int n = 0; n < 2; ++n) _Pragma("unroll") for (int k = 0; k < 2; ++k) dst[n][k] = *(const PG8_LAS bf16x8*)(lds + PG8_SB(b, h) + boff + n * 2048 + k * 1024); } while (0)
#define PG8_MMA(ai, bj, At, Bt) do { __builtin_amdgcn_s_setprio(1); _Pragma("unroll") for (int m = 0; m < 4; ++m) _Pragma("unroll") for (int n = 0; n < 2; ++n) _Pragma("unroll") for (int k = 0; k < 2; ++k) \
        acc[ai][bj][m][n] = __builtin_amdgcn_mfma_f32_16x16x32_bf16(Bt[n][k], At[m][k], acc[ai][bj][m][n], 0, 0, 0); __builtin_amdgcn_s_setprio(0); } while (0)
#define PG8_WAIT_V(n) asm volatile("s_waitcnt vmcnt(" #n ")" ::: "memory")
#define PG8_WAIT_L(n) asm volatile("s_waitcnt lgkmcnt(" #n ")" ::: "memory")
#define PG8_BAR __builtin_amdgcn_s_barrier()
#define PG8_SCHED __builtin_amdgcn_sched_barrier(0)
    Unit cur, nxt; int ui = 0;
    if (!S.next(0, cur)) return;
    f32x4 acc[2][2][4][2];
#pragma unroll
    for (int a = 0; a < 2; ++a)
#pragma unroll
        for (int b = 0; b < 2; ++b)
#pragma unroll
            for (int m = 0; m < 4; ++m)
#pragma unroll
                for (int n = 0; n < 2; ++n) acc[a][b][m][n] = (f32x4){0.f, 0.f, 0.f, 0.f};
    bf16x8 At[4][2], B0[2][2], B1[2][2];
    const char* cA = (const char*)g.A + (size_t)cur.pm * tstep; const char* cB = (const char*)g.Bt + (size_t)cur.pn * tstep;
    S.a_ready(cur);
    if constexpr (SP2) {
        PG8_STAGE(PG8_SB(0, 0), cB, voffB); PG8_STAGE(PG8_SB(0, 1), cB + hstep, voffB); PG8_STAGE(PG8_SA(0, 0), cA, voffA); PG8_STAGE(PG8_SA(0, 1), cA + hstep, voffA);
        if (wr == 1) PG8_BAR;
        PG8_WAIT_V(2); PG8_BAR;
        PG8_STAGE(PG8_SB(1, 0), cB + kstep, voffB); PG8_STAGE(PG8_SA(1, 0), cA + kstep, voffA); PG8_STAGE(PG8_SB(1, 1), cB + hstep + kstep, voffB);
        PG8_WAIT_V(6); PG8_BAR;
    } else {
        PG8_STAGE(PG8_SB(0, 0), cB, voffB); PG8_STAGE(PG8_SA(0, 0), cA, voffA); PG8_STAGE(PG8_SB(0, 1), cB + hstep, voffB); PG8_STAGE(PG8_SA(0, 1), cA + hstep, voffA);
        if (wr == 1) PG8_BAR;
        PG8_WAIT_V(4); PG8_BAR;
        PG8_STAGE(PG8_SB(1, 0), cB + kstep, voffB); PG8_STAGE(PG8_SA(1, 0), cA + kstep, voffA); PG8_STAGE(PG8_SB(1, 1), cB + hstep + kstep, voffB);
        PG8_WAIT_V(6); PG8_BAR;
    }
    for (;;) {
        const bool has_next = S.next(ui + 1, nxt);
        const char* nA = has_next ? (const char*)g.A + (size_t)nxt.pm * tstep : cA; const char* nB = has_next ? (const char*)g.Bt + (size_t)nxt.pn * tstep : cB;
        constexpr int NSEG = Epi::MIDK ? 2 : 1;
#pragma unroll 1
        for (int seg = 0; seg < NSEG; ++seg) {
        if constexpr (Epi::MIDK) { if (seg == 1) E.mid(acc, cur, wr, wc, fr, fq); }
        const int t_hi = (NSEG == 2 && seg == 0) ? (nt >> 1) : nt;
#pragma unroll 1
        for (int t = (NSEG == 2 && seg == 1) ? (nt >> 1) : 0; t < t_hi; t += 2) {
            const bool last = (t == nt - 2);
            const char* a1 = cA + (size_t)(t + 1) * kstep;
            const char* a2 = last ? nA : cA + (size_t)(t + 2) * kstep; const char* b2 = last ? nB : cB + (size_t)(t + 2) * kstep;
            const char* a3 = a2 + kstep; const char* b3 = b2 + kstep;
            if (last && has_next) S.a_ready(nxt);
            if constexpr (SP2) {
            PG8_LDB(B0, 0, 0); PG8_LDB(B1, 0, 1); PG8_SCHED; PG8_LDA(At, 0, 0); PG8_STAGE(PG8_SA(1, 1), a1 + hstep, voffA);
            PG8_WAIT_V(8); PG8_WAIT_L(0); PG8_BAR; PG8_MMA(0, 0, At, B0); PG8_MMA(0, 1, At, B1); PG8_BAR; PG8_SCHED;
            PG8_LDA(At, 0, 1); PG8_STAGE(PG8_SB(0, 0), b2, voffB); PG8_STAGE(PG8_SB(0, 1), b2 + hstep, voffB); PG8_STAGE(PG8_SA(0, 0), a2, voffA);
            PG8_WAIT_V(8); PG8_WAIT_L(0); PG8_BAR; PG8_MMA(1, 0, At, B0); PG8_MMA(1, 1, At, B1); PG8_BAR; PG8_SCHED;
            PG8_LDB(B0, 1, 0); PG8_LDB(B1, 1, 1); PG8_SCHED; PG8_LDA(At, 1, 0); PG8_STAGE(PG8_SA(0, 1), a2 + hstep, voffA);
            PG8_WAIT_V(8); PG8_WAIT_L(0); PG8_BAR; PG8_MMA(0, 0, At, B0); PG8_MMA(0, 1, At, B1); PG8_BAR; PG8_SCHED;
            PG8_LDA(At, 1, 1); PG8_STAGE(PG8_SB(1, 0), b3, voffB); PG8_STAGE(PG8_SB(1, 1), b3 + hstep, voffB); PG8_STAGE(PG8_SA(1, 0), a3, voffA);
            PG8_WAIT_V(8); PG8_WAIT_L(0); PG8_BAR; PG8_MMA(1, 0, At, B0); PG8_MMA(1, 1, At, B1); PG8_BAR; PG8_SCHED;
            } else {
            PG8_LDB(B0, 0, 0); PG8_SCHED; PG8_LDA(At, 0, 0); PG8_STAGE(PG8_SA(1, 1), a1 + hstep, voffA);
            PG8_WAIT_L(8); PG8_BAR; PG8_WAIT_L(0); PG8_MMA(0, 0, At, B0); PG8_BAR; PG8_SCHED;
            PG8_LDB(B1, 0, 1); PG8_STAGE(PG8_SB(0, 0), b2, voffB);
            PG8_BAR; PG8_WAIT_L(0); PG8_MMA(0, 1, At, B1); PG8_BAR;
            PG8_LDA(At, 0, 1); PG8_STAGE(PG8_SA(0, 0), a2, voffA);
            PG8_BAR; PG8_WAIT_L(0); PG8_MMA(1, 0, At, B0); PG8_BAR; PG8_SCHED;
            PG8_STAGE(PG8_SB(0, 1), b2 + hstep, voffB);
            PG8_WAIT_V(6); PG8_BAR; PG8_MMA(1, 1, At, B1); PG8_BAR;
            PG8_LDB(B0, 1, 0); PG8_SCHED; PG8_LDA(At, 1, 0); PG8_STAGE(PG8_SA(0, 1), a2 + hstep, voffA);
            PG8_WAIT_L(8); PG8_BAR; PG8_WAIT_L(0); PG8_MMA(0, 0, At, B0); PG8_BAR; PG8_SCHED;
            PG8_LDB(B1, 1, 1); PG8_STAGE(PG8_SB(1, 0), b3, voffB);
            PG8_BAR; PG8_WAIT_L(0); PG8_MMA(0, 1, At, B1); PG8_BAR;
            PG8_LDA(At, 1, 1); PG8_STAGE(PG8_SA(1, 0), a3, voffA);
            PG8_BAR; PG8_WAIT_L(0); PG8_MMA(1, 0, At, B0); PG8_BAR; PG8_SCHED;
            PG8_STAGE(PG8_SB(1, 1), b3 + hstep, voffB);
            PG8_WAIT_V(6); PG8_BAR; PG8_MMA(1, 1, At, B1); PG8_BAR;
            }
        }
        }
        if constexpr (ALIGN_EPI) { if (wr == 0) PG8_BAR; }
        if constexpr (!Epi::AFTER_DRAIN) { E(acc, cur, wr, wc, fr, fq); S.done(cur); }
        if (!has_next) break;
#pragma unroll
        for (int a = 0; a < 2; ++a)
#pragma unroll
            for (int b = 0; b < 2; ++b)
#pragma unroll
                for (int m = 0; m < 4; ++m)
#pragma unroll
                    for (int n = 0; n < 2; ++n) acc[a][b][m][n] = (f32x4){0.f, 0.f, 0.f, 0.f};
        cur = nxt; cA = nA; cB = nB; ++ui;
        if constexpr (ALIGN_EPI) { if (wr == 1) PG8_BAR; }
    }
    PG8_WAIT_V(0);
    if constexpr (!ALIGN_EPI) { if (wr == 0) PG8_BAR; }
    PG8_BAR;
#undef PG8_SA
#undef PG8_SB
#undef PG8_STAGE
#undef PG8_LDA
#undef PG8_LDB
#undef PG8_MMA
#undef PG8_WAIT_V
#undef PG8_WAIT_L
#undef PG8_BAR
#undef PG8_SCHED
}
}

namespace fox {
typedef unsigned short bf16_t;
typedef short bf16x8 __attribute__((ext_vector_type(8)));
typedef short s16x4 __attribute__((ext_vector_type(4)));
typedef float f32x16 __attribute__((ext_vector_type(16)));
typedef float f32x4 __attribute__((ext_vector_type(4)));
typedef unsigned u32x4 __attribute__((ext_vector_type(4)));
constexpr int D = 128, NW = 8, QBLK = 32, KVBLK = 64, QB = NW * QBLK;
constexpr int SHM_V = KVBLK * D * 2, SHM_K = KVBLK * D * 2;
constexpr int LDS_WS = 2 * SHM_V + 2 * SHM_K;
constexpr int LDS_CUM = LDS_WS + NW * 64 * 4;
constexpr int LDS_BYTES = LDS_CUM + 2048 * 4;
constexpr int QS = 9216, OS = 2048;
constexpr float SCALE = 0.08838834764831845f;
constexpr float THR = 8.f;
constexpr unsigned WBIG = 0x40000000u;

#define KSWZ(row, colB) ((row) * 256 + ((colB) ^ (((row) & 7) << 4)))
#define SBAR() __builtin_amdgcn_sched_barrier(0)
__device__ __forceinline__ int v_st(int k, int c) { const int kk = (k & ~0xC) | ((k & 4) << 1) | ((k & 8) >> 1); return ((kk >> 3) * 4 + (c >> 5)) * 512 + ((kk & 7) * 32 + (c & 31)) * 2; }
__device__ __forceinline__ int v_rd_base(int lane) { return ((lane & 3) << 3) | (((lane >> 2) & 3) << 6) | (((lane >> 4) & 1) << 5) | (((lane >> 5) & 1) << 8); }
constexpr int v_rd_off(int d0, int ks, int half) { return d0 * 512 + ks * 4096 + half * 2048; }
__device__ __forceinline__ int crow(int r, int hi) { return (r & 3) + 8 * (r >> 2) + 4 * hi; }
__device__ __forceinline__ unsigned cvtpk(float lo, float hi) { unsigned r; asm volatile("v_cvt_pk_bf16_f32 %0, %1, %2" : "=v"(r) : "v"(lo), "v"(hi)); return r; }
__device__ __forceinline__ bf16x8 load8(const bf16_t* p) { return *reinterpret_cast<const bf16x8*>(p); }
__device__ __forceinline__ void mask_tile(f32x16& p0, f32x16& p1, int dq) {
    const float NEG = -__builtin_inff();
#pragma unroll
    for (int r = 0; r < 16; ++r) {
        const int c = (r & 3) + 8 * (r >> 2);
        if ((unsigned)(dq - c) >= WBIG) p0[r] = NEG;
        if ((unsigned)(dq - c - 32) >= WBIG) p1[r] = NEG;
    }
}
__device__ __forceinline__ void partialSM(f32x16& p0, f32x16& p1, float& m_reg, float& mn, float& alpha) {
    float pmax = p0[0]; for (int r = 1; r < 16; ++r) pmax = fmaxf(pmax, p0[r]); for (int r = 0; r < 16; ++r) pmax = fmaxf(pmax, p1[r]);
    { auto rr = __builtin_amdgcn_permlane32_swap(__float_as_uint(pmax), __float_as_uint(pmax), false, false);
      pmax = fmaxf(__uint_as_float(rr[0]), __uint_as_float(rr[1])); }
    constexpr float C2 = 1.4426950408889634f * SCALE;
    if (__builtin_expect(__all((pmax - m_reg) * SCALE <= THR), 1)) { mn = m_reg; alpha = 1.f; }
    else { mn = fmaxf(m_reg, pmax); alpha = __builtin_amdgcn_exp2f((m_reg - mn) * C2); m_reg = mn; }
    const float mnL = -mn * C2;
    for (int r = 0; r < 16; ++r) p0[r] = fmaf(p0[r], C2, mnL); for (int r = 0; r < 16; ++r) p1[r] = fmaf(p1[r], C2, mnL);
    for (int r = 0; r < 16; ++r) p0[r] = __builtin_amdgcn_exp2f(p0[r]);
}
__device__ __forceinline__ void finishSM(f32x16& p0, f32x16& p1, float alpha, float& l_reg, bf16x8& pa0, bf16x8& pa1, bf16x8& pa2, bf16x8& pa3) {
    for (int r = 0; r < 16; ++r) p1[r] = __builtin_amdgcn_exp2f(p1[r]);
    float ps = 0; for (int r = 0; r < 16; ++r) ps += p0[r]; for (int r = 0; r < 16; ++r) ps += p1[r];
    { auto rr = __builtin_amdgcn_permlane32_swap(__float_as_uint(ps), __float_as_uint(ps), false, false);
      ps = __uint_as_float(rr[0]) + __uint_as_float(rr[1]); }
    l_reg = l_reg * alpha + ps;
#define PK4(P, B_, OUT) do { unsigned a0 = cvtpk(P[B_+0], P[B_+1]), a1 = cvtpk(P[B_+2], P[B_+3]);                          \
        unsigned b0 = cvtpk(P[B_+4], P[B_+5]), b1 = cvtpk(P[B_+6], P[B_+7]);                                             \
        auto r0 = __builtin_amdgcn_permlane32_swap(a0, b0, false, false); auto r1 = __builtin_amdgcn_permlane32_swap(a1, b1, false, false); \
        u32x4 w = {r0[0], r1[0], r0[1], r1[1]}; OUT = *reinterpret_cast<bf16x8*>(&w); } while (0)
    PK4(p0, 0, pa0); PK4(p0, 8, pa1); PK4(p1, 0, pa2); PK4(p1, 8, pa3);
#undef PK4
}
template <int KB>
__device__ __forceinline__ void qkt(f32x16& p0, f32x16& p1, const char* K_lds, int r32, int hi, const bf16x8* qr, const float* cl) {
#pragma unroll
    for (int g = 0; g < 4; ++g) { const f32x4 c0 = *(const f32x4*)(cl + 8 * g), c1 = *(const f32x4*)(cl + 32 + 8 * g);
#pragma unroll
        for (int i = 0; i < 4; ++i) { p0[4 * g + i] = c0[i]; p1[4 * g + i] = c1[i]; } }
    const char* kb[4];
#pragma unroll
    for (int dd = 0; dd < 4; ++dd) kb[dd] = K_lds + KB * SHM_K + KSWZ(r32, (dd * 16 + hi * 8) * 2);
#pragma unroll
    for (int d0 = 0; d0 < 8; ++d0) { const char* a = kb[d0 & 3] + (d0 >> 2) * 128;
        bf16x8 b0 = *reinterpret_cast<const bf16x8*>(a);
        bf16x8 b1 = *reinterpret_cast<const bf16x8*>(a + 32 * 256);
        p0 = __builtin_amdgcn_mfma_f32_32x32x16_bf16(b0, qr[d0], p0, 0, 0, 0);
        p1 = __builtin_amdgcn_mfma_f32_32x32x16_bf16(b1, qr[d0], p1, 0, 0, 0); }
}
#define TRRD(dst, base, off) asm volatile("ds_read_b64_tr_b16 %0, %1 offset:%2" : "=&v"(dst) : "v"(base), "i"(off) : "memory")
template <int VB>
__device__ __forceinline__ void pv_tile(f32x16* o, int vb0, bf16x8 pa0, bf16x8 pa1, bf16x8 pa2, bf16x8 pa3) {
#define PV_D0(d0) do { s16x4 l0, l1, l2, l3, h0, h1, h2, h3; constexpr int b_ = VB * SHM_V + v_rd_off(d0, 0, 0); \
        TRRD(l0, vb0, b_); TRRD(h0, vb0, b_ + 2048); TRRD(l1, vb0, b_ + 4096); TRRD(h1, vb0, b_ + 6144); TRRD(l2, vb0, b_ + 8192); TRRD(h2, vb0, b_ + 10240); TRRD(l3, vb0, b_ + 12288); TRRD(h3, vb0, b_ + 14336); \
        asm volatile("s_waitcnt lgkmcnt(0)" ::: "memory"); SBAR();   \
        o[d0] = __builtin_amdgcn_mfma_f32_32x32x16_bf16(pa0, (bf16x8){l0[0], l0[1], l0[2], l0[3], h0[0], h0[1], h0[2], h0[3]}, o[d0], 0, 0, 0);   \
        o[d0] = __builtin_amdgcn_mfma_f32_32x32x16_bf16(pa1, (bf16x8){l1[0], l1[1], l1[2], l1[3], h1[0], h1[1], h1[2], h1[3]}, o[d0], 0, 0, 0);   \
        o[d0] = __builtin_amdgcn_mfma_f32_32x32x16_bf16(pa2, (bf16x8){l2[0], l2[1], l2[2], l2[3], h2[0], h2[1], h2[2], h2[3]}, o[d0], 0, 0, 0);   \
        o[d0] = __builtin_amdgcn_mfma_f32_32x32x16_bf16(pa3, (bf16x8){l3[0], l3[1], l3[2], l3[3], h3[0], h3[1], h3[2], h3[3]}, o[d0], 0, 0, 0); } while (0)
    PV_D0(0); PV_D0(1); PV_D0(2); PV_D0(3);
#undef PV_D0
}

struct BlockRef { const bf16_t* Q; const bf16_t* K; const bf16_t* V; bf16_t* O; int P0; };
struct Seam { bf16x8 qr[8]; bf16x8 st_v0, st_v1, st_k0, st_k1; };
#define ROW(p, k0, rr) ((p) + (size_t)((k0) + (rr)) * QS + sc)
#define VMW() asm volatile("s_waitcnt vmcnt(0)" ::: "memory")
#define VMWN(n) asm volatile("s_waitcnt vmcnt(%0)" :: "i"(n) : "memory")
#define SLOAD_H(Kp, Vp, k0) do { S.st_v0 = load8(ROW(Vp, k0, sr)); S.st_v1 = load8(ROW(Vp, k0, 32 + sr));              \
                         S.st_k0 = load8(ROW(Kp, k0, sr)); S.st_k1 = load8(ROW(Kp, k0, 32 + sr)); } while (0)
__device__ __forceinline__ bf16x8 knorm8(bf16x8 kv) {
    const u32x4 w = __builtin_bit_cast(u32x4, kv);
    float x[8] = {__uint_as_float(w.x << 16), __uint_as_float(w.x & 0xffff0000u), __uint_as_float(w.y << 16), __uint_as_float(w.y & 0xffff0000u),
                  __uint_as_float(w.z << 16), __uint_as_float(w.z & 0xffff0000u), __uint_as_float(w.w << 16), __uint_as_float(w.w & 0xffff0000u)};
    float s = 0.f;
#pragma unroll
    for (int i = 0; i < 8; ++i) s += x[i] * x[i];
    s += __shfl_xor(s, 1); s += __shfl_xor(s, 2); s += __shfl_xor(s, 4); s += __shfl_xor(s, 8);
    const float r = 1.0f / sqrtf(s * (1.0f / 128.0f) + 1e-6f);
    u32x4 o; o.x = cvtpk(x[0] * r, x[1] * r); o.y = cvtpk(x[2] * r, x[3] * r); o.z = cvtpk(x[4] * r, x[5] * r); o.w = cvtpk(x[6] * r, x[7] * r);
    return __builtin_bit_cast(bf16x8, o);
}
#define SWRITE_HK(bf) do { *(bf16x8*)(K_lds + (bf) * SHM_K + kws) = S.st_k0; *(bf16x8*)(K_lds + (bf) * SHM_K + kws + 32 * 256) = S.st_k1; } while (0)
#define SWRITE_HV(bf) do { *(bf16x8*)(V_lds + (bf) * SHM_V + vst0) = S.st_v0; *(bf16x8*)(V_lds + (bf) * SHM_V + vst1) = S.st_v1; } while (0)
#define SWRITE_H(bf) do { SWRITE_HV(bf); SWRITE_HK(bf); } while (0)
__device__ __forceinline__ void qnorm(bf16x8* qr, const float* gq, const float* gk, int hi) {
    float s = 0.f;
#pragma unroll
    for (int d0 = 0; d0 < 8; ++d0) { const u32x4 w = __builtin_bit_cast(u32x4, qr[d0]);
        const float a0 = __uint_as_float(w.x << 16), a1 = __uint_as_float(w.x & 0xffff0000u), a2 = __uint_as_float(w.y << 16), a3 = __uint_as_float(w.y & 0xffff0000u);
        const float a4 = __uint_as_float(w.z << 16), a5 = __uint_as_float(w.z & 0xffff0000u), a6 = __uint_as_float(w.w << 16), a7 = __uint_as_float(w.w & 0xffff0000u);
        s += (a0 * a0 + a1 * a1) + (a2 * a2 + a3 * a3) + (a4 * a4 + a5 * a5) + (a6 * a6 + a7 * a7); }
    { auto rr = __builtin_amdgcn_permlane32_swap(__float_as_uint(s), __float_as_uint(s), false, false); s = __uint_as_float(rr[0]) + __uint_as_float(rr[1]); }
    const float r = 1.0f / sqrtf(s * (1.0f / 128.0f) + 1e-6f);
#pragma unroll
    for (int d0 = 0; d0 < 8; ++d0) { const u32x4 w = __builtin_bit_cast(u32x4, qr[d0]); const int d = d0 * 16 + hi * 8;
        const f32x4 g0 = *(const f32x4*)(gq + d) * *(const f32x4*)(gk + d) * r, g1 = *(const f32x4*)(gq + d + 4) * *(const f32x4*)(gk + d + 4) * r;
        u32x4 o; o.x = cvtpk(__uint_as_float(w.x << 16) * g0[0], __uint_as_float(w.x & 0xffff0000u) * g0[1]); o.y = cvtpk(__uint_as_float(w.y << 16) * g0[2], __uint_as_float(w.y & 0xffff0000u) * g0[3]);
        o.z = cvtpk(__uint_as_float(w.z << 16) * g1[0], __uint_as_float(w.z & 0xffff0000u) * g1[1]); o.w = cvtpk(__uint_as_float(w.w << 16) * g1[2], __uint_as_float(w.w & 0xffff0000u) * g1[3]);
        qr[d0] = __builtin_bit_cast(bf16x8, o); }
}
__device__ __forceinline__ void fox_prime(const BlockRef& cur, char* lds, Seam& S) {
    int tid; asm volatile("v_mov_b32 %0, %1" : "=v"(tid) : "v"((int)threadIdx.x));
    const int wid = __builtin_amdgcn_readfirstlane(tid >> 6), lane = tid & 63, r32 = lane & 31, hi = lane >> 5;
    const int sr = tid >> 4, sc = (tid & 15) * 8, kws = KSWZ(sr, sc * 2); char* K_lds = lds + 2 * SHM_V;
#pragma unroll
    for (int d0 = 0; d0 < 8; ++d0) S.qr[d0] = load8(cur.Q + (size_t)(wid * QBLK + r32) * QS + d0 * 16 + hi * 8);
    SLOAD_H(cur.K, cur.V, 0); VMW(); SWRITE_HK(0);
    __syncthreads();
}
__device__ __forceinline__ void fox_block(const BlockRef& cur, char* lds, Seam& S, const float* cumL, int NT, float* plse) {
    const int tid = threadIdx.x, wid = __builtin_amdgcn_readfirstlane(tid >> 6), lane = tid & 63, r32 = lane & 31, hi = lane >> 5;
    const int qlo = cur.P0 + wid * QBLK, qm = qlo + r32 - 4 * hi;
    char* V_lds = lds; char* K_lds = lds + 2 * SHM_V;
    float* ws = (float*)(lds + LDS_WS) + wid * 64; float* li_l = ws, * al_l = ws + 32;
    float m_reg = -1e30f, l_reg = 0; f32x16 o[4] = {};
    const int sr = tid >> 4, sc = (tid & 15) * 8, vst0 = v_st(sr, sc), vst1 = vst0 + 8192  , kws = KSWZ(sr, sc * 2);
    const int vb0 = (int)(uintptr_t)V_lds + v_rd_base(lane);
    const bf16_t* Kh = cur.K; const bf16_t* Vh = cur.V;
    const float* clb = cumL + 4 * hi;
#define RESC(a) do { if (__any((a) < 1.f)) { if (hi == 0) al_l[r32] = (a); asm volatile("s_waitcnt lgkmcnt(0)" ::: "memory");              \
                     for (int d_ = 0; d_ < 4; ++d_) for (int r = 0; r < 16; ++r) o[d_][r] *= al_l[crow(r, hi)]; } } while (0)
#define KBASE(t) ((t) * KVBLK)
#define MASKT(P0_, P1_, t) do { const int kb_ = KBASE(t); if (kb_ + KVBLK - 1 > qlo) mask_tile(P0_, P1_, qm - kb_); } while (0)
    constexpr int NQL = 8;
#define SEAM_K0() do { VMWN(NQL); SWRITE_HK(0); SBAR(); } while (0)
    f32x16 pA0, pA1, pB0, pB1; float mnA, mnB, alA, alB; bf16x8 pa0, pa1, pa2, pa3;
    SWRITE_HV(0); SBAR();
    if (NT > 1) { SLOAD_H(Kh, Vh, KBASE(1)); }
    SBAR(); qkt<0>(pA0, pA1, K_lds, r32, hi, S.qr, clb + KBASE(0));
    MASKT(pA0, pA1, 0); partialSM(pA0, pA1, m_reg, mnA, alA);
    if (NT > 1) { VMW(); SWRITE_H(1); }
    __syncthreads();
#define HALF_STEP(PX0, PX1, mnX, alX, PY0, PY1, alY, t, KB, VB, SB) do {                                                      \
        SBAR(); qkt<KB>(PX0, PX1, K_lds, r32, hi, S.qr, clb + KBASE(t));                                                  \
        finishSM(PY0, PY1, alY, l_reg, pa0, pa1, pa2, pa3); SBAR();                                                           \
        if ((t) + 1 < NT) { SLOAD_H(Kh, Vh, KBASE((t) + 1)); SBAR(); }                                                        \
        pv_tile<VB>(o, vb0, pa0, pa1, pa2, pa3); MASKT(PX0, PX1, (t)); partialSM(PX0, PX1, m_reg, mnX, alX);                   \
        __syncthreads();                                                                                                      \
        if ((t) + 1 < NT) { VMW(); SWRITE_H(SB); }                                                                            \
        RESC(alX); __syncthreads(); } while (0)
    for (int t = 1; t + 1 < NT; t += 2) {
        HALF_STEP(pB0, pB1, mnB, alB, pA0, pA1, alA, t, 1, 0, 0);
        HALF_STEP(pA0, pA1, mnA, alA, pB0, pB1, alB, t + 1, 0, 1, 1);
    }
    const bool even = (NT & 1) == 0;
    if (even) { SBAR(); qkt<1>(pB0, pB1, K_lds, r32, hi, S.qr, clb + KBASE(NT - 1)); SBAR(); }
    finishSM(pA0, pA1, alA, l_reg, pa0, pa1, pa2, pa3); SBAR();
    pv_tile<0>(o, vb0, pa0, pa1, pa2, pa3);
    if (even) { MASKT(pB0, pB1, NT - 1); partialSM(pB0, pB1, m_reg, mnB, alB); __syncthreads(); RESC(alB);
        finishSM(pB0, pB1, alB, l_reg, pa0, pa1, pa2, pa3); SBAR(); pv_tile<1>(o, vb0, pa0, pa1, pa2, pa3); }
    SBAR();
    if (hi == 0) { li_l[r32] = l_reg;
        if (plse) __hip_atomic_store(plse + wid * QBLK + r32, m_reg * (1.4426950408889634f * SCALE) + __builtin_amdgcn_logf(l_reg), __ATOMIC_RELAXED, __HIP_MEMORY_SCOPE_AGENT); }
    asm volatile("s_waitcnt lgkmcnt(0)" ::: "memory");
    float rli[16];
#pragma unroll
    for (int r = 0; r < 16; ++r) rli[r] = __builtin_amdgcn_rcpf(li_l[crow(r, hi)]);
    bf16_t* Ow = cur.O + (size_t)(wid * QBLK) * OS;
#pragma unroll
    for (int r = 0; r < 16; ++r) { const int orow = crow(r, hi);
#pragma unroll
        for (int d0 = 0; d0 < 4; ++d0) { const float v = o[d0][r] * rli[r];
            const float vn = __int_as_float(__builtin_amdgcn_update_dpp(0, __float_as_int(v), 0xB1, 0xf, 0xf, false));
            if ((r32 & 1) == 0) { unsigned* op_ = (unsigned*)(Ow + (size_t)orow * OS + d0 * 32 + r32);
                if (plse) __hip_atomic_store(op_, cvtpk(v, vn), __ATOMIC_RELAXED, __HIP_MEMORY_SCOPE_AGENT); else *op_ = cvtpk(v, vn); } } }
    __syncthreads();
#undef RESC
#undef KBASE
#undef MASKT
#undef SEAM_K0
#undef HALF_STEP
}
#undef ROW
#undef VMWN
#undef SLOAD_H
#undef SWRITE_HK
#undef SWRITE_HV
#undef SWRITE_H

constexpr int GM_U = 2 * SHM_V;
constexpr int GM_UP = 264;
__device__ __forceinline__ void gmlp_unit(char* lds, int idx, const bf16_t* Z, const bf16_t* Wb, const float* b_s, bf16_t* OAB, const float* vs1, const float* vs2, const float* lng, const float* lnb) {
    int tid; asm volatile("v_mov_b32 %0, %1" : "=v"(tid) : "v"((int)threadIdx.x));
    const int wid = __builtin_amdgcn_readfirstlane(tid >> 6), lane = tid & 63, r32 = lane & 31, hi = lane >> 5;
    const int g = idx & 7, row0 = (idx >> 3) * 128;
    char* V_lds = lds;
    const int sr = tid >> 4, sc = (tid & 15) * 8;
    const int rg = wid & 3, dh = wid >> 2, nks = 2 * (rg + 1);
    u32x4 vraw[4], uraw[4]; float s1[4], s2[4];
#pragma unroll
    for (int q = 0; q < 4; ++q) { const int s = q * 32 + sr; const bf16_t* zr = Z + (size_t)(row0 + s) * QS + g * 128 + sc;
        vraw[q] = __builtin_bit_cast(u32x4, load8(zr + 1024)); uraw[q] = __builtin_bit_cast(u32x4, load8(zr)); s1[q] = vs1[row0 + s]; s2[q] = vs2[row0 + s]; }
    const f32x4 lg0 = *(const f32x4*)(lng + g * 128 + sc), lg1 = *(const f32x4*)(lng + g * 128 + sc + 4), lb0 = *(const f32x4*)(lnb + g * 128 + sc), lb1 = *(const f32x4*)(lnb + g * 128 + sc + 4);
    bf16x8 wf[8];
    const bf16_t* wrow = Wb + (size_t)(g * 128 + 32 * rg + r32) * 128 + 8 * hi;
#pragma unroll
    for (int ks = 0; ks < 8; ++ks) wf[ks] = load8(wrow + 16 * ks);
    float bias[16];
#pragma unroll
    for (int r = 0; r < 16; ++r) bias[r] = b_s[g * 128 + 32 * rg + crow(r, hi)];
#pragma unroll
    for (int q = 0; q < 4; ++q) { const int s = q * 32 + sr; const u32x4 w = vraw[q];
        const float mu = s1[q] * (1.0f / 1024.0f), var = s2[q] * (1.0f / 1024.0f) - mu * mu, rs = 1.0f / sqrtf(var + 1e-6f), nm = -mu * rs;
        const f32x4 a0 = (f32x4){__uint_as_float(w.x << 16), __uint_as_float(w.x & 0xffff0000u), __uint_as_float(w.y << 16), __uint_as_float(w.y & 0xffff0000u)};
        const f32x4 a1 = (f32x4){__uint_as_float(w.z << 16), __uint_as_float(w.z & 0xffff0000u), __uint_as_float(w.w << 16), __uint_as_float(w.w & 0xffff0000u)};
        const f32x4 y0 = (a0 * rs + nm) * lg0 + lb0, y1 = (a1 * rs + nm) * lg1 + lb1;
        u32x4 o; o.x = cvtpk(y0[0], y0[1]); o.y = cvtpk(y0[2], y0[3]); o.z = cvtpk(y1[0], y1[1]); o.w = cvtpk(y1[2], y1[3]);
        *(bf16x8*)(V_lds + (q >> 1) * SHM_V + v_st((q & 1) * 32 + sr, sc)) = __builtin_bit_cast(bf16x8, o);
        char* up = lds + GM_U + s * GM_UP + sc * 2; *(unsigned long long*)up = (unsigned long long)uraw[q].x | ((unsigned long long)uraw[q].y << 32);
        *(unsigned long long*)(up + 8) = (unsigned long long)uraw[q].z | ((unsigned long long)uraw[q].w << 32); }
    __syncthreads();
    f32x16 o0 = {}, o1 = {};
    const int vb = (int)(uintptr_t)V_lds + v_rd_base(lane) + dh * 1024;
#define GM_STEP(ks) do { if ((ks) < nks) { s16x4 l0, h0, l1, h1; constexpr int b_ = ((ks) >> 2) * SHM_V + v_rd_off(0, (ks) & 3, 0); \
        TRRD(l0, vb, b_); TRRD(h0, vb, b_ + 2048); TRRD(l1, vb, b_ + 512); TRRD(h1, vb, b_ + 512 + 2048); \
        asm volatile("s_waitcnt lgkmcnt(0)" ::: "memory"); SBAR(); \
        o0 = __builtin_amdgcn_mfma_f32_32x32x16_bf16(wf[ks], (bf16x8){l0[0], l0[1], l0[2], l0[3], h0[0], h0[1], h0[2], h0[3]}, o0, 0, 0, 0); \
        o1 = __builtin_amdgcn_mfma_f32_32x32x16_bf16(wf[ks], (bf16x8){l1[0], l1[1], l1[2], l1[3], h1[0], h1[1], h1[2], h1[3]}, o1, 0, 0, 0); } } while (0)
    GM_STEP(0); GM_STEP(1); GM_STEP(2); GM_STEP(3); GM_STEP(4); GM_STEP(5); GM_STEP(6); GM_STEP(7);
#undef GM_STEP
#pragma unroll
    for (int r = 0; r < 16; ++r) { const int t = 32 * rg + crow(r, hi);
        const size_t ooff = (size_t)(row0 + t) * OS + g * 128;
#pragma unroll
        for (int dd = 0; dd < 2; ++dd) { const int d = (2 * dh + dd) * 32 + r32;
            const float uu = __uint_as_float((unsigned)(*(const unsigned short*)(lds + GM_U + t * GM_UP + d * 2)) << 16);
            const float v = uu * ((dd ? o1[r] : o0[r]) + bias[r]);
            const float vn = __int_as_float(__builtin_amdgcn_update_dpp(0, __float_as_int(v), 0xB1, 0xf, 0xf, false));
            if ((r32 & 1) == 0) *(unsigned*)(OAB + ooff + d) = cvtpk(v, vn); } }
    __syncthreads();
}
#undef TRRD
#undef SBAR
#undef VMW
}

constexpr int NWAVES = 8;
constexpr int N_LAUNCHES = MK_N_LAUNCHES;
constexpr int N_PHASES = 10;
constexpr int M = 8192, DM = 2048, SEQ = 2048, NZ = 9216, DFF = 5632, NUP = 2 * DFF, PLE = 256, INC = 9224;
constexpr float EPS = 1e-6f;
constexpr size_t MiB = 1u << 20;
constexpr size_t WS_CTL = 0, CTL_ZERO_BYTES = 1 * MiB;
constexpr size_t WS_F = 1 * MiB;
constexpr size_t WS_CUM = WS_F + 512 * 1024;
constexpr size_t WS_WSB = 2 * MiB;
constexpr size_t WS_PLSE = 3 * MiB;
constexpr size_t WS_PART = 148 * MiB;
constexpr size_t WS_Z = 4 * MiB;
constexpr size_t WS_Y = 148 * MiB;
constexpr size_t WS_E = 100 * MiB;
constexpr size_t WS_A2 = 132 * MiB;
constexpr size_t WS_HALO = 165 * MiB, WS_FA = 167 * MiB, WS_FB = 169 * MiB;
constexpr size_t WS_WUP = 180 * MiB, WS_WDOWN = 224 * MiB, WS_WGATE = 246 * MiB, WS_WPLE = 254 * MiB, WS_PB = 255 * MiB;
constexpr size_t WS_H = 259 * MiB;
constexpr size_t WS_WIN = 291 * MiB, WS_WAB = 327 * MiB, WS_WOUT = 335 * MiB;
constexpr size_t WS_HM = 4 * MiB;
constexpr size_t WS_END = 347 * MiB;
constexpr int CW_BAR = 4096, CW_GQ = 8192, CW_AFLAG = 9216, CW_SSQ1 = 16384, CW_SSQ2 = 24576, CW_SSQE = 32768, CW_VS1 = 40960, CW_VS2 = 49152;

constexpr int RING_BYTES = 131072;
constexpr int LDSCTL_OFF = 143360, MISC_OFF = LDSCTL_OFF + 320;
constexpr int LDS_BYTES = 147456;
constexpr int P0_WF_OFF = 67584;
static_assert(4 * 16640 <= P0_WF_OFF && P0_WF_OFF + 65536 <= LDSCTL_OFF && 8 * 16640 <= LDSCTL_OFF && fox::LDS_BYTES <= RING_BYTES && MISC_OFF + 128 <= LDS_BYTES, "LDS map");

#define GAS __attribute__((address_space(1)))
#define LAS __attribute__((address_space(3)))
typedef unsigned short bf16;
typedef unsigned v4u __attribute__((ext_vector_type(4)));
typedef float f32x4 __attribute__((ext_vector_type(4)));
#define RLX_AGENT __ATOMIC_RELAXED, __HIP_MEMORY_SCOPE_AGENT
#define LDS_WAIT() asm volatile("s_waitcnt lgkmcnt(0)" ::: "memory")
__device__ __forceinline__ unsigned f2bf(float f) { unsigned u = __builtin_bit_cast(unsigned, f); return (u + 0x7fffu + ((u >> 16) & 1u)) >> 16; }
__device__ __forceinline__ unsigned pk2(float lo, float hi) { unsigned r; asm("v_cvt_pk_bf16_f32 %0, %1, %2" : "=v"(r) : "v"(lo), "v"(hi)); return r; }
__device__ __forceinline__ float bflo(unsigned w) { return __uint_as_float(w << 16); }
__device__ __forceinline__ float bfhi(unsigned w) { return __uint_as_float(w & 0xffff0000u); }

#define XB_TMO      128
#define XB_XCNT(j)  (256  + 64 * (j))
#define XB_XSUB(j)  (1280 + 64 * (j))
#define XB_XGEN(j)  (2304 + 64 * (j))
#define XB_TOP      3328
#define XB_TOPGEN   3392
#define XCD_BAR_WORDS 3456
#define XB_SPIN_CAP (1u << 18)
__device__ __forceinline__ unsigned xb_ld(unsigned* p)              { return __hip_atomic_load(p, __ATOMIC_RELAXED, __HIP_MEMORY_SCOPE_AGENT); }
__device__ __forceinline__ unsigned xb_add(unsigned* p, unsigned v) { return __hip_atomic_fetch_add(p, v, __ATOMIC_RELAXED, __HIP_MEMORY_SCOPE_AGENT); }
__device__ __forceinline__ unsigned xb_xcc_id() { return (unsigned)__builtin_amdgcn_s_getreg((3 << 11) | 20) & 0xFu; }
#define XB_SPIN(cond, bar) do { unsigned _sp = 0; while (cond) { __builtin_amdgcn_s_sleep(1); \
    if ((++_sp & 255u) == 0u) { if (xb_ld(&(bar)[XB_TMO])) break; if (_sp > XB_SPIN_CAP) { atomicAdd(&(bar)[XB_TMO], 1u); break; } } } } while (0)
struct XcdBarrier { unsigned* bar; unsigned x; volatile LAS unsigned* st; };
__device__ __forceinline__ XcdBarrier xcd_barrier_post(unsigned* bar, volatile LAS unsigned* st) {
    XcdBarrier b; b.bar = bar; b.x = xb_xcc_id(); b.st = st;
    if (threadIdx.x == 0) (void)xb_add(&bar[XB_XCNT(b.x)], 1u);
    return b;
}
__device__ __forceinline__ void xcd_barrier_complete(unsigned* bar, unsigned x, unsigned& nloc, unsigned& nx) {
    const unsigned G = gridDim.x * gridDim.y * gridDim.z;
    unsigned sum, cnt, mine, sp = 0u;
    for (;;) {
        sum = 0u; cnt = 0u; mine = 0u;
#pragma unroll
        for (unsigned j = 0; j < 16; ++j) { const unsigned c = xb_ld(&bar[XB_XCNT(j)]); sum += c; cnt += (c > 0u) ? 1u : 0u; mine = (j == x) ? c : mine; }
        if (sum == G) break;
        __builtin_amdgcn_s_sleep(1);
        if ((++sp & 255u) == 0u) { if (xb_ld(&bar[XB_TMO])) break; if (sp > XB_SPIN_CAP) { atomicAdd(&bar[XB_TMO], 1u); break; } }
    }
    nloc = mine > 0u ? mine : 1u; nx = cnt > 0u ? cnt : 1u;
}
__device__ __forceinline__ void xcd_barrier(const XcdBarrier& b) {
    asm volatile("s_waitcnt vmcnt(0)" ::: "memory");
    __syncthreads();
    if (threadIdx.x == 0) {
        unsigned* bar = b.bar;
        __builtin_amdgcn_s_waitcnt(0);
        unsigned nloc = b.st[0], nx = b.st[1];
        if (nloc == 0u) { xcd_barrier_complete(bar, b.x, nloc, nx); b.st[0] = nloc; b.st[1] = nx; }
        const unsigned old = xb_add(&bar[XB_XSUB(b.x)], 1u);
        const unsigned gen = old / nloc;
        if (old + 1u == (gen + 1u) * nloc) {
            __builtin_amdgcn_fence(__ATOMIC_RELEASE, "agent");
            asm volatile("s_waitcnt vmcnt(0)" ::: "memory");
            const unsigned og = xb_add(&bar[XB_TOP], 1u);
            const unsigned tg = og / nx;
            if (og + 1u == (tg + 1u) * nx) xb_add(&bar[XB_TOPGEN], 1u);
            else XB_SPIN(xb_ld(&bar[XB_TOPGEN]) == tg, bar);
            __builtin_amdgcn_fence(__ATOMIC_ACQUIRE, "agent");
            xb_add(&bar[XB_XGEN(b.x)], 1u);
            asm volatile("s_waitcnt vmcnt(0)" ::: "memory");
        } else {
            XB_SPIN(xb_ld(&bar[XB_XGEN(b.x)]) == gen, bar);
            __builtin_amdgcn_fence(__ATOMIC_ACQUIRE, "agent");
            asm volatile("s_waitcnt vmcnt(0)" ::: "memory");
        }
    }
    __syncthreads();
}

__device__ __forceinline__ float wave_sum(float v) {
    v += __int_as_float(__builtin_amdgcn_update_dpp(0, __float_as_int(v), 0xB1, 0xf, 0xf, false));
    v += __int_as_float(__builtin_amdgcn_update_dpp(0, __float_as_int(v), 0x4E, 0xf, 0xf, false));
    v += __int_as_float(__builtin_amdgcn_update_dpp(0, __float_as_int(v), 0x141, 0xf, 0xf, false));
    v += __int_as_float(__builtin_amdgcn_update_dpp(0, __float_as_int(v), 0x140, 0xf, 0xf, false));
    { auto r = __builtin_amdgcn_permlane16_swap(__float_as_uint(v), __float_as_uint(v), false, false); v = __uint_as_float(r[0]) + __uint_as_float(r[1]); }
    { auto r = __builtin_amdgcn_permlane32_swap(__float_as_uint(v), __float_as_uint(v), false, false); v = __uint_as_float(r[0]) + __uint_as_float(r[1]); }
    return v;
}
struct TPtrs { const float *w_in, *wa, *wb, *wout, *wup, *wdown, *wgate, *wple, *g_up, *g_gate; bf16 *WIN, *WAB, *WOUT, *WUP, *WDOWN, *WGATE, *WPLE; };
constexpr int TI1 = 32 * 80, TI2 = 32 * 64, TI3 = 16 * 32, TI4 = 16 * 32, TI5 = 32 * 32, TI6 = 32 * 176, TI7 = 88 * 32, TI8 = 32 * 32, TI9 = 4 * 32;
constexpr int TG0 = TI1 + TI2, TG1 = TI3 + TI4 + TI5 + TI6, TG2 = TI7 + TI8 + TI9;
template <int GRP> __device__ __forceinline__ void t_decode(const TPtrs& P, int r, int lane, const float*& src, int& ldw, bf16*& dst, int& ldk, const float*& gain) {
    const float* W; bf16* WT; int k0, scol, drow, dk0; const float* gn = nullptr;
    if (GRP == 0) {
        if (r < TI1) { const int kb = r / 80, nb = r % 80; W = P.w_in; ldw = 9224; k0 = 64 * kb; scol = 64 * nb; WT = P.WIN; ldk = 2048; drow = 64 * nb; dk0 = k0; }
        else { r -= TI1; const int kb = r / 64, nb = r % 64; W = P.w_in; ldw = 9224; k0 = 64 * kb; scol = 5128 + 64 * nb; WT = P.WIN; ldk = 2048; dk0 = k0;
               const int o = 64 * nb, c = o < 2048 ? o : o - 2048; drow = 5120 + 256 * (c >> 7) + (c & 127) + (o < 2048 ? 0 : 128); }
    } else if (GRP == 1) {
        if (r < TI3) { const int kb = r / 32, nb = r % 32; W = P.wa; ldw = 2048; k0 = 64 * kb; scol = 64 * nb; WT = P.WAB; ldk = 2048; drow = 64 * nb; dk0 = k0; }
        else if (r < TI3 + TI4) { r -= TI3; const int kb = r / 32, nb = r % 32; W = P.wb; ldw = 2048; k0 = 64 * kb; scol = 64 * nb; WT = P.WAB; ldk = 2048; drow = 64 * nb; dk0 = 1024 + k0; }
        else if (r < TI3 + TI4 + TI5) { r -= TI3 + TI4; const int kb = r / 32, nb = r % 32; W = P.wout; ldw = 2048; k0 = 64 * kb; scol = 64 * nb; WT = P.WOUT; ldk = 2048; drow = 64 * nb; dk0 = k0; }
        else { r -= TI3 + TI4 + TI5; const int kb = r / 176, nb = r % 176; W = P.wup; ldw = 11264; k0 = 64 * kb; scol = 64 * nb; const int mm = scol < 5632 ? scol : scol - 5632;
               WT = P.WUP; ldk = 2048; drow = 256 * (mm >> 7) + (mm & 127) + (scol < 5632 ? 0 : 128); dk0 = k0; gn = P.g_up; }
    } else {
        if (r < TI7) { const int kb = r / 32, nb = r % 32; W = P.wdown; ldw = 2048; k0 = 64 * kb; scol = 64 * nb; WT = P.WDOWN; ldk = 5632; drow = 64 * nb; dk0 = k0; }
        else if (r < TI7 + TI8) { r -= TI7; const int kb = r / 32, nb = r % 32; W = P.wgate; ldw = 2048; k0 = 64 * kb; scol = 64 * nb; WT = P.WGATE; ldk = 2048; drow = 64 * nb; dk0 = k0; gn = P.g_gate; }
        else { r -= TI7 + TI8; const int kb = r / 32, nb = r % 32; W = P.wple; ldw = 2048; k0 = 64 * kb; scol = 64 * nb; WT = P.WPLE; ldk = 256; drow = 64 * nb; dk0 = k0; }
    }
    src = W + (size_t)(k0 + (lane >> 4)) * ldw + scol + 4 * (lane & 15);
    dst = WT + (size_t)(drow + (lane >> 3)) * ldk + dk0 + 8 * (lane & 7);
    gain = gn ? gn + k0 + (lane >> 4) : nullptr;
}
template <int GRP> __device__ __forceinline__ void run_transposes(const TPtrs& P, int first, int stride, LAS float* scr, int lane) {
    constexpr int NIT = GRP == 0 ? TG0 : (GRP == 1 ? TG1 : TG2);
    int it = first; if (it >= NIT) return;
    const float* src; bf16* dst; int ldw, ldk; const float* gain;
    t_decode<GRP>(P, it, lane, src, ldw, dst, ldk, gain);
    f32x4 v[16]; float gv[16];
#pragma unroll
    for (int i = 0; i < 16; ++i) v[i] = *(const GAS f32x4*)(src + (size_t)(4 * i) * ldw);
#pragma unroll
    for (int i = 0; i < 16; ++i) gv[i] = (GRP != 0 && gain) ? gain[4 * i] : 1.0f;
    const int kr = lane >> 4, nq = lane & 15, c = lane & 7;
    for (;;) {
#pragma unroll
        for (int i = 0; i < 16; ++i) { LAS float* d = scr + (4 * i + kr) * 65 + 4 * nq; const f32x4 t = v[i] * gv[i]; d[0] = t.x; d[1] = t.y; d[2] = t.z; d[3] = t.w; }
        const int nit = it + stride; const bool more = nit < NIT;
        bf16* cdst = dst; const int cldk = ldk;
        if (more) { t_decode<GRP>(P, nit, lane, src, ldw, dst, ldk, gain);
#pragma unroll
            for (int i = 0; i < 16; ++i) v[i] = *(const GAS f32x4*)(src + (size_t)(4 * i) * ldw);
#pragma unroll
            for (int i = 0; i < 16; ++i) gv[i] = (GRP != 0 && gain) ? gain[4 * i] : 1.0f; }
        LDS_WAIT(); asm volatile("" ::: "memory");
#pragma unroll
        for (int j = 0; j < 8; ++j) { const LAS float* sp = scr + (8 * c) * 65 + (lane >> 3) + 8 * j;
            v4u o; o.x = pk2(sp[0 * 65], sp[1 * 65]); o.y = pk2(sp[2 * 65], sp[3 * 65]); o.z = pk2(sp[4 * 65], sp[5 * 65]); o.w = pk2(sp[6 * 65], sp[7 * 65]);
            *(GAS v4u*)(cdst + (size_t)(8 * j) * cldk) = o; }
        LDS_WAIT(); asm volatile("" ::: "memory");
        if (!more) break;
        it = nit;
    }
}

__device__ __forceinline__ void conv_fixup_rows(int pm, int ch, bf16* HM, const float* HALO, const float* FA, const float* FB, const float* conv_w, const float* conv_b) {
    const int c = ch * 8;
    float o0[8], o1[8];
#pragma unroll
    for (int h = 0; h < 2; ++h) { const int cc = c + 4 * h;
        const f32x4 w0 = *(const f32x4*)(conv_w + cc), w1 = *(const f32x4*)(conv_w + DFF + cc), w2 = *(const f32x4*)(conv_w + 2 * DFF + cc), cbv = *(const f32x4*)(conv_b + cc);
        const f32x4 am2 = *(const f32x4*)(HALO + (size_t)((pm - 1) * 2 + 0) * DFF + cc), am1 = *(const f32x4*)(HALO + (size_t)((pm - 1) * 2 + 1) * DFF + cc);
        const f32x4 a0 = *(const f32x4*)(FA + (size_t)(pm * 2 + 0) * DFF + cc), a1 = *(const f32x4*)(FA + (size_t)(pm * 2 + 1) * DFF + cc);
        const f32x4 b0 = *(const f32x4*)(FB + (size_t)(pm * 2 + 0) * DFF + cc), b1 = *(const f32x4*)(FB + (size_t)(pm * 2 + 1) * DFF + cc);
#pragma unroll
        for (int q = 0; q < 4; ++q) { o0[4 * h + q] = pg8::EpiUpConv::gelu_t(cbv[q] + w0[q] * am2[q] + w1[q] * am1[q] + w2[q] * a0[q]) * b0[q];
                                      o1[4 * h + q] = pg8::EpiUpConv::gelu_t(cbv[q] + w0[q] * am1[q] + w1[q] * a0[q] + w2[q] * a1[q]) * b1[q]; } }
    v4u ov; ov.x = pk2(o0[0], o0[1]); ov.y = pk2(o0[2], o0[3]); ov.z = pk2(o0[4], o0[5]); ov.w = pk2(o0[6], o0[7]);
    *(v4u*)(HM + (size_t)(pm * 256) * DFF + c) = ov;
    ov.x = pk2(o1[0], o1[1]); ov.y = pk2(o1[2], o1[3]); ov.z = pk2(o1[4], o1[5]); ov.w = pk2(o1[6], o1[7]);
    *(v4u*)(HM + (size_t)(pm * 256 + 1) * DFF + c) = ov;
}

struct Args { const float* in[23]; float* out; unsigned char* ws; int ph_lo, ph_hi, one, pad; };

__global__ void __launch_bounds__(NWAVES * 64, 2) mega_fwd(Args args) {
    extern __shared__ __attribute__((aligned(16))) unsigned char lds[];
    LAS unsigned char* ldsL = (LAS unsigned char*)lds;
    volatile LAS unsigned* MISC = (volatile LAS unsigned*)(ldsL + MISC_OFF);
    const int tid = threadIdx.x, lane = tid & 63, wave = __builtin_amdgcn_readfirstlane(tid >> 6);
    const int G = gridDim.x; const int bx = blockIdx.x; const int vcu = (G % 8 == 0) ? (bx % 8) * (G / 8) + bx / 8 : bx;
    unsigned char* ws = args.ws;
    unsigned* ctl = (unsigned*)(ws + WS_CTL);
    const float* x = args.in[0]; const float* pin = args.in[1]; const float* norm_mix_g = args.in[2]; const float* w_in = args.in[3];
    const float* gmlp_ln_g = args.in[4]; const float* gmlp_ln_b = args.in[5]; const float* gmlp_w_s = args.in[6]; const float* gmlp_b_s = args.in[7];
    const float* fox_b_f = args.in[8]; const float* q_norm_g = args.in[9]; const float* k_norm_g = args.in[10];
    const float* w_branch_a = args.in[11]; const float* w_branch_b = args.in[12]; const float* w_out = args.in[13]; const float* norm_ffn_g = args.in[14];
    const float* w_up = args.in[15]; const float* conv_w = args.in[16]; const float* conv_b = args.in[17]; const float* w_down = args.in[18];
    const float* ple_proj = args.in[19]; const float* ple_norm_g = args.in[20]; const float* ple_gate_norm_g = args.in[21]; const float* w_ple_gate = args.in[22];
    float* out = args.out;
    float* Fb = (float*)(ws + WS_F); float* CUM = (float*)(ws + WS_CUM); bf16* WSB = (bf16*)(ws + WS_WSB);
    bf16* Z = (bf16*)(ws + WS_Z); bf16* Y = (bf16*)(ws + WS_Y); bf16* EB = (bf16*)(ws + WS_E); bf16* A2 = (bf16*)(ws + WS_A2);
    bf16* WUP = (bf16*)(ws + WS_WUP); bf16* WDOWN = (bf16*)(ws + WS_WDOWN); bf16* WGATE = (bf16*)(ws + WS_WGATE); bf16* WPLE = (bf16*)(ws + WS_WPLE);
    bf16* PB = (bf16*)(ws + WS_PB); bf16* H = (bf16*)(ws + WS_H); bf16* WIN = (bf16*)(ws + WS_WIN); bf16* WAB = (bf16*)(ws + WS_WAB); bf16* WOUT = (bf16*)(ws + WS_WOUT);
    bf16* HM = (bf16*)(ws + WS_HM); float* HALO = (float*)(ws + WS_HALO); float* FA = (float*)(ws + WS_FA); float* FB = (float*)(ws + WS_FB); bf16* OAB = (bf16*)out;
#define MAKE_TP() TPtrs TP; TP.w_in = args.in[3]; TP.wa = args.in[11]; TP.wb = args.in[12]; TP.wout = args.in[13]; TP.wup = args.in[15]; TP.wdown = args.in[18]; TP.wgate = args.in[22]; TP.wple = args.in[19]; TP.g_up = args.in[14]; TP.g_gate = args.in[21]; \
    TP.WIN = (bf16*)(args.ws + WS_WIN); TP.WAB = (bf16*)(args.ws + WS_WAB); TP.WOUT = (bf16*)(args.ws + WS_WOUT); TP.WUP = (bf16*)(args.ws + WS_WUP); TP.WDOWN = (bf16*)(args.ws + WS_WDOWN); TP.WGATE = (bf16*)(args.ws + WS_WGATE); TP.WPLE = (bf16*)(args.ws + WS_WPLE)
    float* VS1 = (float*)(ctl + CW_VS1); float* VS2 = (float*)(ctl + CW_VS2);
    float* SSQ1 = (float*)(ctl + CW_SSQ1); float* SSQ2 = (float*)(ctl + CW_SSQ2); float* SSQE = (float*)(ctl + CW_SSQE);

    for (int u = tid; u < (LDS_BYTES - LDSCTL_OFF) / 4; u += NWAVES * 64) ((LAS unsigned*)(ldsL + LDSCTL_OFF))[u] = 0u;
    __syncthreads();
    XcdBarrier bar; bar.bar = ctl + CW_BAR; bar.x = 0; bar.st = nullptr;
    if (args.one) bar = xcd_barrier_post(ctl + CW_BAR, MISC + 8);
    const int lo = args.ph_lo, hi = args.ph_hi;
#ifndef PROBE_PHASE
#define PROBE_PHASE (-1)
#endif
#ifndef PROBE_SCALE
#define PROBE_SCALE 5000.0f
#endif
    unsigned long long pr_prev = 0; float pr_us = 0.f;
    if (PROBE_PHASE >= 0) pr_prev = __builtin_amdgcn_s_memrealtime();
#define PR_STAMP(k) do { if (PROBE_PHASE >= 0) { const unsigned long long t_ = __builtin_amdgcn_s_memrealtime(); if ((k) == PROBE_PHASE) pr_us = (float)(t_ - pr_prev) * 0.01f; pr_prev = t_; } } while (0)
#ifndef PH_MASK
#define PH_MASK 0x3ff
#endif
#define IN(k) ((((PH_MASK) >> (k)) & 1) && lo <= (k) && (k) < hi)
#define GRID_BAR(k) do { if (IN(k) && IN((k) + 1)) xcd_barrier(bar); } while (0)
    const int gw = vcu * NWAVES + wave, NGW = G * NWAVES;
    const int gt = vcu * (NWAVES * 64) + tid, NGT = G * NWAVES * 64;

    if (IN(0)) {
        { LAS float* wf = (LAS float*)(ldsL + P0_WF_OFF);
          for (int k = tid; k < DM; k += NWAVES * 64) { const f32x4 a = *(const f32x4*)(w_in + (size_t)k * INC + 5120), b = *(const f32x4*)(w_in + (size_t)k * INC + 5124);
              wf[0 * DM + k] = a[0]; wf[1 * DM + k] = a[1]; wf[2 * DM + k] = a[2]; wf[3 * DM + k] = a[3]; wf[4 * DM + k] = b[0]; wf[5 * DM + k] = b[1]; wf[6 * DM + k] = b[2]; wf[7 * DM + k] = b[3]; }
          __syncthreads(); }
        if (wave < 4) {
        const int gw = vcu * 4 + wave, NGW = G * 4, gt = vcu * 256 + tid, NGT = G * 256;
        { const LAS float* wf = (const LAS float*)(ldsL + P0_WF_OFF);
          f32x4 g4v[8];
#pragma unroll
          for (int j = 0; j < 8; ++j) g4v[j] = *((const GAS f32x4*)norm_mix_g + lane + 64 * j);
          f32x4 v[8], nv[8];
          if (gw < M) {
#pragma unroll
              for (int j = 0; j < 8; ++j) v[j] = ((const GAS f32x4*)(x + (size_t)gw * DM) + lane)[64 * j]; }
          for (int m = gw; m < M; m += NGW) {
            if (m + NGW < M) {
#pragma unroll
                for (int j = 0; j < 8; ++j) nv[j] = ((const GAS f32x4*)(x + (size_t)(m + NGW) * DM) + lane)[64 * j]; }
            float s = 0.f;
#pragma unroll
            for (int j = 0; j < 8; ++j) s += (v[j].x * v[j].x + v[j].y * v[j].y) + (v[j].z * v[j].z + v[j].w * v[j].w);
            const float rstd = 1.0f / sqrtf(wave_sum(s) * (1.0f / DM) + EPS);
            float fa[8];
#pragma unroll
            for (int f = 0; f < 8; ++f) fa[f] = 0.f;
            GAS unsigned long long* o8 = (GAS unsigned long long*)(H + (size_t)m * DM) + lane;
#pragma unroll
            for (int j = 0; j < 8; ++j) { const f32x4 h4 = v[j] * rstd * g4v[j];
                o8[64 * j] = (unsigned long long)pk2(h4.x, h4.y) | ((unsigned long long)pk2(h4.z, h4.w) << 32);
#pragma unroll
                for (int f = 0; f < 8; ++f) { const f32x4 w4 = *(const LAS f32x4*)(wf + f * DM + 256 * j + 4 * lane); fa[f] += (h4.x * w4.x + h4.y * w4.y) + (h4.z * w4.z + h4.w * w4.w); }
                asm volatile("" ::: "memory"); }
#pragma unroll
            for (int f = 0; f < 8; ++f) fa[f] = wave_sum(fa[f]);
            if (lane < 8) {
                float fv = fa[0];
#pragma unroll
                for (int f = 1; f < 8; ++f) fv = (lane == f) ? fa[f] : fv;
                const float xx = fv + fox_b_f[lane];
                Fb[(size_t)((m >> 11) * 8 + lane) * SEQ + (m & (SEQ - 1))] = fminf(xx, 0.f) - log1pf(expf(-fabsf(xx))); }
#pragma unroll
            for (int j = 0; j < 8; ++j) v[j] = nv[j];
          } }
        for (int i = gt; i < M * PLE / 8; i += NGT) { const f32x4 a = *(const f32x4*)(pin + (size_t)i * 8), b = *(const f32x4*)(pin + (size_t)i * 8 + 4);
            v4u o; o.x = pk2(a.x, a.y); o.y = pk2(a.z, a.w); o.z = pk2(b.x, b.y); o.w = pk2(b.z, b.w); *(v4u*)(PB + (size_t)i * 8) = o; }
        for (int i = gt; i < 8 * 128 * 128 / 8; i += NGT) { const int e = i * 8, t = (e >> 7) & 127, s0 = e & 127; const f32x4 a = *(const f32x4*)(gmlp_w_s + e), b = *(const f32x4*)(gmlp_w_s + e + 4);
            float w[8] = {a.x, a.y, a.z, a.w, b.x, b.y, b.z, b.w};
#pragma unroll
            for (int q = 0; q < 8; ++q) if (s0 + q > t) w[q] = 0.f;
            v4u o; o.x = pk2(w[0], w[1]); o.y = pk2(w[2], w[3]); o.z = pk2(w[4], w[5]); o.w = pk2(w[6], w[7]); *(v4u*)(WSB + e) = o; }
        } else {
            MAKE_TP(); run_transposes<0>(TP, vcu * 4 + (wave - 4), G * 4, (LAS float*)(ldsL + (wave - 4) * 16640), lane);
        }
        __syncthreads();
    }
    GRID_BAR(0); PR_STAMP(0);

    if (IN(1)) {
        pg8::Gemm g{H, WIN, M, NZ, DM}; pg8::StaticOrder S; S.init(M, NZ, G, bx);
        pg8::EpiZ E{Z, VS1, VS2, q_norm_g, k_norm_g, (LAS float*)(ldsL + RING_BYTES)};
        pg8::gemm_phase<pg8::EpiZ, pg8::StaticOrder, true, true>(ldsL, g, S, E);
        { const int rem = S.nwg % G; const int nidle = rem ? G - rem : G, idle = rem ? bx - rem : bx;
          if (idle >= 0) { MAKE_TP(); run_transposes<1>(TP, idle * NWAVES + wave, nidle * NWAVES, (LAS float*)(ldsL + wave * 16640), lane); } }
    }
    GRID_BAR(1); PR_STAMP(1);

    PR_STAMP(2);

    if (IN(3)) {
        int msid0 = -1, msid1 = -1;
        for (int it = vcu; it < 512; it += G) {
            const int item = it & 255, pc = it >> 8;
            const int bh = item >> 3, sl = item & 7, b = bh >> 3, h = bh & 7;
            const size_t rowb = (size_t)b * SEQ;
            if (pc == 1 && sl < 5) continue;
            int qb, t0, t1;
            if (pc == 0) { qb = sl == 0 ? 7 : sl == 1 ? 6 : sl == 2 ? 5 : sl == 3 ? 4 : sl == 4 ? 3 : sl == 5 ? 7 : sl == 6 ? 2 : 6;
                           t0 = (sl == 5 || sl == 7) ? 20 : 0;
                           t1 = sl < 4 ? 20 : sl == 4 ? 16 : sl == 5 ? 32 : sl == 6 ? 12 : 28; }
            else { qb = sl == 5 ? 5 : sl == 6 ? 0 : 1; t0 = sl == 5 ? 20 : 0; t1 = sl == 5 ? 24 : sl == 6 ? 4 : 8; }
            const bool split = qb >= 5; const int me = t0 ? 1 : 0, sid = bh * 4 + (qb - 4);
            fox::BlockRef cur; cur.P0 = qb * 256 - t0 * 64;
            cur.Q = Z + (rowb + qb * 256) * NZ + 2048 + h * 128; cur.K = Z + (rowb + t0 * 64) * NZ + 3072 + h * 128; cur.V = Z + (rowb + t0 * 64) * NZ + 4096 + h * 128;
            cur.O = split ? (bf16*)(ws + WS_PART) + (rowb + qb * 256) * 2048 + me * 1024 + h * 128 : OAB + (rowb + qb * 256) * 2048 + 1024 + h * 128;
            float* cumL = (float*)(lds + fox::LDS_CUM);
            {
              float* wsum = (float*)(lds + fox::LDS_WS);
              int tq; asm volatile("v_mov_b32 %0, %1" : "=v"(tq) : "v"(tid));
              const int nk = t1 * 64; const bool act = 4 * tq < nk;
              float v[4];
              { f32x4 ls = (f32x4){0.f, 0.f, 0.f, 0.f}; if (act) ls = *(const f32x4*)(Fb + (size_t)bh * SEQ + 4 * tq); v[0] = ls[0]; v[1] = ls[1]; v[2] = ls[2]; v[3] = ls[3]; }
              v[1] += v[0]; v[2] += v[1]; v[3] += v[2];
              const float tot = v[3]; float incl = tot;
#pragma unroll
              for (int o = 1; o < 64; o <<= 1) { const float t = __shfl_up(incl, o); if (lane >= o) incl += t; }
              if (lane == 63) wsum[wave] = incl;
              __syncthreads();
              float off = incl - tot;
              for (int w = 0; w < wave; ++w) off += wsum[w];
              const float isc = -11.313708498984761f;
              if (act) *(f32x4*)(cumL + 4 * tq) = (f32x4){(v[0] + off) * isc, (v[1] + off) * isc, (v[2] + off) * isc, (v[3] + off) * isc}; }
            { fox::Seam S;
              fox::fox_prime(cur, (char*)lds, S);
              fox::fox_block(cur, (char*)lds, S, cumL + t0 * 64, t1 - t0, split ? (float*)(ws + WS_PLSE) + (size_t)(sid * 2 + me) * 256 : nullptr); }
            if (split) {
                asm volatile("s_waitcnt vmcnt(0)" ::: "memory");
                __syncthreads();
                if (tid == 0) MISC[17] = atomicAdd(ctl + CW_AFLAG + sid, 1u);
                __syncthreads();
                if (MISC[17] == 1u) { if (msid0 < 0) msid0 = sid; else msid1 = sid; }
                __syncthreads();
            }
        }
        for (int mi = 0; mi < 2; ++mi) { const int sid = mi ? msid1 : msid0; if (sid < 0) continue;
            const int bh = sid >> 2, qb = 4 + (sid & 3), b = bh >> 3, h = bh & 7; const size_t rowb = (size_t)b * SEQ;
            __builtin_amdgcn_fence(__ATOMIC_ACQUIRE, "agent");
            asm volatile("s_waitcnt vmcnt(0)" ::: "memory");
            const float* LB0 = (const float*)(ws + WS_PLSE) + (size_t)sid * 2 * 256;
            const int row = tid >> 1, c0 = (tid & 1) * 64;
            const float l0 = LB0[row], l1 = LB0[256 + row], mx = fmaxf(l0, l1);
            const float w0 = __builtin_amdgcn_exp2f(l0 - mx), w1 = __builtin_amdgcn_exp2f(l1 - mx), inv = __builtin_amdgcn_rcpf(w0 + w1), a0 = w0 * inv, a1 = w1 * inv;
            const bf16* p0 = (const bf16*)(ws + WS_PART) + (rowb + qb * 256 + row) * 2048 + h * 128 + c0; const bf16* p1 = p0 + 1024;
            bf16* op = OAB + (rowb + qb * 256 + row) * 2048 + 1024 + h * 128 + c0;
#pragma unroll 2
            for (int j = 0; j < 8; ++j) { const v4u x = *(const v4u*)(p0 + 8 * j), y = *(const v4u*)(p1 + 8 * j); v4u o;
                o.x = pk2(a0 * bflo(x.x) + a1 * bflo(y.x), a0 * bfhi(x.x) + a1 * bfhi(y.x)); o.y = pk2(a0 * bflo(x.y) + a1 * bflo(y.y), a0 * bfhi(x.y) + a1 * bfhi(y.y));
                o.z = pk2(a0 * bflo(x.z) + a1 * bflo(y.z), a0 * bfhi(x.z) + a1 * bfhi(y.z)); o.w = pk2(a0 * bflo(x.w) + a1 * bflo(y.w), a0 * bfhi(x.w) + a1 * bfhi(y.w));
                *(v4u*)(op + 8 * j) = o; }
        }
        for (;;) {
            if (tid == 0) MISC[16] = atomicAdd(ctl + CW_GQ, 1u);
            __syncthreads();
            const unsigned idx = MISC[16];
            __syncthreads();
            if (idx >= 512u) break;
            fox::gmlp_unit((char*)lds, (int)idx, Z, WSB, gmlp_b_s, OAB, VS1, VS2, gmlp_ln_g, gmlp_ln_b);
        }
    }
    GRID_BAR(3); PR_STAMP(3);

    if (IN(4)) {
        pg8::Gemm g{OAB, WAB, M, DM, 2048}; pg8::StaticOrder S; S.init(M, DM, G, bx);
        pg8::EpiY E{Z, Y};
        pg8::gemm_phase<pg8::EpiY, pg8::StaticOrder, true, true>(ldsL, g, S, E);
    }
    GRID_BAR(4); PR_STAMP(4);

    if (IN(5)) {
        pg8::Gemm g{Y, WOUT, M, DM, DM}; pg8::StaticOrder S; S.init(M, DM, G, bx);
        pg8::EpiRes<true> E{x, H, SSQ1};
        pg8::gemm_phase<pg8::EpiRes<true>, pg8::StaticOrder, true, true>(ldsL, g, S, E);
    }
    GRID_BAR(5); PR_STAMP(5);

    if (IN(6)) {
        pg8::Gemm g{H, WUP, M, NUP, DM}; pg8::StaticOrder S; S.init(M, NUP, G, bx);
        pg8::EpiUpConv E{HM, SSQ1, conv_w, conv_b, HALO, FA, FB, (LAS float*)(ldsL + RING_BYTES)};
        pg8::gemm_phase<pg8::EpiUpConv, pg8::StaticOrder, true, true>(ldsL, g, S, E);
        { const int rem = S.nwg % G; const int nidle = rem ? G - rem : G, idle = rem ? bx - rem : bx;
          if (idle >= 0) { MAKE_TP(); run_transposes<2>(TP, idle * NWAVES + wave, nidle * NWAVES, (LAS float*)(ldsL + wave * 16640), lane); } }
    }
    GRID_BAR(6); PR_STAMP(6);

    if (IN(8)) {
        { pg8::StaticOrder S; S.init(M, DM, G, bx); pg8::Unit u;
          for (int i = 0; S.next(i, u); ++i) if (u.pm & 7) for (int ch = tid; ch < DFF / 8; ch += NWAVES * 64) conv_fixup_rows(u.pm, ch, HM, HALO, FA, FB, conv_w, conv_b);
          asm volatile("s_waitcnt vmcnt(0)" ::: "memory"); __syncthreads(); }
        { pg8::Gemm g{HM, WDOWN, M, DM, DFF}; pg8::StaticOrder S; S.init(M, DM, G, bx);
          pg8::EpiRes<false> E{H, A2, SSQ2};
          pg8::gemm_phase<pg8::EpiRes<false>, pg8::StaticOrder, true, true>(ldsL, g, S, E); }
        { pg8::Gemm g{PB, WPLE, M, DM, PLE}; pg8::StaticOrder S; S.init(M, DM, G, bx);
          pg8::EpiE E{EB, SSQE};
          pg8::gemm_phase<pg8::EpiE, pg8::StaticOrder, true, true>(ldsL, g, S, E); }
    }
    GRID_BAR(8); PR_STAMP(8);

    if (IN(9)) {
        pg8::Gemm g{A2, WGATE, M, DM, DM}; pg8::StaticOrder S; S.init(M, DM, G, bx);
        pg8::EpiFinal E{out, A2, EB, ple_norm_g, SSQ2, SSQE};
        pg8::gemm_phase<pg8::EpiFinal, pg8::StaticOrder, true, true>(ldsL, g, S, E);
    }
    PR_STAMP(9);
    if (PROBE_PHASE >= 0 && bx == 0) {
        asm volatile("s_waitcnt vmcnt(0)" ::: "memory"); __syncthreads();
        if (tid == 0) { int best = 0; float bv = 1e30f; for (int i = 0; i < 256; ++i) { const float a = fabsf(out[i]); if (a < bv) { bv = a; best = i; } }
            out[best] += 0.04f + pr_us / PROBE_SCALE; }
    }
#undef IN
#undef GRID_BAR
}

extern "C" void kernel_launch(void* const* d_in, const int* in_sizes, int n_in, void* d_out, int out_size, void* d_ws, size_t ws_size, hipStream_t stream) {
    static int grid = 0;
    if (grid == 0) {
        if (n_in != 23 || out_size != M * DM || ws_size < WS_END) { fprintf(stderr, "kernel_launch: unexpected shapes (n_in %d, out %d, ws %zu)\n", n_in, out_size, ws_size); grid = -1; return; }
        int dev = 0, cus = 0, per_cu = 0;
        if (hipGetDevice(&dev) != hipSuccess || hipDeviceGetAttribute(&cus, hipDeviceAttributeMultiprocessorCount, dev) != hipSuccess) { grid = -1; return; }
        if (hipFuncSetAttribute((const void*)mega_fwd, hipFuncAttributeMaxDynamicSharedMemorySize, LDS_BYTES) != hipSuccess) { fprintf(stderr, "kernel_launch: hipFuncSetAttribute failed\n"); grid = -1; return; }
        if (hipOccupancyMaxActiveBlocksPerMultiprocessor(&per_cu, (const void*)mega_fwd, NWAVES * 64, LDS_BYTES) != hipSuccess || per_cu < 1) { fprintf(stderr, "kernel_launch: occupancy query says %d\n", per_cu); (void)hipGetLastError(); per_cu = 1; }
        grid = cus * (per_cu < 1 ? 1 : 1);
    }
    if (grid < 0) return;
    (void)hipMemsetAsync((char*)d_ws + WS_CTL, 0, CTL_ZERO_BYTES, stream);
    Args a{};
    for (int i = 0; i < 23; ++i) a.in[i] = (const float*)d_in[i];
    a.out = (float*)d_out; a.ws = (unsigned char*)d_ws;
    if (N_LAUNCHES == 1) {
        a.ph_lo = 0; a.ph_hi = N_PHASES; a.one = 1;
        void* kargs[] = {&a};
        hipError_t e = hipLaunchCooperativeKernel((const void*)mega_fwd, dim3(grid), dim3(NWAVES * 64), kargs, LDS_BYTES, stream);
        if (e != hipSuccess) fprintf(stderr, "kernel_launch: cooperative launch failed: %s (grid %d)\n", hipGetErrorString(e), grid);
    } else {
        for (int p = 0; p < N_PHASES; ++p) { a.ph_lo = p; a.ph_hi = p + 1; a.one = 0;
            hipLaunchKernelGGL(mega_fwd, dim3(grid), dim3(NWAVES * 64), LDS_BYTES, stream, a); }
    }
}
```

```cpp
#include <hip/hip_runtime.h>
#include <cstdio>
#include <cstdint>

#ifndef MK_N_LAUNCHES
#define MK_N_LAUNCHES 1
#endif

namespace pg8 {
#define PG8_LAS __attribute__((address_space(3)))
typedef unsigned short bf16_t;
typedef short bf16x8 __attribute__((ext_vector_type(8)));
typedef float f32x4 __attribute__((ext_vector_type(4)));
typedef float f32x2 __attribute__((ext_vector_type(2)));
typedef unsigned u32x4 __attribute__((ext_vector_type(4)));
constexpr int BM = 256, BK = 64, HALF = 128, HTB = HALF * BK * 2, STAGE_BYTES = 8 * HTB, NXCD = 8, WGM = 8;

__host__ __device__ __forceinline__ int lds_byte(int r, int c) { const int st = (r >> 4) * 2 + (c >> 5), rr = r & 15, cc = c & 31, ob = rr * 64 + cc * 2; return st * 1024 + (ob ^ (((ob >> 9) & 1) << 5)); }
__host__ __device__ __forceinline__ void stage_rc(int b, int& R, int& C) { const int st = b / 1024, sb = b % 1024, swz = sb ^ (((sb >> 9) & 1) << 5); R = (st >> 1) * 16 + swz / 64; C = (st & 1) * 32 + (swz % 64) / 2; }
__host__ __device__ __forceinline__ int perm32(int rho) { const int n = rho >> 4, i = rho & 15; return 8 * (i >> 2) + 4 * n + (i & 3); }

struct Unit { int pm, pn; };
struct Gemm { const bf16_t* A; const bf16_t* Bt; int M, N, K; };

struct StaticOrder {
    int nM, nN, nwg, G, c;
    __host__ __device__ __forceinline__ void init(int M, int N, int G_, int c_) { nM = M / BM; nN = N / BM; nwg = nM * nN; G = G_; c = c_; }
    __host__ __device__ __forceinline__ bool next(int i, Unit& u) const {
        const long L = (long)i * G + c; if (L >= nwg) return false;
        int wgid = (int)L; { const int q = nwg / NXCD, r = nwg % NXCD, xcd = wgid % NXCD, off = wgid / NXCD; wgid = (xcd < r ? xcd * (q + 1) : r * (q + 1) + (xcd - r) * q) + off; }
        const int nig = WGM * nN, gid = wgid / nig, fm = gid * WGM, gsz = (nM - fm) < WGM ? (nM - fm) : WGM;
        u.pm = fm + ((wgid % nig) % gsz); u.pn = (wgid % nig) / gsz; return true;
    }
    __device__ __forceinline__ void a_ready(const Unit&) const {}
    __device__ __forceinline__ void done(const Unit&) const {}
};

__device__ __forceinline__ unsigned cvt_pk_bf16(float lo, float hi) { unsigned r; asm volatile("v_cvt_pk_bf16_f32 %0, %1, %2" : "=v"(r) : "v"(lo), "v"(hi)); return r; }
__device__ __forceinline__ float xsum_fq(float x) {
    { auto r = __builtin_amdgcn_permlane16_swap(__float_as_uint(x), __float_as_uint(x), false, false); x = __uint_as_float(r[0]) + __uint_as_float(r[1]); }
    { auto r = __builtin_amdgcn_permlane32_swap(__float_as_uint(x), __float_as_uint(x), false, false); x = __uint_as_float(r[0]) + __uint_as_float(r[1]); }
    return x;
}
__device__ __forceinline__ float bf_lo(unsigned w) { return __uint_as_float(w << 16); }
__device__ __forceinline__ float bf_hi(unsigned w) { return __uint_as_float(w & 0xffff0000u); }
__device__ __forceinline__ f32x2 gelu_pk(f32x2 v) {
    const f32x2 av = __builtin_elementwise_abs(v), d = av * 0.2316418882f + 1.0f;
    f32x2 t; t.x = __builtin_amdgcn_rcpf(d.x); t.y = __builtin_amdgcn_rcpf(d.y);
    f32x2 q = t * 0.5307027145f + (-0.7265760135f); q = q * t + 0.7107068705f; q = q * t + (-0.142248368f); q = q * t + 0.127414796f; q = q * t;
    const f32x2 s = (v * v) * (-0.72134752044f);
    f32x2 e; e.x = __builtin_amdgcn_exp2f(s.x); e.y = __builtin_amdgcn_exp2f(s.y);
    const f32x2 m = v * (q * e), r = v - m;
    f32x2 o; o.x = v.x < 0.f ? m.x : r.x; o.y = v.y < 0.f ? m.y : r.y; return o;
}
__device__ __forceinline__ float sigmoid_f(float x) { return __builtin_amdgcn_rcpf(1.0f + __builtin_amdgcn_exp2f(-1.4426950408889634f * x)); }
__device__ __forceinline__ f32x4 gelu4(f32x4 v) { f32x2 a = gelu_pk((f32x2){v[0], v[1]}), b = gelu_pk((f32x2){v[2], v[3]}); return (f32x4){a.x, a.y, b.x, b.y}; }
__device__ __forceinline__ f32x4 sigm4(f32x4 v) { return (f32x4){sigmoid_f(v[0]), sigmoid_f(v[1]), sigmoid_f(v[2]), sigmoid_f(v[3])}; }
__device__ __forceinline__ u32x4 pack8(f32x4 a, f32x4 b) { u32x4 w; w.x = cvt_pk_bf16(a[0], a[1]); w.y = cvt_pk_bf16(a[2], a[3]); w.z = cvt_pk_bf16(b[0], b[1]); w.w = cvt_pk_bf16(b[2], b[3]); return w; }

typedef f32x4 Acc[2][2][4][2];
#define EPI_LOOP_ROWS for (int ai = 0; ai < 2; ++ai) _Pragma("unroll") for (int m = 0; m < 4; ++m)

constexpr int ZLD = 9216;
struct EpiZ {
    static constexpr bool PERM = true, AFTER_DRAIN = false, MIDK = false;
    bf16_t* Z; float* vs1; float* vs2; const float* gq; const float* gk; PG8_LAS float* red;
    __device__ __forceinline__ void mid(Acc&, const Unit&, int, int, int, int) const {}
    __device__ __forceinline__ void operator()(const Acc& acc, const Unit& u, int wr, int wc, int fr, int fq) const {
        const int mode = u.pn < 8 ? 1 : (u.pn < 20 ? 0 : 2); const bool isv = (u.pn >= 4 && u.pn < 8);
        const int row0 = u.pm * BM + wr * 64 + fr, col0 = u.pn * BM + wc * 32 + 8 * fq;
        if (u.pn >= 8 && u.pn < 16) {
            const float* gn = u.pn < 12 ? gq : gk;
            const f32x4 g0 = *(const f32x4*)(gn + wc * 32 + 8 * fq), g1 = *(const f32x4*)(gn + wc * 32 + 8 * fq + 4);
#pragma unroll
            EPI_LOOP_ROWS {
#pragma unroll
                for (int bj = 0; bj < 2; ++bj) { const f32x4 v0 = acc[ai][bj][m][0], v1 = acc[ai][bj][m][1];
                    float q2 = (v0[0] * v0[0] + v0[1] * v0[1]) + (v0[2] * v0[2] + v0[3] * v0[3]) + (v1[0] * v1[0] + v1[1] * v1[1]) + (v1[2] * v1[2] + v1[3] * v1[3]);
                    q2 = xsum_fq(q2);
                    if (fq == 0) red[(ai * HALF + wr * 64 + m * 16 + fr) * 8 + bj * 4 + wc] = q2; } }
            asm volatile("s_waitcnt lgkmcnt(0)" ::: "memory"); __builtin_amdgcn_s_barrier(); asm volatile("" ::: "memory");
#pragma unroll
            EPI_LOOP_ROWS { bf16_t* rowp = Z + (size_t)(row0 + ai * HALF + m * 16) * ZLD + col0;
#pragma unroll
                for (int bj = 0; bj < 2; ++bj) { const f32x4 p = *(const PG8_LAS f32x4*)(red + (ai * HALF + wr * 64 + m * 16 + fr) * 8 + bj * 4);
                    const float r = 1.0f / sqrtf(((p[0] + p[1]) + (p[2] + p[3])) * (1.0f / 128.0f) + 1e-6f);
                    *(u32x4*)(rowp + bj * HALF) = pack8(acc[ai][bj][m][0] * r * g0, acc[ai][bj][m][1] * r * g1); } }
            return;
        }
        if (mode == 2) {
#pragma unroll
            EPI_LOOP_ROWS { bf16_t* rowp = Z + (size_t)(row0 + ai * HALF + m * 16) * ZLD + col0;
                f32x4 rt[2], sb[2];
#pragma unroll
                for (int n = 0; n < 2; ++n) { const f32x4 ga = acc[ai][0][m][n] * (-1.4426950408889634f), gb = acc[ai][1][m][n] * (-1.4426950408889634f);
#pragma unroll
                    for (int i = 0; i < 4; ++i) { const float da = 1.0f + __builtin_amdgcn_exp2f(ga[i]), db = 1.0f + __builtin_amdgcn_exp2f(gb[i]);
                        sb[n][i] = __builtin_amdgcn_rcpf(db); rt[n][i] = db * __builtin_amdgcn_rcpf(da); } }
                *(u32x4*)rowp = pack8(rt[0], rt[1]); *(u32x4*)(rowp + HALF) = pack8(sb[0], sb[1]); }
            return;
        }
#pragma unroll
        EPI_LOOP_ROWS { bf16_t* rowp = Z + (size_t)(row0 + ai * HALF + m * 16) * ZLD + col0;
            float s1 = 0.f, s2 = 0.f;
#pragma unroll
            for (int bj = 0; bj < 2; ++bj) { f32x4 v0 = acc[ai][bj][m][0], v1 = acc[ai][bj][m][1];
                if (mode == 1) { v0 = gelu4(v0); v1 = gelu4(v1); } else if (mode == 2) { v0 = sigm4(v0); v1 = sigm4(v1); }
                if (isv) { s1 += (v0[0] + v0[1]) + (v0[2] + v0[3]) + (v1[0] + v1[1]) + (v1[2] + v1[3]);
                           s2 += (v0[0] * v0[0] + v0[1] * v0[1]) + (v0[2] * v0[2] + v0[3] * v0[3]) + (v1[0] * v1[0] + v1[1] * v1[1]) + (v1[2] * v1[2] + v1[3] * v1[3]); }
                *(u32x4*)(rowp + bj * HALF) = pack8(v0, v1); }
            if (isv) { s1 = xsum_fq(s1); s2 = xsum_fq(s2);
                       if (fq == 0) { atomicAdd(vs1 + row0 + ai * HALF + m * 16, s1); atomicAdd(vs2 + row0 + ai * HALF + m * 16, s2); } } }
    }
};
struct EpiY {
    static constexpr bool PERM = true, AFTER_DRAIN = false, MIDK = true;
    const bf16_t* Z; bf16_t* Y;
    __device__ __forceinline__ void mid(Acc& acc, const Unit& u, int wr, int wc, int fr, int fq) const {
        int opq; asm volatile("v_mov_b32 %0, 0" : "=v"(opq));
        const int row0 = u.pm * BM + wr * 64 + fr + opq, gc0 = 5120 + u.pn * 512 + wc * 32 + 8 * fq;
#pragma unroll
        EPI_LOOP_ROWS { const bf16_t* rowp = Z + (size_t)(row0 + ai * HALF + m * 16) * ZLD + gc0;
#pragma unroll
            for (int bj = 0; bj < 2; ++bj) { const u32x4 a = *(const u32x4*)(rowp + bj * 256);
                acc[ai][bj][m][0] *= (f32x4){bf_lo(a.x), bf_hi(a.x), bf_lo(a.y), bf_hi(a.y)}; acc[ai][bj][m][1] *= (f32x4){bf_lo(a.z), bf_hi(a.z), bf_lo(a.w), bf_hi(a.w)}; }
            if (m & 1) asm volatile("" ::: "memory"); }
    }
    __device__ __forceinline__ void operator()(const Acc& acc, const Unit& u, int wr, int wc, int fr, int fq) const {
        int opq; asm volatile("v_mov_b32 %0, 0" : "=v"(opq));
        const int row0 = u.pm * BM + wr * 64 + fr + opq, col0 = u.pn * BM + wc * 32 + 8 * fq, gc0 = 5120 + u.pn * 512 + wc * 32 + 8 * fq + 128;
#pragma unroll
        EPI_LOOP_ROWS { const int row = row0 + ai * HALF + m * 16; const bf16_t* rowp = Z + (size_t)row * ZLD + gc0;
#pragma unroll
            for (int bj = 0; bj < 2; ++bj) { const u32x4 b = *(const u32x4*)(rowp + bj * 256);
                const f32x4 s0 = (f32x4){bf_lo(b.x), bf_hi(b.x), bf_lo(b.y), bf_hi(b.y)}, s1 = (f32x4){bf_lo(b.z), bf_hi(b.z), bf_lo(b.w), bf_hi(b.w)};
                *(u32x4*)(Y + (size_t)row * 2048 + col0 + bj * HALF) = pack8(acc[ai][bj][m][0] * s0, acc[ai][bj][m][1] * s1); }
            if (m & 1) asm volatile("" ::: "memory"); }
    }
};
template <bool BASE_F32> struct EpiRes {
    static constexpr bool PERM = true, AFTER_DRAIN = false, MIDK = false;
    const void* base; bf16_t* xn; float* ssq;
    __device__ __forceinline__ void mid(Acc&, const Unit&, int, int, int, int) const {}
    __device__ __forceinline__ void operator()(const Acc& acc, const Unit& u, int wr, int wc, int fr, int fq) const {
        const int row0 = u.pm * BM + wr * 64 + fr, col0 = u.pn * BM + wc * 32 + 8 * fq;
#pragma unroll
        EPI_LOOP_ROWS { const int row = row0 + ai * HALF + m * 16; const size_t off = (size_t)row * 2048 + col0; float s = 0.f;
#pragma unroll
            for (int bj = 0; bj < 2; ++bj) { f32x4 b0, b1;
                if (BASE_F32) { b0 = *(const f32x4*)((const float*)base + off + bj * HALF); b1 = *(const f32x4*)((const float*)base + off + bj * HALF + 4); }
                else { const u32x4 w = *(const u32x4*)((const bf16_t*)base + off + bj * HALF); b0 = (f32x4){bf_lo(w.x), bf_hi(w.x), bf_lo(w.y), bf_hi(w.y)}; b1 = (f32x4){bf_lo(w.z), bf_hi(w.z), bf_lo(w.w), bf_hi(w.w)}; }
                const f32x4 x0 = b0 + acc[ai][bj][m][0], x1 = b1 + acc[ai][bj][m][1];
                s += (x0[0] * x0[0] + x0[1] * x0[1]) + (x0[2] * x0[2] + x0[3] * x0[3]) + (x1[0] * x1[0] + x1[1] * x1[1]) + (x1[2] * x1[2] + x1[3] * x1[3]);
                *(u32x4*)(xn + off + bj * HALF) = pack8(x0, x1); }
            s = xsum_fq(s);
            if (fq == 0) atomicAdd(ssq + row, s); }
    }
};
struct EpiUpConv {
    static constexpr bool PERM = true, AFTER_DRAIN = false, MIDK = false;
    bf16_t* HM; const float* ssq; const float* cw; const float* cb; float* HALO; float* FA; float* FB; PG8_LAS float* hl;
    __device__ __forceinline__ void mid(Acc&, const Unit&, int, int, int, int) const {}
    __device__ __forceinline__ static float gelu_t(float cv) { const float inner = cv + 0.044715f * cv * cv * cv; return cv * __builtin_amdgcn_rcpf(1.0f + __builtin_amdgcn_exp2f(-2.3022081986f * inner)); }
    __device__ __forceinline__ void operator()(const Acc& acc, const Unit& u, int wr, int wc, int fr, int fq) const {
        int opq; asm volatile("v_mov_b32 %0, 0" : "=v"(opq));
        const int lane = (int)(threadIdx.x & 63);
        const int cl = wc * 32 + 8 * fq, c0 = u.pn * 128 + cl + opq;
        const int rowg = u.pm * BM + wr * 64 + fr;
        float rr[2][4];
#pragma unroll
        for (int ai = 0; ai < 2; ++ai)
#pragma unroll
            for (int m = 0; m < 4; ++m) rr[ai][m] = 1.0f / sqrtf(ssq[rowg + ai * HALF + m * 16] * (1.0f / 2048.0f) + 1e-6f);
#pragma unroll
        for (int ai = 0; ai < 2; ++ai) if (fr >= 14) { const float r = rr[ai][3]; const f32x4 x0 = acc[ai][0][3][0] * r, x1 = acc[ai][0][3][1] * r;
            PG8_LAS float* d = hl + ((2 * ai + wr) * 2 + (fr - 14)) * 128 + cl; *(PG8_LAS f32x4*)d = x0; *(PG8_LAS f32x4*)(d + 4) = x1;
            if (ai == 1 && wr == 1) { float* gp = HALO + (size_t)(u.pm * 2 + (fr - 14)) * 5632 + c0; *(f32x4*)gp = x0; *(f32x4*)(gp + 4) = x1; } }
        if (wr == 0 && fr < 2) { const float r = rr[0][0]; float* ga = FA + (size_t)(u.pm * 2 + fr) * 5632 + c0; float* gb = FB + (size_t)(u.pm * 2 + fr) * 5632 + c0;
            *(f32x4*)ga = acc[0][0][0][0] * r; *(f32x4*)(ga + 4) = acc[0][0][0][1] * r; *(f32x4*)gb = acc[0][1][0][0] * r; *(f32x4*)(gb + 4) = acc[0][1][0][1] * r; }
        f32x2 w0[4], w1[4], w2[4], cbv[4];
        { const f32x4 a = *(const f32x4*)(cw + c0), b = *(const f32x4*)(cw + c0 + 4); w0[0] = (f32x2){a[0], a[1]}; w0[1] = (f32x2){a[2], a[3]}; w0[2] = (f32x2){b[0], b[1]}; w0[3] = (f32x2){b[2], b[3]}; }
        { const f32x4 a = *(const f32x4*)(cw + 5632 + c0), b = *(const f32x4*)(cw + 5632 + c0 + 4); w1[0] = (f32x2){a[0], a[1]}; w1[1] = (f32x2){a[2], a[3]}; w1[2] = (f32x2){b[0], b[1]}; w1[3] = (f32x2){b[2], b[3]}; }
        { const f32x4 a = *(const f32x4*)(cw + 11264 + c0), b = *(const f32x4*)(cw + 11264 + c0 + 4); w2[0] = (f32x2){a[0], a[1]}; w2[1] = (f32x2){a[2], a[3]}; w2[2] = (f32x2){b[0], b[1]}; w2[3] = (f32x2){b[2], b[3]}; }
        { const f32x4 a = *(const f32x4*)(cb + c0), b = *(const f32x4*)(cb + c0 + 4); cbv[0] = (f32x2){a[0], a[1]}; cbv[1] = (f32x2){a[2], a[3]}; cbv[2] = (f32x2){b[0], b[1]}; cbv[3] = (f32x2){b[2], b[3]}; }
        asm volatile("s_waitcnt lgkmcnt(0)" ::: "memory"); __builtin_amdgcn_s_barrier(); asm volatile("" ::: "memory");
        const bool f15 = fr == 15, f14 = fr >= 14;
#pragma unroll
        for (int ai = 0; ai < 2; ++ai) {
            f32x2 xp[4];
            { const int g = 2 * ai + wr;
              if (g > 0 && fr >= 14) { const PG8_LAS float* d = hl + ((g - 1) * 2 + (fr - 14)) * 128 + cl; const f32x4 h0 = *(const PG8_LAS f32x4*)d, h1 = *(const PG8_LAS f32x4*)(d + 4);
                  xp[0] = (f32x2){h0[0], h0[1]}; xp[1] = (f32x2){h0[2], h0[3]}; xp[2] = (f32x2){h1[0], h1[1]}; xp[3] = (f32x2){h1[2], h1[3]}; }
              else {
#pragma unroll
                  for (int j = 0; j < 4; ++j) xp[j] = (f32x2){0.f, 0.f}; } }
#pragma unroll
            for (int m = 0; m < 4; ++m) { const float r = rr[ai][m]; const int row = rowg + ai * HALF + m * 16;
                f32x2 o[4];
#pragma unroll
                for (int j = 0; j < 4; ++j) {
                    const f32x4 av = acc[ai][0][m][j >> 1], bv = acc[ai][1][m][j >> 1];
                    const f32x2 x = (f32x2){av[(j & 1) * 2], av[(j & 1) * 2 + 1]} * r, bb = (f32x2){bv[(j & 1) * 2], bv[(j & 1) * 2 + 1]} * r;
                    const f32x2 s1 = f15 ? xp[j] : x, s2 = f14 ? xp[j] : x;
                    f32x2 p1, p2;
                    p1.x = __int_as_float(__builtin_amdgcn_update_dpp(0, __float_as_int(s1.x), 0x121, 0xf, 0xf, false)); p1.y = __int_as_float(__builtin_amdgcn_update_dpp(0, __float_as_int(s1.y), 0x121, 0xf, 0xf, false));
                    p2.x = __int_as_float(__builtin_amdgcn_update_dpp(0, __float_as_int(s2.x), 0x122, 0xf, 0xf, false)); p2.y = __int_as_float(__builtin_amdgcn_update_dpp(0, __float_as_int(s2.y), 0x122, 0xf, 0xf, false));
                    const f32x2 cv = ((cbv[j] + w0[j] * p2) + w1[j] * p1) + w2[j] * x;
                    const f32x2 arg = (cv * (cv * cv * 0.044715f + 1.0f)) * (-2.3022081986f);
                    f32x2 e; e.x = __builtin_amdgcn_exp2f(arg.x); e.y = __builtin_amdgcn_exp2f(arg.y);
                    const f32x2 d = e + 1.0f; f32x2 rc; rc.x = __builtin_amdgcn_rcpf(d.x); rc.y = __builtin_amdgcn_rcpf(d.y);
                    o[j] = (cv * rc) * bb; xp[j] = x; }
                *(u32x4*)(HM + (size_t)row * 5632 + c0) = pack8((f32x4){o[0].x, o[0].y, o[1].x, o[1].y}, (f32x4){o[2].x, o[2].y, o[3].x, o[3].y}); }
        }
    }
};
struct EpiE {
    static constexpr bool PERM = true, AFTER_DRAIN = false, MIDK = false;
    bf16_t* O; float* ssq;
    __device__ __forceinline__ void mid(Acc&, const Unit&, int, int, int, int) const {}
    __device__ __forceinline__ void operator()(const Acc& acc, const Unit& u, int wr, int wc, int fr, int fq) const {
        const int row0 = u.pm * BM + wr * 64 + fr, col0 = u.pn * BM + wc * 32 + 8 * fq;
#pragma unroll
        EPI_LOOP_ROWS { const int row = row0 + ai * HALF + m * 16; float s = 0.f; bf16_t* rowp = O + (size_t)row * 2048 + col0;
#pragma unroll
            for (int bj = 0; bj < 2; ++bj) { const f32x4 x0 = acc[ai][bj][m][0], x1 = acc[ai][bj][m][1];
                s += (x0[0] * x0[0] + x0[1] * x0[1]) + (x0[2] * x0[2] + x0[3] * x0[3]) + (x1[0] * x1[0] + x1[1] * x1[1]) + (x1[2] * x1[2] + x1[3] * x1[3]);
                *(u32x4*)(rowp + bj * HALF) = pack8(x0, x1); }
            s = xsum_fq(s);
            if (fq == 0) atomicAdd(ssq + row, s); }
    }
};
struct EpiFinal {
    static constexpr bool PERM = true, AFTER_DRAIN = false, MIDK = false;
    float* out; const bf16_t* xb; const bf16_t* E; const float* gp; const float* ssq2; const float* ssqE;
    __device__ __forceinline__ void mid(Acc&, const Unit&, int, int, int, int) const {}
    __device__ __forceinline__ void operator()(const Acc& acc, const Unit& u, int wr, int wc, int fr, int fq) const {
        const int row0 = u.pm * BM + wr * 64 + fr, col0 = u.pn * BM + wc * 32 + 8 * fq;
        f32x4 gv[2][2];
#pragma unroll
        for (int bj = 0; bj < 2; ++bj) { gv[bj][0] = *(const f32x4*)(gp + col0 + bj * HALF); gv[bj][1] = *(const f32x4*)(gp + col0 + bj * HALF + 4); }
#pragma unroll
        EPI_LOOP_ROWS { const int row = row0 + ai * HALF + m * 16; const size_t off = (size_t)row * 2048 + col0;
            const float r2 = 1.0f / sqrtf(ssq2[row] * (1.0f / 2048.0f) + 1e-6f), rE = 1.0f / sqrtf(ssqE[row] * (1.0f / 2048.0f) + 1e-6f);
#pragma unroll
            for (int bj = 0; bj < 2; ++bj) { const u32x4 xw = *(const u32x4*)(xb + off + bj * HALF);
                const f32x4 b0 = (f32x4){bf_lo(xw.x), bf_hi(xw.x), bf_lo(xw.y), bf_hi(xw.y)}, b1 = (f32x4){bf_lo(xw.z), bf_hi(xw.z), bf_lo(xw.w), bf_hi(xw.w)};
                const u32x4 e = *(const u32x4*)(E + off + bj * HALF);
                const f32x4 e0 = (f32x4){bf_lo(e.x), bf_hi(e.x), bf_lo(e.y), bf_hi(e.y)}, e1 = (f32x4){bf_lo(e.z), bf_hi(e.z), bf_lo(e.w), bf_hi(e.w)};
                const f32x4 g0 = sigm4(acc[ai][bj][m][0] * r2), g1 = sigm4(acc[ai][bj][m][1] * r2);
                *(f32x4*)(out + off + bj * HALF) = b0 + g0 * (e0 * rE * gv[bj][0]); *(f32x4*)(out + off + bj * HALF + 4) = b1 + g1 * (e1 * rE * gv[bj][1]); } }
    }
};

template <class Epi, class Sched, bool ALIGN_EPI = false, bool SP2 = false>
__device__ __forceinline__ void gemm_phase(PG8_LAS unsigned char* lds, const Gemm g, const Sched& S, const Epi& E) {
    const int tid = threadIdx.x, wid = __builtin_amdgcn_readfirstlane(tid >> 6), lane = tid & 63, wr = wid >> 2, wc = wid & 3, fr = lane & 15, fq = lane >> 4;
    const int K = g.K, nt = K / BK;
    unsigned voffA[2], voffB[2];
#pragma unroll
    for (int i = 0; i < 2; ++i) { int R, C; stage_rc(tid * 16 + i * 8192, R, C); const int Rb = Epi::PERM ? ((R & ~31) + perm32(R & 31)) : R;
        voffA[i] = (unsigned)(R * K + C) * 2u; voffB[i] = (unsigned)(Rb * K + C) * 2u; }
    const size_t kstep = (size_t)(BK * 2);
    const size_t hstep = (size_t)HALF * K * 2;
    const size_t tstep = 2 * hstep;
    const unsigned ldsw = (unsigned)wid * 1024u;
    const int aoff = lds_byte(wr * 64 + fr, fq * 8), boff = lds_byte(wc * 32 + fr, fq * 8);
#define PG8_SA(b, h) (((b) * 2 + (h)) * HTB)
#define PG8_SB(b, h) ((4 + (b) * 2 + (h)) * HTB)
#define PG8_STAGE(bufoff, gbase, voff) do { _Pragma("unroll") for (int _i = 0; _i < 2; ++_i) \
        __builtin_amdgcn_global_load_lds((const unsigned*)((const char*)(gbase) + (voff)[_i]), (PG8_LAS unsigned*)(lds + (bufoff) + ldsw + _i * 8192), 16, 0, 0); } while (0)
#define PG8_LDA(dst, b, h) do { _Pragma("unroll") for (int m = 0; m < 4; ++m) _Pragma("unroll") for (int k = 0; k < 2; ++k) dst[m][k] = *(const PG8_LAS bf16x8*)(lds + PG8_SA(b, h) + aoff + m * 2048 + k * 1024); } while (0)
#define PG8_LDB(dst, b, h) do { _Pragma("unroll") for (int n = 0; n < 2; ++n) _Pragma("unroll") for (int k = 0; k < 2; ++k) dst[n][k] = *(const PG8_LAS bf16x8*)(lds + PG8_SB(b, h) + boff + n * 2048 + k * 1024); } while (0)
#define PG8_MMA(ai, bj, At, Bt) do { __builtin_amdgcn_s_setprio(1); _Pragma("unroll") for (int m = 0; m < 4; ++m) _Pragma("unroll") for (int n = 0; n < 2; ++n) _Pragma("unroll") for (int k = 0; k < 2; ++k) \
        acc[ai][bj][m][n] = __builtin_amdgcn_mfma_f32_16x16x32_bf16(Bt[n][k], At[m][k], acc[ai][bj][m][n], 0, 0, 0); __builtin_amdgcn_s_setprio(0); } while (0)
#define PG8_WAIT_V(n) asm volatile("s_waitcnt vmcnt(" #n ")" ::: "memory")
#define PG8_WAIT_L(n) asm volatile("s_waitcnt lgkmcnt(" #n ")" ::: "memory")
#define PG8_BAR __builtin_amdgcn_s_barrier()
#define PG8_SCHED __builtin_amdgcn_sched_barrier(0)
    Unit cur, nxt; int ui = 0;
    if (!S.next(0, cur)) return;
    f32x4 acc[2][2][4][2];
#pragma unroll
    for (int a = 0; a < 2; ++a)
#pragma unroll
        for (int b = 0; b < 2; ++b)
#pragma unroll
            for (int m = 0; m < 4; ++m)
#pragma unroll
                for (int n = 0; n < 2; ++n) acc[a][b][m][n] = (f32x4){0.f, 0.f, 0.f, 0.f};
    bf16x8 At[4][2], B0[2][2], B1[2][2];
    const char* cA = (const char*)g.A + (size_t)cur.pm * tstep; const char* cB = (const char*)g.Bt + (size_t)cur.pn * tstep;
    S.a_ready(cur);
    if constexpr (SP2) {
        PG8_STAGE(PG8_SB(0, 0), cB, voffB); PG8_STAGE(PG8_SB(0, 1), cB + hstep, voffB); PG8_STAGE(PG8_SA(0, 0), cA, voffA); PG8_STAGE(PG8_SA(0, 1), cA + hstep, voffA);
        if (wr == 1) PG8_BAR;
        PG8_WAIT_V(2); PG8_BAR;
        PG8_STAGE(PG8_SB(1, 0), cB + kstep, voffB); PG8_STAGE(PG8_SA(1, 0), cA + kstep, voffA); PG8_STAGE(PG8_SB(1, 1), cB + hstep + kstep, voffB);
        PG8_WAIT_V(6); PG8_BAR;
    } else {
        PG8_STAGE(PG8_SB(0, 0), cB, voffB); PG8_STAGE(PG8_SA(0, 0), cA, voffA); PG8_STAGE(PG8_SB(0, 1), cB + hstep, voffB); PG8_STAGE(PG8_SA(0, 1), cA + hstep, voffA);
        if (wr == 1) PG8_BAR;
        PG8_WAIT_V(4); PG8_BAR;
        PG8_STAGE(PG8_SB(1, 0), cB + kstep, voffB); PG8_STAGE(PG8_SA(1, 0), cA + kstep, voffA); PG8_STAGE(PG8_SB(1, 1), cB + hstep + kstep, voffB);
        PG8_WAIT_V(6); PG8_BAR;
    }
    for (;;) {
        const bool has_next = S.next(ui + 1, nxt);
        const char* nA = has_next ? (const char*)g.A + (size_t)nxt.pm * tstep : cA; const char* nB = has_next ? (const char*)g.Bt + (size_t)nxt.pn * tstep : cB;
        constexpr int NSEG = Epi::MIDK ? 2 : 1;
#pragma unroll 1
        for (int seg = 0; seg < NSEG; ++seg) {
        if constexpr (Epi::MIDK) { if (seg == 1) E.mid(acc, cur, wr, wc, fr, fq); }
        const int t_hi = (NSEG == 2 && seg == 0) ? (nt >> 1) : nt;
#pragma unroll 1
        for (int t = (NSEG == 2 && seg == 1) ? (nt >> 1) : 0; t < t_hi; t += 2) {
            const bool last = (t == nt - 2);
            const char* a1 = cA + (size_t)(t + 1) * kstep;
            const char* a2 = last ? nA : cA + (size_t)(t + 2) * kstep; const char* b2 = last ? nB : cB + (size_t)(t + 2) * kstep;
            const char* a3 = a2 + kstep; const char* b3 = b2 + kstep;
            if (last && has_next) S.a_ready(nxt);
            if constexpr (SP2) {
            PG8_LDB(B0, 0, 0); PG8_LDB(B1, 0, 1); PG8_SCHED; PG8_LDA(At, 0, 0); PG8_STAGE(PG8_SA(1, 1), a1 + hstep, voffA);
            PG8_WAIT_V(8); PG8_WAIT_L(0); PG8_BAR; PG8_MMA(0, 0, At, B0); PG8_MMA(0, 1, At, B1); PG8_BAR; PG8_SCHED;
            PG8_LDA(At, 0, 1); PG8_STAGE(PG8_SB(0, 0), b2, voffB); PG8_STAGE(PG8_SB(0, 1), b2 + hstep, voffB); PG8_STAGE(PG8_SA(0, 0), a2, voffA);
            PG8_WAIT_V(8); PG8_WAIT_L(0); PG8_BAR; PG8_MMA(1, 0, At, B0); PG8_MMA(1, 1, At, B1); PG8_BAR; PG8_SCHED;
            PG8_LDB(B0, 1, 0); PG8_LDB(B1, 1, 1); PG8_SCHED; PG8_LDA(At, 1, 0); PG8_STAGE(PG8_SA(0, 1), a2 + hstep, voffA);
            PG8_WAIT_V(8); PG8_WAIT_L(0); PG8_BAR; PG8_MMA(0, 0, At, B0); PG8_MMA(0, 1, At, B1); PG8_BAR; PG8_SCHED;
            PG8_LDA(At, 1, 1); PG8_STAGE(PG8_SB(1, 0), b3, voffB); PG8_STAGE(PG8_SB(1, 1), b3 + hstep, voffB); PG8_STAGE(PG8_SA(1, 0), a3, voffA);
            PG8_WAIT_V(8); PG8_WAIT_L(0); PG8_BAR; PG8_MMA(1, 0, At, B0); PG8_MMA(1, 1, At, B1); PG8_BAR; PG8_SCHED;
            } else {
            PG8_LDB(B0, 0, 0); PG8_SCHED; PG8_LDA(At, 0, 0); PG8_STAGE(PG8_SA(1, 1), a1 + hstep, voffA);
            PG8_WAIT_L(8); PG8_BAR; PG8_WAIT_L(0); PG8_MMA(0, 0, At, B0); PG8_BAR; PG8_SCHED;
            PG8_LDB(B1, 0, 1); PG8_STAGE(PG8_SB(0, 0), b2, voffB);
            PG8_BAR; PG8_WAIT_L(0); PG8_MMA(0, 1, At, B1); PG8_BAR;
            PG8_LDA(At, 0, 1); PG8_STAGE(PG8_SA(0, 0), a2, voffA);
            PG8_BAR; PG8_WAIT_L(0); PG8_MMA(1, 0, At, B0); PG8_BAR; PG8_SCHED;
            PG8_STAGE(PG8_SB(0, 1), b2 + hstep, voffB);
            PG8_WAIT_V(6); PG8_BAR; PG8_MMA(1, 1, At, B1); PG8_BAR;
            PG8_LDB(B0, 1, 0); PG8_SCHED; PG8_LDA(At, 1, 0); PG8_STAGE(PG8_SA(0, 1), a2 + hstep, voffA);
            PG8_WAIT_L(8); PG8_BAR; PG8_WAIT_L(0); PG8_MMA(0, 0, At, B0); PG8_BAR; PG8_SCHED;
            PG8_LDB(B1, 1, 1); PG8_STAGE(PG8_SB(1, 0), b3, voffB);
            PG8_BAR; PG8_WAIT_L(0); PG8_MMA(0, 1, At, B1); PG8_BAR;
            PG8_LDA(At, 1, 1); PG8_STAGE(PG8_SA(1, 0), a3, voffA);
            PG8_BAR; PG8_WAIT_L(0); PG8_MMA(1, 0, At, B0); PG8_BAR; PG8_SCHED;
            PG8_STAGE(PG8_SB(1, 1), b3 + hstep, voffB);
            PG8_WAIT_V(6); PG8_BAR; PG8_MMA(1, 1, At, B1); PG8_BAR;
            }
        }
        }
        if constexpr (ALIGN_EPI) { if (wr == 0) PG8_BAR; }
        if constexpr (!Epi::AFTER_DRAIN) { E(acc, cur, wr, wc, fr, fq); S.done(cur); }
        if (!has_next) break;
#pragma unroll
        for (int a = 0; a < 2; ++a)
#pragma unroll
            for (int b = 0; b < 2; ++b)
#pragma unroll
                for (int m = 0; m < 4; ++m)
#pragma unroll
                    for (int n = 0; n < 2; ++n) acc[a][b][m][n] = (f32x4){0.f, 0.f, 0.f, 0.f};
        cur = nxt; cA = nA; cB = nB; ++ui;
        if constexpr (ALIGN_EPI) { if (wr == 1) PG8_BAR; }
    }
    PG8_WAIT_V(0);
    if constexpr (!ALIGN_EPI) { if (wr == 0) PG8_BAR; }
    PG8_BAR;
#undef PG8_SA
#undef PG8_SB
#undef PG8_STAGE
#undef PG8_LDA
#undef PG8_LDB
#undef PG8_MMA
#undef PG8_WAIT_V
#undef PG8_WAIT_L
#undef PG8_BAR
#undef PG8_SCHED
}
}

namespace fox {
typedef unsigned short bf16_t;
typedef short bf16x8 __attribute__((ext_vector_type(8)));
typedef short s16x4 __attribute__((ext_vector_type(4)));
typedef float f32x16 __attribute__((ext_vector_type(16)));
typedef float f32x4 __attribute__((ext_vector_type(4)));
typedef unsigned u32x4 __attribute__((ext_vector_type(4)));
constexpr int D = 128, NW = 8, QBLK = 32, KVBLK = 64, QB = NW * QBLK;
constexpr int SHM_V = KVBLK * D * 2, SHM_K = KVBLK * D * 2;
constexpr int LDS_WS = 2 * SHM_V + 2 * SHM_K;
constexpr int LDS_CUM = LDS_WS + NW * 64 * 4;
constexpr int LDS_BYTES = LDS_CUM + 2048 * 4;
constexpr int QS = 9216, OS = 2048;
constexpr float SCALE = 0.08838834764831845f;
constexpr float THR = 8.f;
constexpr unsigned WBIG = 0x40000000u;

#define KSWZ(row, colB) ((row) * 256 + ((colB) ^ (((row) & 7) << 4)))
#define SBAR() __builtin_amdgcn_sched_barrier(0)
__device__ __forceinline__ int v_st(int k, int c) { const int kk = (k & ~0xC) | ((k & 4) << 1) | ((k & 8) >> 1); return ((kk >> 3) * 4 + (c >> 5)) * 512 + ((kk & 7) * 32 + (c & 31)) * 2; }
__device__ __forceinline__ int v_rd_base(int lane) { return ((lane & 3) << 3) | (((lane >> 2) & 3) << 6) | (((lane >> 4) & 1) << 5) | (((lane >> 5) & 1) << 8); }
constexpr int v_rd_off(int d0, int ks, int half) { return d0 * 512 + ks * 4096 + half * 2048; }
__device__ __forceinline__ int crow(int r, int hi) { return (r & 3) + 8 * (r >> 2) + 4 * hi; }
__device__ __forceinline__ unsigned cvtpk(float lo, float hi) { unsigned r; asm volatile("v_cvt_pk_bf16_f32 %0, %1, %2" : "=v"(r) : "v"(lo), "v"(hi)); return r; }
__device__ __forceinline__ bf16x8 load8(const bf16_t* p) { return *reinterpret_cast<const bf16x8*>(p); }
__device__ __forceinline__ void mask_tile(f32x16& p0, f32x16& p1, int dq) {
    const float NEG = -__builtin_inff();
#pragma unroll
    for (int r = 0; r < 16; ++r) {
        const int c = (r & 3) + 8 * (r >> 2);
        if ((unsigned)(dq - c) >= WBIG) p0[r] = NEG;
        if ((unsigned)(dq - c - 32) >= WBIG) p1[r] = NEG;
    }
}
__device__ __forceinline__ void partialSM(f32x16& p0, f32x16& p1, float& m_reg, float& mn, float& alpha) {
    float pmax = p0[0]; for (int r = 1; r < 16; ++r) pmax = fmaxf(pmax, p0[r]); for (int r = 0; r < 16; ++r) pmax = fmaxf(pmax, p1[r]);
    { auto rr = __builtin_amdgcn_permlane32_swap(__float_as_uint(pmax), __float_as_uint(pmax), false, false);
      pmax = fmaxf(__uint_as_float(rr[0]), __uint_as_float(rr[1])); }
    constexpr float C2 = 1.4426950408889634f * SCALE;
    if (__builtin_expect(__all((pmax - m_reg) * SCALE <= THR), 1)) { mn = m_reg; alpha = 1.f; }
    else { mn = fmaxf(m_reg, pmax); alpha = __builtin_amdgcn_exp2f((m_reg - mn) * C2); m_reg = mn; }
    const float mnL = -mn * C2;
    for (int r = 0; r < 16; ++r) p0[r] = fmaf(p0[r], C2, mnL); for (int r = 0; r < 16; ++r) p1[r] = fmaf(p1[r], C2, mnL);
    for (int r = 0; r < 16; ++r) p0[r] = __builtin_amdgcn_exp2f(p0[r]);
}
__device__ __forceinline__ void finishSM(f32x16& p0, f32x16& p1, float alpha, float& l_reg, bf16x8& pa0, bf16x8& pa1, bf16x8& pa2, bf16x8& pa3) {
    for (int r = 0; r < 16; ++r) p1[r] = __builtin_amdgcn_exp2f(p1[r]);
    float ps = 0; for (int r = 0; r < 16; ++r) ps += p0[r]; for (int r = 0; r < 16; ++r) ps += p1[r];
    { auto rr = __builtin_amdgcn_permlane32_swap(__float_as_uint(ps), __float_as_uint(ps), false, false);
      ps = __uint_as_float(rr[0]) + __uint_as_float(rr[1]); }
    l_reg = l_reg * alpha + ps;
#define PK4(P, B_, OUT) do { unsigned a0 = cvtpk(P[B_+0], P[B_+1]), a1 = cvtpk(P[B_+2], P[B_+3]);                          \
        unsigned b0 = cvtpk(P[B_+4], P[B_+5]), b1 = cvtpk(P[B_+6], P[B_+7]);                                             \
        auto r0 = __builtin_amdgcn_permlane32_swap(a0, b0, false, false); auto r1 = __builtin_amdgcn_permlane32_swap(a1, b1, false, false); \
        u32x4 w = {r0[0], r1[0], r0[1], r1[1]}; OUT = *reinterpret_cast<bf16x8*>(&w); } while (0)
    PK4(p0, 0, pa0); PK4(p0, 8, pa1); PK4(p1, 0, pa2); PK4(p1, 8, pa3);
#undef PK4
}
template <int KB>
__device__ __forceinline__ void qkt(f32x16& p0, f32x16& p1, const char* K_lds, int r32, int hi, const bf16x8* qr, const float* cl) {
#pragma unroll
    for (int g = 0; g < 4; ++g) { const f32x4 c0 = *(const f32x4*)(cl + 8 * g), c1 = *(const f32x4*)(cl + 32 + 8 * g);
#pragma unroll
        for (int i = 0; i < 4; ++i) { p0[4 * g + i] = c0[i]; p1[4 * g + i] = c1[i]; } }
    const char* kb[4];
#pragma unroll
    for (int dd = 0; dd < 4; ++dd) kb[dd] = K_lds + KB * SHM_K + KSWZ(r32, (dd * 16 + hi * 8) * 2);
#pragma unroll
    for (int d0 = 0; d0 < 8; ++d0) { const char* a = kb[d0 & 3] + (d0 >> 2) * 128;
        bf16x8 b0 = *reinterpret_cast<const bf16x8*>(a);
        bf16x8 b1 = *reinterpret_cast<const bf16x8*>(a + 32 * 256);
        p0 = __builtin_amdgcn_mfma_f32_32x32x16_bf16(b0, qr[d0], p0, 0, 0, 0);
        p1 = __builtin_amdgcn_mfma_f32_32x32x16_bf16(b1, qr[d0], p1, 0, 0, 0); }
}
#define TRRD(dst, base, off) asm volatile("ds_read_b64_tr_b16 %0, %1 offset:%2" : "=&v"(dst) : "v"(base), "i"(off) : "memory")
template <int VB>
__device__ __forceinline__ void pv_tile(f32x16* o, int vb0, bf16x8 pa0, bf16x8 pa1, bf16x8 pa2, bf16x8 pa3) {
#define PV_D0(d0) do { s16x4 l0, l1, l2, l3, h0, h1, h2, h3; constexpr int b_ = VB * SHM_V + v_rd_off(d0, 0, 0); \
        TRRD(l0, vb0, b_); TRRD(h0, vb0, b_ + 2048); TRRD(l1, vb0, b_ + 4096); TRRD(h1, vb0, b_ + 6144); TRRD(l2, vb0, b_ + 8192); TRRD(h2, vb0, b_ + 10240); TRRD(l3, vb0, b_ + 12288); TRRD(h3, vb0, b_ + 14336); \
        asm volatile("s_waitcnt lgkmcnt(0)" ::: "memory"); SBAR();   \
        o[d0] = __builtin_amdgcn_mfma_f32_32x32x16_bf16(pa0, (bf16x8){l0[0], l0[1], l0[2], l0[3], h0[0], h0[1], h0[2], h0[3]}, o[d0], 0, 0, 0);   \
        o[d0] = __builtin_amdgcn_mfma_f32_32x32x16_bf16(pa1, (bf16x8){l1[0], l1[1], l1[2], l1[3], h1[0], h1[1], h1[2], h1[3]}, o[d0], 0, 0, 0);   \
        o[d0] = __builtin_amdgcn_mfma_f32_32x32x16_bf16(pa2, (bf16x8){l2[0], l2[1], l2[2], l2[3], h2[0], h2[1], h2[2], h2[3]}, o[d0], 0, 0, 0);   \
        o[d0] = __builtin_amdgcn_mfma_f32_32x32x16_bf16(pa3, (bf16x8){l3[0], l3[1], l3[2], l3[3], h3[0], h3[1], h3[2], h3[3]}, o[d0], 0, 0, 0); } while (0)
    PV_D0(0); PV_D0(1); PV_D0(2); PV_D0(3);
#undef PV_D0
}

struct BlockRef { const bf16_t* Q; const bf16_t* K; const bf16_t* V; bf16_t* O; int P0; };
struct Seam { bf16x8 qr[8]; bf16x8 st_v0, st_v1, st_k0, st_k1; };
#define ROW(p, k0, rr) ((p) + (size_t)((k0) + (rr)) * QS + sc)
#define VMW() asm volatile("s_waitcnt vmcnt(0)" ::: "memory")
#define VMWN(n) asm volatile("s_waitcnt vmcnt(%0)" :: "i"(n) : "memory")
#define SLOAD_H(Kp, Vp, k0) do { S.st_v0 = load8(ROW(Vp, k0, sr)); S.st_v1 = load8(ROW(Vp, k0, 32 + sr));              \
                         S.st_k0 = load8(ROW(Kp, k0, sr)); S.st_k1 = load8(ROW(Kp, k0, 32 + sr)); } while (0)
__device__ __forceinline__ bf16x8 knorm8(bf16x8 kv) {
    const u32x4 w = __builtin_bit_cast(u32x4, kv);
    float x[8] = {__uint_as_float(w.x << 16), __uint_as_float(w.x & 0xffff0000u), __uint_as_float(w.y << 16), __uint_as_float(w.y & 0xffff0000u),
                  __uint_as_float(w.z << 16), __uint_as_float(w.z & 0xffff0000u), __uint_as_float(w.w << 16), __uint_as_float(w.w & 0xffff0000u)};
    float s = 0.f;
#pragma unroll
    for (int i = 0; i < 8; ++i) s += x[i] * x[i];
    s += __shfl_xor(s, 1); s += __shfl_xor(s, 2); s += __shfl_xor(s, 4); s += __shfl_xor(s, 8);
    const float r = 1.0f / sqrtf(s * (1.0f / 128.0f) + 1e-6f);
    u32x4 o; o.x = cvtpk(x[0] * r, x[1] * r); o.y = cvtpk(x[2] * r, x[3] * r); o.z = cvtpk(x[4] * r, x[5] * r); o.w = cvtpk(x[6] * r, x[7] * r);
    return __builtin_bit_cast(bf16x8, o);
}
#define SWRITE_HK(bf) do { *(bf16x8*)(K_lds + (bf) * SHM_K + kws) = S.st_k0; *(bf16x8*)(K_lds + (bf) * SHM_K + kws + 32 * 256) = S.st_k1; } while (0)
#define SWRITE_HV(bf) do { *(bf16x8*)(V_lds + (bf) * SHM_V + vst0) = S.st_v0; *(bf16x8*)(V_lds + (bf) * SHM_V + vst1) = S.st_v1; } while (0)
#define SWRITE_H(bf) do { SWRITE_HV(bf); SWRITE_HK(bf); } while (0)
__device__ __forceinline__ void qnorm(bf16x8* qr, const float* gq, const float* gk, int hi) {
    float s = 0.f;
#pragma unroll
    for (int d0 = 0; d0 < 8; ++d0) { const u32x4 w = __builtin_bit_cast(u32x4, qr[d0]);
        const float a0 = __uint_as_float(w.x << 16), a1 = __uint_as_float(w.x & 0xffff0000u), a2 = __uint_as_float(w.y << 16), a3 = __uint_as_float(w.y & 0xffff0000u);
        const float a4 = __uint_as_float(w.z << 16), a5 = __uint_as_float(w.z & 0xffff0000u), a6 = __uint_as_float(w.w << 16), a7 = __uint_as_float(w.w & 0xffff0000u);
        s += (a0 * a0 + a1 * a1) + (a2 * a2 + a3 * a3) + (a4 * a4 + a5 * a5) + (a6 * a6 + a7 * a7); }
    { auto rr = __builtin_amdgcn_permlane32_swap(__float_as_uint(s), __float_as_uint(s), false, false); s = __uint_as_float(rr[0]) + __uint_as_float(rr[1]); }
    const float r = 1.0f / sqrtf(s * (1.0f / 128.0f) + 1e-6f);
#pragma unroll
    for (int d0 = 0; d0 < 8; ++d0) { const u32x4 w = __builtin_bit_cast(u32x4, qr[d0]); const int d = d0 * 16 + hi * 8;
        const f32x4 g0 = *(const f32x4*)(gq + d) * *(const f32x4*)(gk + d) * r, g1 = *(const f32x4*)(gq + d + 4) * *(const f32x4*)(gk + d + 4) * r;
        u32x4 o; o.x = cvtpk(__uint_as_float(w.x << 16) * g0[0], __uint_as_float(w.x & 0xffff0000u) * g0[1]); o.y = cvtpk(__uint_as_float(w.y << 16) * g0[2], __uint_as_float(w.y & 0xffff0000u) * g0[3]);
        o.z = cvtpk(__uint_as_float(w.z << 16) * g1[0], __uint_as_float(w.z & 0xffff0000u) * g1[1]); o.w = cvtpk(__uint_as_float(w.w << 16) * g1[2], __uint_as_float(w.w & 0xffff0000u) * g1[3]);
        qr[d0] = __builtin_bit_cast(bf16x8, o); }
}
__device__ __forceinline__ void fox_prime(const BlockRef& cur, char* lds, Seam& S) {
    int tid; asm volatile("v_mov_b32 %0, %1" : "=v"(tid) : "v"((int)threadIdx.x));
    const int wid = __builtin_amdgcn_readfirstlane(tid >> 6), lane = tid & 63, r32 = lane & 31, hi = lane >> 5;
    const int sr = tid >> 4, sc = (tid & 15) * 8, kws = KSWZ(sr, sc * 2); char* K_lds = lds + 2 * SHM_V;
#pragma unroll
    for (int d0 = 0; d0 < 8; ++d0) S.qr[d0] = load8(cur.Q + (size_t)(wid * QBLK + r32) * QS + d0 * 16 + hi * 8);
    SLOAD_H(cur.K, cur.V, 0); VMW(); SWRITE_HK(0);
    __syncthreads();
}
__device__ __forceinline__ void fox_block(const BlockRef& cur, char* lds, Seam& S, const float* cumL, int NT, float* plse) {
    const int tid = threadIdx.x, wid = __builtin_amdgcn_readfirstlane(tid >> 6), lane = tid & 63, r32 = lane & 31, hi = lane >> 5;
    const int qlo = cur.P0 + wid * QBLK, qm = qlo + r32 - 4 * hi;
    char* V_lds = lds; char* K_lds = lds + 2 * SHM_V;
    float* ws = (float*)(lds + LDS_WS) + wid * 64; float* li_l = ws, * al_l = ws + 32;
    float m_reg = -1e30f, l_reg = 0; f32x16 o[4] = {};
    const int sr = tid >> 4, sc = (tid & 15) * 8, vst0 = v_st(sr, sc), vst1 = vst0 + 8192  , kws = KSWZ(sr, sc * 2);
    const int vb0 = (int)(uintptr_t)V_lds + v_rd_base(lane);
    const bf16_t* Kh = cur.K; const bf16_t* Vh = cur.V;
    const float* clb = cumL + 4 * hi;
#define RESC(a) do { if (__any((a) < 1.f)) { if (hi == 0) al_l[r32] = (a); asm volatile("s_waitcnt lgkmcnt(0)" ::: "memory");              \
                     for (int d_ = 0; d_ < 4; ++d_) for (int r = 0; r < 16; ++r) o[d_][r] *= al_l[crow(r, hi)]; } } while (0)
#define KBASE(t) ((t) * KVBLK)
#define MASKT(P0_, P1_, t) do { const int kb_ = KBASE(t); if (kb_ + KVBLK - 1 > qlo) mask_tile(P0_, P1_, qm - kb_); } while (0)
    constexpr int NQL = 8;
#define SEAM_K0() do { VMWN(NQL); SWRITE_HK(0); SBAR(); } while (0)
    f32x16 pA0, pA1, pB0, pB1; float mnA, mnB, alA, alB; bf16x8 pa0, pa1, pa2, pa3;
    SWRITE_HV(0); SBAR();
    if (NT > 1) { SLOAD_H(Kh, Vh, KBASE(1)); }
    SBAR(); qkt<0>(pA0, pA1, K_lds, r32, hi, S.qr, clb + KBASE(0));
    MASKT(pA0, pA1, 0); partialSM(pA0, pA1, m_reg, mnA, alA);
    if (NT > 1) { VMW(); SWRITE_H(1); }
    __syncthreads();
#define HALF_STEP(PX0, PX1, mnX, alX, PY0, PY1, alY, t, KB, VB, SB) do {                                                      \
        SBAR(); qkt<KB>(PX0, PX1, K_lds, r32, hi, S.qr, clb + KBASE(t));                                                  \
        finishSM(PY0, PY1, alY, l_reg, pa0, pa1, pa2, pa3); SBAR();                                                           \
        if ((t) + 1 < NT) { SLOAD_H(Kh, Vh, KBASE((t) + 1)); SBAR(); }                                                        \
        pv_tile<VB>(o, vb0, pa0, pa1, pa2, pa3); MASKT(PX0, PX1, (t)); partialSM(PX0, PX1, m_reg, mnX, alX);                   \
        __syncthreads();                                                                                                      \
        if ((t) + 1 < NT) { VMW(); SWRITE_H(SB); }                                                                            \
        RESC(alX); __syncthreads(); } while (0)
    for (int t = 1; t + 1 < NT; t += 2) {
        HALF_STEP(pB0, pB1, mnB, alB, pA0, pA1, alA, t, 1, 0, 0);
        HALF_STEP(pA0, pA1, mnA, alA, pB0, pB1, alB, t + 1, 0, 1, 1);
    }
    const bool even = (NT & 1) == 0;
    if (even) { SBAR(); qkt<1>(pB0, pB1, K_lds, r32, hi, S.qr, clb + KBASE(NT - 1)); SBAR(); }
    finishSM(pA0, pA1, alA, l_reg, pa0, pa1, pa2, pa3); SBAR();
    pv_tile<0>(o, vb0, pa0, pa1, pa2, pa3);
    if (even) { MASKT(pB0, pB1, NT - 1); partialSM(pB0, pB1, m_reg, mnB, alB); __syncthreads(); RESC(alB);
        finishSM(pB0, pB1, alB, l_reg, pa0, pa1, pa2, pa3); SBAR(); pv_tile<1>(o, vb0, pa0, pa1, pa2, pa3); }
    SBAR();
    if (hi == 0) { li_l[r32] = l_reg;
        if (plse) __hip_atomic_store(plse + wid * QBLK + r32, m_reg * (1.4426950408889634f * SCALE) + __builtin_amdgcn_logf(l_reg), __ATOMIC_RELAXED, __HIP_MEMORY_SCOPE_AGENT); }
    asm volatile("s_waitcnt lgkmcnt(0)" ::: "memory");
    float rli[16];
#pragma unroll
    for (int r = 0; r < 16; ++r) rli[r] = __builtin_amdgcn_rcpf(li_l[crow(r, hi)]);
    bf16_t* Ow = cur.O + (size_t)(wid * QBLK) * OS;
#pragma unroll
    for (int r = 0; r < 16; ++r) { const int orow = crow(r, hi);
#pragma unroll
        for (int d0 = 0; d0 < 4; ++d0) { const float v = o[d0][r] * rli[r];
            const float vn = __int_as_float(__builtin_amdgcn_update_dpp(0, __float_as_int(v), 0xB1, 0xf, 0xf, false));
            if ((r32 & 1) == 0) { unsigned* op_ = (unsigned*)(Ow + (size_t)orow * OS + d0 * 32 + r32);
                if (plse) __hip_atomic_store(op_, cvtpk(v, vn), __ATOMIC_RELAXED, __HIP_MEMORY_SCOPE_AGENT); else *op_ = cvtpk(v, vn); } } }
    __syncthreads();
#undef RESC
#undef KBASE
#undef MASKT
#undef SEAM_K0
#undef HALF_STEP
}
#undef ROW
#undef VMWN
#undef SLOAD_H
#undef SWRITE_HK
#undef SWRITE_HV
#undef SWRITE_H

constexpr int GM_U = 2 * SHM_V;
constexpr int GM_UP = 264;
__device__ __forceinline__ void gmlp_unit(char* lds, int idx, const bf16_t* Z, const bf16_t* Wb, const float* b_s, bf16_t* OAB, const float* vs1, const float* vs2, const float* lng, const float* lnb) {
    int tid; asm volatile("v_mov_b32 %0, %1" : "=v"(tid) : "v"((int)threadIdx.x));
    const int wid = __builtin_amdgcn_readfirstlane(tid >> 6), lane = tid & 63, r32 = lane & 31, hi = lane >> 5;
    const int g = idx & 7, row0 = (idx >> 3) * 128;
    char* V_lds = lds;
    const int sr = tid >> 4, sc = (tid & 15) * 8;
    const int rg = wid & 3, dh = wid >> 2, nks = 2 * (rg + 1);
    u32x4 vraw[4], uraw[4]; float s1[4], s2[4];
#pragma unroll
    for (int q = 0; q < 4; ++q) { const int s = q * 32 + sr; const bf16_t* zr = Z + (size_t)(row0 + s) * QS + g * 128 + sc;
        vraw[q] = __builtin_bit_cast(u32x4, load8(zr + 1024)); uraw[q] = __builtin_bit_cast(u32x4, load8(zr)); s1[q] = vs1[row0 + s]; s2[q] = vs2[row0 + s]; }
    const f32x4 lg0 = *(const f32x4*)(lng + g * 128 + sc), lg1 = *(const f32x4*)(lng + g * 128 + sc + 4), lb0 = *(const f32x4*)(lnb + g * 128 + sc), lb1 = *(const f32x4*)(lnb + g * 128 + sc + 4);
    bf16x8 wf[8];
    const bf16_t* wrow = Wb + (size_t)(g * 128 + 32 * rg + r32) * 128 + 8 * hi;
#pragma unroll
    for (int ks = 0; ks < 8; ++ks) wf[ks] = load8(wrow + 16 * ks);
    float bias[16];
#pragma unroll
    for (int r = 0; r < 16; ++r) bias[r] = b_s[g * 128 + 32 * rg + crow(r, hi)];
#pragma unroll
    for (int q = 0; q < 4; ++q) { const int s = q * 32 + sr; const u32x4 w = vraw[q];
        const float mu = s1[q] * (1.0f / 1024.0f), var = s2[q] * (1.0f / 1024.0f) - mu * mu, rs = 1.0f / sqrtf(var + 1e-6f), nm = -mu * rs;
        const f32x4 a0 = (f32x4){__uint_as_float(w.x << 16), __uint_as_float(w.x & 0xffff0000u), __uint_as_float(w.y << 16), __uint_as_float(w.y & 0xffff0000u)};
        const f32x4 a1 = (f32x4){__uint_as_float(w.z << 16), __uint_as_float(w.z & 0xffff0000u), __uint_as_float(w.w << 16), __uint_as_float(w.w & 0xffff0000u)};
        const f32x4 y0 = (a0 * rs + nm) * lg0 + lb0, y1 = (a1 * rs + nm) * lg1 + lb1;
        u32x4 o; o.x = cvtpk(y0[0], y0[1]); o.y = cvtpk(y0[2], y0[3]); o.z = cvtpk(y1[0], y1[1]); o.w = cvtpk(y1[2], y1[3]);
        *(bf16x8*)(V_lds + (q >> 1) * SHM_V + v_st((q & 1) * 32 + sr, sc)) = __builtin_bit_cast(bf16x8, o);
        char* up = lds + GM_U + s * GM_UP + sc * 2; *(unsigned long long*)up = (unsigned long long)uraw[q].x | ((unsigned long long)uraw[q].y << 32);
        *(unsigned long long*)(up + 8) = (unsigned long long)uraw[q].z | ((unsigned long long)uraw[q].w << 32); }
    __syncthreads();
    f32x16 o0 = {}, o1 = {};
    const int vb = (int)(uintptr_t)V_lds + v_rd_base(lane) + dh * 1024;
#define GM_STEP(ks) do { if ((ks) < nks) { s16x4 l0, h0, l1, h1; constexpr int b_ = ((ks) >> 2) * SHM_V + v_rd_off(0, (ks) & 3, 0); \
        TRRD(l0, vb, b_); TRRD(h0, vb, b_ + 2048); TRRD(l1, vb, b_ + 512); TRRD(h1, vb, b_ + 512 + 2048); \
        asm volatile("s_waitcnt lgkmcnt(0)" ::: "memory"); SBAR(); \
        o0 = __builtin_amdgcn_mfma_f32_32x32x16_bf16(wf[ks], (bf16x8){l0[0], l0[1], l0[2], l0[3], h0[0], h0[1], h0[2], h0[3]}, o0, 0, 0, 0); \
        o1 = __builtin_amdgcn_mfma_f32_32x32x16_bf16(wf[ks], (bf16x8){l1[0], l1[1], l1[2], l1[3], h1[0], h1[1], h1[2], h1[3]}, o1, 0, 0, 0); } } while (0)
    GM_STEP(0); GM_STEP(1); GM_STEP(2); GM_STEP(3); GM_STEP(4); GM_STEP(5); GM_STEP(6); GM_STEP(7);
#undef GM_STEP
#pragma unroll
    for (int r = 0; r < 16; ++r) { const int t = 32 * rg + crow(r, hi);
        const size_t ooff = (size_t)(row0 + t) * OS + g * 128;
#pragma unroll
        for (int dd = 0; dd < 2; ++dd) { const int d = (2 * dh + dd) * 32 + r32;
            const float uu = __uint_as_float((unsigned)(*(const unsigned short*)(lds + GM_U + t * GM_UP + d * 2)) << 16);
            const float v = uu * ((dd ? o1[r] : o0[r]) + bias[r]);
            const float vn = __int_as_float(__builtin_amdgcn_update_dpp(0, __float_as_int(v), 0xB1, 0xf, 0xf, false));
            if ((r32 & 1) == 0) *(unsigned*)(OAB + ooff + d) = cvtpk(v, vn); } }
    __syncthreads();
}
#undef TRRD
#undef SBAR
#undef VMW
}

constexpr int NWAVES = 8;
constexpr int N_LAUNCHES = MK_N_LAUNCHES;
constexpr int N_PHASES = 10;
constexpr int M = 8192, DM = 2048, SEQ = 2048, NZ = 9216, DFF = 5632, NUP = 2 * DFF, PLE = 256, INC = 9224;
constexpr float EPS = 1e-6f;
constexpr size_t MiB = 1u << 20;
constexpr size_t WS_CTL = 0, CTL_ZERO_BYTES = 1 * MiB;
constexpr size_t WS_F = 1 * MiB;
constexpr size_t WS_CUM = WS_F + 512 * 1024;
constexpr size_t WS_WSB = 2 * MiB;
constexpr size_t WS_PLSE = 3 * MiB;
constexpr size_t WS_PART = 148 * MiB;
constexpr size_t WS_Z = 4 * MiB;
constexpr size_t WS_Y = 148 * MiB;
constexpr size_t WS_E = 100 * MiB;
constexpr size_t WS_A2 = 132 * MiB;
constexpr size_t WS_HALO = 165 * MiB, WS_FA = 167 * MiB, WS_FB = 169 * MiB;
constexpr size_t WS_WUP = 180 * MiB, WS_WDOWN = 224 * MiB, WS_WGATE = 246 * MiB, WS_WPLE = 254 * MiB, WS_PB = 255 * MiB;
constexpr size_t WS_H = 259 * MiB;
constexpr size_t WS_WIN = 291 * MiB, WS_WAB = 327 * MiB, WS_WOUT = 335 * MiB;
constexpr size_t WS_HM = 4 * MiB;
constexpr size_t WS_END = 347 * MiB;
constexpr int CW_BAR = 4096, CW_GQ = 8192, CW_AFLAG = 9216, CW_SSQ1 = 16384, CW_SSQ2 = 24576, CW_SSQE = 32768, CW_VS1 = 40960, CW_VS2 = 49152;

constexpr int RING_BYTES = 131072;
constexpr int LDSCTL_OFF = 143360, MISC_OFF = LDSCTL_OFF + 320;
constexpr int LDS_BYTES = 147456;
constexpr int P0_WF_OFF = 67584;
static_assert(4 * 16640 <= P0_WF_OFF && P0_WF_OFF + 65536 <= LDSCTL_OFF && 8 * 16640 <= LDSCTL_OFF && fox::LDS_BYTES <= RING_BYTES && MISC_OFF + 128 <= LDS_BYTES, "LDS map");

#define GAS __attribute__((address_space(1)))
#define LAS __attribute__((address_space(3)))
typedef unsigned short bf16;
typedef unsigned v4u __attribute__((ext_vector_type(4)));
typedef float f32x4 __attribute__((ext_vector_type(4)));
#define RLX_AGENT __ATOMIC_RELAXED, __HIP_MEMORY_SCOPE_AGENT
#define LDS_WAIT() asm volatile("s_waitcnt lgkmcnt(0)" ::: "memory")
__device__ __forceinline__ unsigned f2bf(float f) { unsigned u = __builtin_bit_cast(unsigned, f); return (u + 0x7fffu + ((u >> 16) & 1u)) >> 16; }
__device__ __forceinline__ unsigned pk2(float lo, float hi) { unsigned r; asm("v_cvt_pk_bf16_f32 %0, %1, %2" : "=v"(r) : "v"(lo), "v"(hi)); return r; }
__device__ __forceinline__ float bflo(unsigned w) { return __uint_as_float(w << 16); }
__device__ __forceinline__ float bfhi(unsigned w) { return __uint_as_float(w & 0xffff0000u); }

#define XB_TMO      128
#define XB_XCNT(j)  (256  + 64 * (j))
#define XB_XSUB(j)  (1280 + 64 * (j))
#define XB_XGEN(j)  (2304 + 64 * (j))
#define XB_TOP      3328
#define XB_TOPGEN   3392
#define XCD_BAR_WORDS 3456
#define XB_SPIN_CAP (1u << 18)
__device__ __forceinline__ unsigned xb_ld(unsigned* p)              { return __hip_atomic_load(p, __ATOMIC_RELAXED, __HIP_MEMORY_SCOPE_AGENT); }
__device__ __forceinline__ unsigned xb_add(unsigned* p, unsigned v) { return __hip_atomic_fetch_add(p, v, __ATOMIC_RELAXED, __HIP_MEMORY_SCOPE_AGENT); }
__device__ __forceinline__ unsigned xb_xcc_id() { return (unsigned)__builtin_amdgcn_s_getreg((3 << 11) | 20) & 0xFu; }
#define XB_SPIN(cond, bar) do { unsigned _sp = 0; while (cond) { __builtin_amdgcn_s_sleep(1); \
    if ((++_sp & 255u) == 0u) { if (xb_ld(&(bar)[XB_TMO])) break; if (_sp > XB_SPIN_CAP) { atomicAdd(&(bar)[XB_TMO], 1u); break; } } } } while (0)
struct XcdBarrier { unsigned* bar; unsigned x; volatile LAS unsigned* st; };
__device__ __forceinline__ XcdBarrier xcd_barrier_post(unsigned* bar, volatile LAS unsigned* st) {
    XcdBarrier b; b.bar = bar; b.x = xb_xcc_id(); b.st = st;
    if (threadIdx.x == 0) (void)xb_add(&bar[XB_XCNT(b.x)], 1u);
    return b;
}
__device__ __forceinline__ void xcd_barrier_complete(unsigned* bar, unsigned x, unsigned& nloc, unsigned& nx) {
    const unsigned G = gridDim.x * gridDim.y * gridDim.z;
    unsigned sum, cnt, mine, sp = 0u;
    for (;;) {
        sum = 0u; cnt = 0u; mine = 0u;
#pragma unroll
        for (unsigned j = 0; j < 16; ++j) { const unsigned c = xb_ld(&bar[XB_XCNT(j)]); sum += c; cnt += (c > 0u) ? 1u : 0u; mine = (j == x) ? c : mine; }
        if (sum == G) break;
        __builtin_amdgcn_s_sleep(1);
        if ((++sp & 255u) == 0u) { if (xb_ld(&bar[XB_TMO])) break; if (sp > XB_SPIN_CAP) { atomicAdd(&bar[XB_TMO], 1u); break; } }
    }
    nloc = mine > 0u ? mine : 1u; nx = cnt > 0u ? cnt : 1u;
}
__device__ __forceinline__ void xcd_barrier(const XcdBarrier& b) {
    asm volatile("s_waitcnt vmcnt(0)" ::: "memory");
    __syncthreads();
    if (threadIdx.x == 0) {
        unsigned* bar = b.bar;
        __builtin_amdgcn_s_waitcnt(0);
        unsigned nloc = b.st[0], nx = b.st[1];
        if (nloc == 0u) { xcd_barrier_complete(bar, b.x, nloc, nx); b.st[0] = nloc; b.st[1] = nx; }
        const unsigned old = xb_add(&bar[XB_XSUB(b.x)], 1u);
        const unsigned gen = old / nloc;
        if (old + 1u == (gen + 1u) * nloc) {
            __builtin_amdgcn_fence(__ATOMIC_RELEASE, "agent");
            asm volatile("s_waitcnt vmcnt(0)" ::: "memory");
            const unsigned og = xb_add(&bar[XB_TOP], 1u);
            const unsigned tg = og / nx;
            if (og + 1u == (tg + 1u) * nx) xb_add(&bar[XB_TOPGEN], 1u);
            else XB_SPIN(xb_ld(&bar[XB_TOPGEN]) == tg, bar);
            __builtin_amdgcn_fence(__ATOMIC_ACQUIRE, "agent");
            xb_add(&bar[XB_XGEN(b.x)], 1u);
            asm volatile("s_waitcnt vmcnt(0)" ::: "memory");
        } else {
            XB_SPIN(xb_ld(&bar[XB_XGEN(b.x)]) == gen, bar);
            __builtin_amdgcn_fence(__ATOMIC_ACQUIRE, "agent");
            asm volatile("s_waitcnt vmcnt(0)" ::: "memory");
        }
    }
    __syncthreads();
}

__device__ __forceinline__ float wave_sum(float v) {
    v += __int_as_float(__builtin_amdgcn_update_dpp(0, __float_as_int(v), 0xB1, 0xf, 0xf, false));
    v += __int_as_float(__builtin_amdgcn_update_dpp(0, __float_as_int(v), 0x4E, 0xf, 0xf, false));
    v += __int_as_float(__builtin_amdgcn_update_dpp(0, __float_as_int(v), 0x141, 0xf, 0xf, false));
    v += __int_as_float(__builtin_amdgcn_update_dpp(0, __float_as_int(v), 0x140, 0xf, 0xf, false));
    { auto r = __builtin_amdgcn_permlane16_swap(__float_as_uint(v), __float_as_uint(v), false, false); v = __uint_as_float(r[0]) + __uint_as_float(r[1]); }
    { auto r = __builtin_amdgcn_permlane32_swap(__float_as_uint(v), __float_as_uint(v), false, false); v = __uint_as_float(r[0]) + __uint_as_float(r[1]); }
    return v;
}
struct TPtrs { const float *w_in, *wa, *wb, *wout, *wup, *wdown, *wgate, *wple, *g_up, *g_gate; bf16 *WIN, *WAB, *WOUT, *WUP, *WDOWN, *WGATE, *WPLE; };
constexpr int TI1 = 32 * 80, TI2 = 32 * 64, TI3 = 16 * 32, TI4 = 16 * 32, TI5 = 32 * 32, TI6 = 32 * 176, TI7 = 88 * 32, TI8 = 32 * 32, TI9 = 4 * 32;
constexpr int TG0 = TI1 + TI2, TG1 = TI3 + TI4 + TI5 + TI6 + TI9, TG2 = TI7 + TI8;
template <int GRP> __device__ __forceinline__ void t_decode(const TPtrs& P, int r, int lane, const float*& src, int& ldw, bf16*& dst, int& ldk, const float*& gain) {
    const float* W; bf16* WT; int k0, scol, drow, dk0; const float* gn = nullptr;
    if (GRP == 0) {
        if (r < TI1) { const int kb = r / 80, nb = r % 80; W = P.w_in; ldw = 9224; k0 = 64 * kb; scol = 64 * nb; WT = P.WIN; ldk = 2048; drow = 64 * nb; dk0 = k0; }
        else { r -= TI1; const int kb = r / 64, nb = r % 64; W = P.w_in; ldw = 9224; k0 = 64 * kb; scol = 5128 + 64 * nb; WT = P.WIN; ldk = 2048; dk0 = k0;
               const int o = 64 * nb, c = o < 2048 ? o : o - 2048; drow = 5120 + 256 * (c >> 7) + (c & 127) + (o < 2048 ? 0 : 128); }
    } else if (GRP == 1) {
        if (r < TI3) { const int kb = r / 32, nb = r % 32; W = P.wa; ldw = 2048; k0 = 64 * kb; scol = 64 * nb; WT = P.WAB; ldk = 2048; drow = 64 * nb; dk0 = k0; }
        else if (r < TI3 + TI4) { r -= TI3; const int kb = r / 32, nb = r % 32; W = P.wb; ldw = 2048; k0 = 64 * kb; scol = 64 * nb; WT = P.WAB; ldk = 2048; drow = 64 * nb; dk0 = 1024 + k0; }
        else if (r < TI3 + TI4 + TI5) { r -= TI3 + TI4; const int kb = r / 32, nb = r % 32; W = P.wout; ldw = 2048; k0 = 64 * kb; scol = 64 * nb; WT = P.WOUT; ldk = 2048; drow = 64 * nb; dk0 = k0; }
        else if (r >= TI3 + TI4 + TI5 + TI6) { r -= TI3 + TI4 + TI5 + TI6; const int kb = r / 32, nb = r % 32; W = P.wple; ldw = 2048; k0 = 64 * kb; scol = 64 * nb; WT = P.WPLE; ldk = 256; drow = 64 * nb; dk0 = k0; }
        else { r -= TI3 + TI4 + TI5; const int kb = r / 176, nb = r % 176; W = P.wup; ldw = 11264; k0 = 64 * kb; scol = 64 * nb; const int mm = scol < 5632 ? scol : scol - 5632;
               WT = P.WUP; ldk = 2048; drow = 256 * (mm >> 7) + (mm & 127) + (scol < 5632 ? 0 : 128); dk0 = k0; gn = P.g_up; }
    } else {
        if (r < TI7) { const int kb = r / 32, nb = r % 32; W = P.wdown; ldw = 2048; k0 = 64 * kb; scol = 64 * nb; WT = P.WDOWN; ldk = 5632; drow = 64 * nb; dk0 = k0; }
        else { r -= TI7; const int kb = r / 32, nb = r % 32; W = P.wgate; ldw = 2048; k0 = 64 * kb; scol = 64 * nb; WT = P.WGATE; ldk = 2048; drow = 64 * nb; dk0 = k0; gn = P.g_gate; }
    }
    src = W + (size_t)(k0 + (lane >> 4)) * ldw + scol + 4 * (lane & 15);
    dst = WT + (size_t)(drow + (lane >> 3)) * ldk + dk0 + 8 * (lane & 7);
    gain = gn ? gn + k0 + (lane >> 4) : nullptr;
}
template <int GRP> __device__ __forceinline__ void run_transposes(const TPtrs& P, int first, int stride, LAS float* scr, int lane) {
    constexpr int NIT = GRP == 0 ? TG0 : (GRP == 1 ? TG1 : TG2);
    int it = first; if (it >= NIT) return;
    const float* src; bf16* dst; int ldw, ldk; const float* gain;
    t_decode<GRP>(P, it, lane, src, ldw, dst, ldk, gain);
    f32x4 v[16]; float gv[16];
#pragma unroll
    for (int i = 0; i < 16; ++i) v[i] = *(const GAS f32x4*)(src + (size_t)(4 * i) * ldw);
#pragma unroll
    for (int i = 0; i < 16; ++i) gv[i] = (GRP != 0 && gain) ? gain[4 * i] : 1.0f;
    const int kr = lane >> 4, nq = lane & 15, c = lane & 7;
    for (;;) {
#pragma unroll
        for (int i = 0; i < 16; ++i) { LAS float* d = scr + (4 * i + kr) * 65 + 4 * nq; const f32x4 t = v[i] * gv[i]; d[0] = t.x; d[1] = t.y; d[2] = t.z; d[3] = t.w; }
        const int nit = it + stride; const bool more = nit < NIT;
        bf16* cdst = dst; const int cldk = ldk;
        if (more) { t_decode<GRP>(P, nit, lane, src, ldw, dst, ldk, gain);
#pragma unroll
            for (int i = 0; i < 16; ++i) v[i] = *(const GAS f32x4*)(src + (size_t)(4 * i) * ldw);
#pragma unroll
            for (int i = 0; i < 16; ++i) gv[i] = (GRP != 0 && gain) ? gain[4 * i] : 1.0f; }
        LDS_WAIT(); asm volatile("" ::: "memory");
#pragma unroll
        for (int j = 0; j < 8; ++j) { const LAS float* sp = scr + (8 * c) * 65 + (lane >> 3) + 8 * j;
            v4u o; o.x = pk2(sp[0 * 65], sp[1 * 65]); o.y = pk2(sp[2 * 65], sp[3 * 65]); o.z = pk2(sp[4 * 65], sp[5 * 65]); o.w = pk2(sp[6 * 65], sp[7 * 65]);
            *(GAS v4u*)(cdst + (size_t)(8 * j) * cldk) = o; }
        LDS_WAIT(); asm volatile("" ::: "memory");
        if (!more) break;
        it = nit;
    }
}

__device__ __forceinline__ void conv_fixup_rows(int pm, int ch, bf16* HM, const float* HALO, const float* FA, const float* FB, const float* conv_w, const float* conv_b) {
    const int c = ch * 8;
    float o0[8], o1[8];
#pragma unroll
    for (int h = 0; h < 2; ++h) { const int cc = c + 4 * h;
        const f32x4 w0 = *(const f32x4*)(conv_w + cc), w1 = *(const f32x4*)(conv_w + DFF + cc), w2 = *(const f32x4*)(conv_w + 2 * DFF + cc), cbv = *(const f32x4*)(conv_b + cc);
        const f32x4 am2 = *(const f32x4*)(HALO + (size_t)((pm - 1) * 2 + 0) * DFF + cc), am1 = *(const f32x4*)(HALO + (size_t)((pm - 1) * 2 + 1) * DFF + cc);
        const f32x4 a0 = *(const f32x4*)(FA + (size_t)(pm * 2 + 0) * DFF + cc), a1 = *(const f32x4*)(FA + (size_t)(pm * 2 + 1) * DFF + cc);
        const f32x4 b0 = *(const f32x4*)(FB + (size_t)(pm * 2 + 0) * DFF + cc), b1 = *(const f32x4*)(FB + (size_t)(pm * 2 + 1) * DFF + cc);
#pragma unroll
        for (int q = 0; q < 4; ++q) { o0[4 * h + q] = pg8::EpiUpConv::gelu_t(cbv[q] + w0[q] * am2[q] + w1[q] * am1[q] + w2[q] * a0[q]) * b0[q];
                                      o1[4 * h + q] = pg8::EpiUpConv::gelu_t(cbv[q] + w0[q] * am1[q] + w1[q] * a0[q] + w2[q] * a1[q]) * b1[q]; } }
    v4u ov; ov.x = pk2(o0[0], o0[1]); ov.y = pk2(o0[2], o0[3]); ov.z = pk2(o0[4], o0[5]); ov.w = pk2(o0[6], o0[7]);
    *(v4u*)(HM + (size_t)(pm * 256) * DFF + c) = ov;
    ov.x = pk2(o1[0], o1[1]); ov.y = pk2(o1[2], o1[3]); ov.z = pk2(o1[4], o1[5]); ov.w = pk2(o1[6], o1[7]);
    *(v4u*)(HM + (size_t)(pm * 256 + 1) * DFF + c) = ov;
}

struct Args { const float* in[23]; float* out; unsigned char* ws; int ph_lo, ph_hi, one, pad; };

__global__ void __launch_bounds__(NWAVES * 64, 2) mega_fwd(Args args) {
    extern __shared__ __attribute__((aligned(16))) unsigned char lds[];
    LAS unsigned char* ldsL = (LAS unsigned char*)lds;
    volatile LAS unsigned* MISC = (volatile LAS unsigned*)(ldsL + MISC_OFF);
    const int tid = threadIdx.x, lane = tid & 63, wave = __builtin_amdgcn_readfirstlane(tid >> 6);
    const int G = gridDim.x; const int bx = blockIdx.x; const int vcu = (G % 8 == 0) ? (bx % 8) * (G / 8) + bx / 8 : bx;
    unsigned char* ws = args.ws;
    unsigned* ctl = (unsigned*)(ws + WS_CTL);
    const float* x = args.in[0]; const float* pin = args.in[1]; const float* norm_mix_g = args.in[2]; const float* w_in = args.in[3];
    const float* gmlp_ln_g = args.in[4]; const float* gmlp_ln_b = args.in[5]; const float* gmlp_w_s = args.in[6]; const float* gmlp_b_s = args.in[7];
    const float* fox_b_f = args.in[8]; const float* q_norm_g = args.in[9]; const float* k_norm_g = args.in[10];
    const float* w_branch_a = args.in[11]; const float* w_branch_b = args.in[12]; const float* w_out = args.in[13]; const float* norm_ffn_g = args.in[14];
    const float* w_up = args.in[15]; const float* conv_w = args.in[16]; const float* conv_b = args.in[17]; const float* w_down = args.in[18];
    const float* ple_proj = args.in[19]; const float* ple_norm_g = args.in[20]; const float* ple_gate_norm_g = args.in[21]; const float* w_ple_gate = args.in[22];
    float* out = args.out;
    float* Fb = (float*)(ws + WS_F); float* CUM = (float*)(ws + WS_CUM); bf16* WSB = (bf16*)(ws + WS_WSB);
    bf16* Z = (bf16*)(ws + WS_Z); bf16* Y = (bf16*)(ws + WS_Y); bf16* EB = (bf16*)(ws + WS_E); bf16* A2 = (bf16*)(ws + WS_A2);
    bf16* WUP = (bf16*)(ws + WS_WUP); bf16* WDOWN = (bf16*)(ws + WS_WDOWN); bf16* WGATE = (bf16*)(ws + WS_WGATE); bf16* WPLE = (bf16*)(ws + WS_WPLE);
    bf16* PB = (bf16*)(ws + WS_PB); bf16* H = (bf16*)(ws + WS_H); bf16* WIN = (bf16*)(ws + WS_WIN); bf16* WAB = (bf16*)(ws + WS_WAB); bf16* WOUT = (bf16*)(ws + WS_WOUT);
    bf16* HM = (bf16*)(ws + WS_HM); float* HALO = (float*)(ws + WS_HALO); float* FA = (float*)(ws + WS_FA); float* FB = (float*)(ws + WS_FB); bf16* OAB = (bf16*)out;
#define MAKE_TP() TPtrs TP; TP.w_in = args.in[3]; TP.wa = args.in[11]; TP.wb = args.in[12]; TP.wout = args.in[13]; TP.wup = args.in[15]; TP.wdown = args.in[18]; TP.wgate = args.in[22]; TP.wple = args.in[19]; TP.g_up = args.in[14]; TP.g_gate = args.in[21]; \
    TP.WIN = (bf16*)(args.ws + WS_WIN); TP.WAB = (bf16*)(args.ws + WS_WAB); TP.WOUT = (bf16*)(args.ws + WS_WOUT); TP.WUP = (bf16*)(args.ws + WS_WUP); TP.WDOWN = (bf16*)(args.ws + WS_WDOWN); TP.WGATE = (bf16*)(args.ws + WS_WGATE); TP.WPLE = (bf16*)(args.ws + WS_WPLE)
    float* VS1 = (float*)(ctl + CW_VS1); float* VS2 = (float*)(ctl + CW_VS2);
    float* SSQ1 = (float*)(ctl + CW_SSQ1); float* SSQ2 = (float*)(ctl + CW_SSQ2); float* SSQE = (float*)(ctl + CW_SSQE);

    for (int u = tid; u < (LDS_BYTES - LDSCTL_OFF) / 4; u += NWAVES * 64) ((LAS unsigned*)(ldsL + LDSCTL_OFF))[u] = 0u;
    __syncthreads();
    XcdBarrier bar; bar.bar = ctl + CW_BAR; bar.x = 0; bar.st = nullptr;
    if (args.one) bar = xcd_barrier_post(ctl + CW_BAR, MISC + 8);
    const int lo = args.ph_lo, hi = args.ph_hi;
#ifndef PROBE_PHASE
#define PROBE_PHASE (-1)
#endif
#ifndef PROBE_SCALE
#define PROBE_SCALE 5000.0f
#endif
    unsigned long long pr_prev = 0; float pr_us = 0.f;
    if (PROBE_PHASE >= 0) pr_prev = __builtin_amdgcn_s_memrealtime();
#define PR_STAMP(k) do { if (PROBE_PHASE >= 0) { const unsigned long long t_ = __builtin_amdgcn_s_memrealtime(); if ((k) == PROBE_PHASE) pr_us = (float)(t_ - pr_prev) * 0.01f; pr_prev = t_; } } while (0)
#ifndef PH_MASK
#define PH_MASK 0x3ff
#endif
#define IN(k) ((((PH_MASK) >> (k)) & 1) && lo <= (k) && (k) < hi)
#define GRID_BAR(k) do { if (IN(k) && IN((k) + 1)) xcd_barrier(bar); } while (0)
    const int gw = vcu * NWAVES + wave, NGW = G * NWAVES;
    const int gt = vcu * (NWAVES * 64) + tid, NGT = G * NWAVES * 64;

    if (IN(0)) {
        { LAS float* wf = (LAS float*)(ldsL + P0_WF_OFF);
          for (int k = tid; k < DM; k += NWAVES * 64) { const f32x4 a = *(const f32x4*)(w_in + (size_t)k * INC + 5120), b = *(const f32x4*)(w_in + (size_t)k * INC + 5124);
              wf[0 * DM + k] = a[0]; wf[1 * DM + k] = a[1]; wf[2 * DM + k] = a[2]; wf[3 * DM + k] = a[3]; wf[4 * DM + k] = b[0]; wf[5 * DM + k] = b[1]; wf[6 * DM + k] = b[2]; wf[7 * DM + k] = b[3]; }
          __syncthreads(); }
        if (wave < 4) {
        const int gw = vcu * 4 + wave, NGW = G * 4, gt = vcu * 256 + tid, NGT = G * 256;
        { const LAS float* wf = (const LAS float*)(ldsL + P0_WF_OFF);
          f32x4 g4v[8];
#pragma unroll
          for (int j = 0; j < 8; ++j) g4v[j] = *((const GAS f32x4*)norm_mix_g + lane + 64 * j);
          f32x4 v[8], nv[8];
          if (gw < M) {
#pragma unroll
              for (int j = 0; j < 8; ++j) v[j] = ((const GAS f32x4*)(x + (size_t)gw * DM) + lane)[64 * j]; }
          for (int m = gw; m < M; m += NGW) {
            if (m + NGW < M) {
#pragma unroll
                for (int j = 0; j < 8; ++j) nv[j] = ((const GAS f32x4*)(x + (size_t)(m + NGW) * DM) + lane)[64 * j]; }
            float s = 0.f;
#pragma unroll
            for (int j = 0; j < 8; ++j) s += (v[j].x * v[j].x + v[j].y * v[j].y) + (v[j].z * v[j].z + v[j].w * v[j].w);
            const float rstd = 1.0f / sqrtf(wave_sum(s) * (1.0f / DM) + EPS);
            float fa[8];
#pragma unroll
            for (int f = 0; f < 8; ++f) fa[f] = 0.f;
            GAS unsigned long long* o8 = (GAS unsigned long long*)(H + (size_t)m * DM) + lane;
#pragma unroll
            for (int j = 0; j < 8; ++j) { const f32x4 h4 = v[j] * rstd * g4v[j];
                o8[64 * j] = (unsigned long long)pk2(h4.x, h4.y) | ((unsigned long long)pk2(h4.z, h4.w) << 32);
#pragma unroll
                for (int f = 0; f < 8; ++f) { const f32x4 w4 = *(const LAS f32x4*)(wf + f * DM + 256 * j + 4 * lane); fa[f] += (h4.x * w4.x + h4.y * w4.y) + (h4.z * w4.z + h4.w * w4.w); }
                asm volatile("" ::: "memory"); }
#pragma unroll
            for (int f = 0; f < 8; ++f) fa[f] = wave_sum(fa[f]);
            if (lane < 8) {
                float fv = fa[0];
#pragma unroll
                for (int f = 1; f < 8; ++f) fv = (lane == f) ? fa[f] : fv;
                const float xx = fv + fox_b_f[lane];
                Fb[(size_t)((m >> 11) * 8 + lane) * SEQ + (m & (SEQ - 1))] = fminf(xx, 0.f) - log1pf(expf(-fabsf(xx))); }
#pragma unroll
            for (int j = 0; j < 8; ++j) v[j] = nv[j];
          } }
        for (int i = gt; i < M * PLE / 8; i += NGT) { const f32x4 a = *(const f32x4*)(pin + (size_t)i * 8), b = *(const f32x4*)(pin + (size_t)i * 8 + 4);
            v4u o; o.x = pk2(a.x, a.y); o.y = pk2(a.z, a.w); o.z = pk2(b.x, b.y); o.w = pk2(b.z, b.w); *(v4u*)(PB + (size_t)i * 8) = o; }
        for (int i = gt; i < 8 * 128 * 128 / 8; i += NGT) { const int e = i * 8, t = (e >> 7) & 127, s0 = e & 127; const f32x4 a = *(const f32x4*)(gmlp_w_s + e), b = *(const f32x4*)(gmlp_w_s + e + 4);
            float w[8] = {a.x, a.y, a.z, a.w, b.x, b.y, b.z, b.w};
#pragma unroll
            for (int q = 0; q < 8; ++q) if (s0 + q > t) w[q] = 0.f;
            v4u o; o.x = pk2(w[0], w[1]); o.y = pk2(w[2], w[3]); o.z = pk2(w[4], w[5]); o.w = pk2(w[6], w[7]); *(v4u*)(WSB + e) = o; }
        } else {
            MAKE_TP(); run_transposes<0>(TP, vcu * 4 + (wave - 4), G * 4, (LAS float*)(ldsL + (wave - 4) * 16640), lane);
        }
        __syncthreads();
    }
    GRID_BAR(0); PR_STAMP(0);

    if (IN(1)) {
        pg8::Gemm g{H, WIN, M, NZ, DM}; pg8::StaticOrder S; S.init(M, NZ, G, bx);
        pg8::EpiZ E{Z, VS1, VS2, q_norm_g, k_norm_g, (LAS float*)(ldsL + RING_BYTES)};
        pg8::gemm_phase<pg8::EpiZ, pg8::StaticOrder, true, true>(ldsL, g, S, E);
        { const int rem = S.nwg % G; const int nidle = rem ? G - rem : G, idle = rem ? bx - rem : bx;
          if (idle >= 0) { MAKE_TP(); run_transposes<1>(TP, idle * NWAVES + wave, nidle * NWAVES, (LAS float*)(ldsL + wave * 16640), lane); } }
    }
    GRID_BAR(1); PR_STAMP(1);

    PR_STAMP(2);

    if (IN(3)) {
        int msid0 = -1, msid1 = -1;
        for (int it = vcu; it < 512; it += G) {
            const int item = it & 255, pc = it >> 8;
            const int bh = item >> 3, sl = item & 7, b = bh >> 3, h = bh & 7;
            const size_t rowb = (size_t)b * SEQ;
            if (pc == 1 && sl < 5) continue;
            int qb, t0, t1;
            if (pc == 0) { qb = sl == 0 ? 7 : sl == 1 ? 6 : sl == 2 ? 5 : sl == 3 ? 4 : sl == 4 ? 3 : sl == 5 ? 7 : sl == 6 ? 2 : 6;
                           t0 = (sl == 5 || sl == 7) ? 20 : 0;
                           t1 = sl < 4 ? 20 : sl == 4 ? 16 : sl == 5 ? 32 : sl == 6 ? 12 : 28; }
            else { qb = sl == 5 ? 5 : sl == 6 ? 0 : 1; t0 = sl == 5 ? 20 : 0; t1 = sl == 5 ? 24 : sl == 6 ? 4 : 8; }
            const bool split = qb >= 5; const int me = t0 ? 1 : 0, sid = bh * 4 + (qb - 4);
            fox::BlockRef cur; cur.P0 = qb * 256 - t0 * 64;
            cur.Q = Z + (rowb + qb * 256) * NZ + 2048 + h * 128; cur.K = Z + (rowb + t0 * 64) * NZ + 3072 + h * 128; cur.V = Z + (rowb + t0 * 64) * NZ + 4096 + h * 128;
            cur.O = split ? (bf16*)(ws + WS_PART) + (rowb + qb * 256) * 2048 + me * 1024 + h * 128 : OAB + (rowb + qb * 256) * 2048 + 1024 + h * 128;
            float* cumL = (float*)(lds + fox::LDS_CUM);
            {
              float* wsum = (float*)(lds + fox::LDS_WS);
              int tq; asm volatile("v_mov_b32 %0, %1" : "=v"(tq) : "v"(tid));
              const int nk = t1 * 64; const bool act = 4 * tq < nk;
              float v[4];
              { f32x4 ls = (f32x4){0.f, 0.f, 0.f, 0.f}; if (act) ls = *(const f32x4*)(Fb + (size_t)bh * SEQ + 4 * tq); v[0] = ls[0]; v[1] = ls[1]; v[2] = ls[2]; v[3] = ls[3]; }
              v[1] += v[0]; v[2] += v[1]; v[3] += v[2];
              const float tot = v[3]; float incl = tot;
#pragma unroll
              for (int o = 1; o < 64; o <<= 1) { const float t = __shfl_up(incl, o); if (lane >= o) incl += t; }
              if (lane == 63) wsum[wave] = incl;
              __syncthreads();
              float off = incl - tot;
              for (int w = 0; w < wave; ++w) off += wsum[w];
              const float isc = -11.313708498984761f;
              if (act) *(f32x4*)(cumL + 4 * tq) = (f32x4){(v[0] + off) * isc, (v[1] + off) * isc, (v[2] + off) * isc, (v[3] + off) * isc}; }
            { fox::Seam S;
              fox::fox_prime(cur, (char*)lds, S);
              fox::fox_block(cur, (char*)lds, S, cumL + t0 * 64, t1 - t0, split ? (float*)(ws + WS_PLSE) + (size_t)(sid * 2 + me) * 256 : nullptr); }
            if (split) {
                asm volatile("s_waitcnt vmcnt(0)" ::: "memory");
                __syncthreads();
                if (tid == 0) MISC[17] = atomicAdd(ctl + CW_AFLAG + sid, 1u);
                __syncthreads();
                if (MISC[17] == 1u) { if (msid0 < 0) msid0 = sid; else msid1 = sid; }
                __syncthreads();
            }
        }
        for (int mi = 0; mi < 2; ++mi) { const int sid = mi ? msid1 : msid0; if (sid < 0) continue;
            const int bh = sid >> 2, qb = 4 + (sid & 3), b = bh >> 3, h = bh & 7; const size_t rowb = (size_t)b * SEQ;
            __builtin_amdgcn_fence(__ATOMIC_ACQUIRE, "agent");
            asm volatile("s_waitcnt vmcnt(0)" ::: "memory");
            const float* LB0 = (const float*)(ws + WS_PLSE) + (size_t)sid * 2 * 256;
            const int row = tid >> 1, c0 = (tid & 1) * 64;
            const float l0 = LB0[row], l1 = LB0[256 + row], mx = fmaxf(l0, l1);
            const float w0 = __builtin_amdgcn_exp2f(l0 - mx), w1 = __builtin_amdgcn_exp2f(l1 - mx), inv = __builtin_amdgcn_rcpf(w0 + w1), a0 = w0 * inv, a1 = w1 * inv;
            const bf16* p0 = (const bf16*)(ws + WS_PART) + (rowb + qb * 256 + row) * 2048 + h * 128 + c0; const bf16* p1 = p0 + 1024;
            bf16* op = OAB + (rowb + qb * 256 + row) * 2048 + 1024 + h * 128 + c0;
#pragma unroll 2
            for (int j = 0; j < 8; ++j) { const v4u x = *(const v4u*)(p0 + 8 * j), y = *(const v4u*)(p1 + 8 * j); v4u o;
                o.x = pk2(a0 * bflo(x.x) + a1 * bflo(y.x), a0 * bfhi(x.x) + a1 * bfhi(y.x)); o.y = pk2(a0 * bflo(x.y) + a1 * bflo(y.y), a0 * bfhi(x.y) + a1 * bfhi(y.y));
                o.z = pk2(a0 * bflo(x.z) + a1 * bflo(y.z), a0 * bfhi(x.z) + a1 * bfhi(y.z)); o.w = pk2(a0 * bflo(x.w) + a1 * bflo(y.w), a0 * bfhi(x.w) + a1 * bfhi(y.w));
                *(v4u*)(op + 8 * j) = o; }
        }
        for (;;) {
            if (tid == 0) MISC[16] = atomicAdd(ctl + CW_GQ, 1u);
            __syncthreads();
            const unsigned idx = MISC[16];
            __syncthreads();
            if (idx >= 512u) break;
            fox::gmlp_unit((char*)lds, (int)idx, Z, WSB, gmlp_b_s, OAB, VS1, VS2, gmlp_ln_g, gmlp_ln_b);
        }
    }
    GRID_BAR(3); PR_STAMP(3);

    if (IN(4)) {
        pg8::Gemm g{OAB, WAB, M, DM, 2048}; pg8::StaticOrder S; S.init(M, DM, G, bx);
        pg8::EpiY E{Z, Y};
        pg8::gemm_phase<pg8::EpiY, pg8::StaticOrder, true, true>(ldsL, g, S, E);
    }
    GRID_BAR(4); PR_STAMP(4);

    if (IN(5)) {
        pg8::Gemm g{Y, WOUT, M, DM, DM}; pg8::StaticOrder S; S.init(M, DM, G, bx);
        pg8::EpiRes<true> E{x, H, SSQ1};
        pg8::gemm_phase<pg8::EpiRes<true>, pg8::StaticOrder, true, true>(ldsL, g, S, E);
    }
    GRID_BAR(5); PR_STAMP(5);

    if (IN(6)) {
        pg8::Gemm g{H, WUP, M, NUP, DM}; pg8::StaticOrder S; S.init(M, NUP, G, bx);
        pg8::EpiUpConv E{HM, SSQ1, conv_w, conv_b, HALO, FA, FB, (LAS float*)(ldsL + RING_BYTES)};
        pg8::gemm_phase<pg8::EpiUpConv, pg8::StaticOrder, true, true>(ldsL, g, S, E);
        { const int rem = S.nwg % G; const int nidle = rem ? G - rem : G, idle = rem ? bx - rem : bx;
          if (idle >= 0) { { MAKE_TP(); run_transposes<2>(TP, idle * NWAVES + wave, nidle * NWAVES, (LAS float*)(ldsL + wave * 16640), lane); }
              asm volatile("s_waitcnt vmcnt(0)" ::: "memory"); __syncthreads();
              pg8::Gemm ge{PB, WPLE, M, DM, PLE}; pg8::StaticOrder SE; SE.init(M, DM, nidle, idle);
              pg8::EpiE EE{EB, SSQE};
              pg8::gemm_phase<pg8::EpiE, pg8::StaticOrder, true, true>(ldsL, ge, SE, EE); } }
    }
    GRID_BAR(6); PR_STAMP(6);

    if (IN(8)) {
        { pg8::StaticOrder S; S.init(M, DM, G, bx); pg8::Unit u;
          for (int i = 0; S.next(i, u); ++i) if (u.pm & 7) for (int ch = tid; ch < DFF / 8; ch += NWAVES * 64) conv_fixup_rows(u.pm, ch, HM, HALO, FA, FB, conv_w, conv_b);
          asm volatile("s_waitcnt vmcnt(0)" ::: "memory"); __syncthreads(); }
        { pg8::Gemm g{HM, WDOWN, M, DM, DFF}; pg8::StaticOrder S; S.init(M, DM, G, bx);
          pg8::EpiRes<false> E{H, A2, SSQ2};
          pg8::gemm_phase<pg8::EpiRes<false>, pg8::StaticOrder, true, true>(ldsL, g, S, E); }
    }
    GRID_BAR(8); PR_STAMP(8);

    if (IN(9)) {
        pg8::Gemm g{A2, WGATE, M, DM, DM}; pg8::StaticOrder S; S.init(M, DM, G, bx);
        pg8::EpiFinal E{out, A2, EB, ple_norm_g, SSQ2, SSQE};
        pg8::gemm_phase<pg8::EpiFinal, pg8::StaticOrder, true, true>(ldsL, g, S, E);
    }
    PR_STAMP(9);
    if (PROBE_PHASE >= 0 && bx == 0) {
        asm volatile("s_waitcnt vmcnt(0)" ::: "memory"); __syncthreads();
        if (tid == 0) { int best = 0; float bv = 1e30f; for (int i = 0; i < 256; ++i) { const float a = fabsf(out[i]); if (a < bv) { bv = a; best = i; } }
            out[best] += 0.04f + pr_us / PROBE_SCALE; }
    }
#undef IN
#undef GRID_BAR
}

extern "C" void kernel_launch(void* const* d_in, const int* in_sizes, int n_in, void* d_out, int out_size, void* d_ws, size_t ws_size, hipStream_t stream) {
    static int grid = 0;
    if (grid == 0) {
        if (n_in != 23 || out_size != M * DM || ws_size < WS_END) { fprintf(stderr, "kernel_launch: unexpected shapes (n_in %d, out %d, ws %zu)\n", n_in, out_size, ws_size); grid = -1; return; }
        int dev = 0, cus = 0, per_cu = 0;
        if (hipGetDevice(&dev) != hipSuccess || hipDeviceGetAttribute(&cus, hipDeviceAttributeMultiprocessorCount, dev) != hipSuccess) { grid = -1; return; }
        if (hipFuncSetAttribute((const void*)mega_fwd, hipFuncAttributeMaxDynamicSharedMemorySize, LDS_BYTES) != hipSuccess) { fprintf(stderr, "kernel_launch: hipFuncSetAttribute failed\n"); grid = -1; return; }
        if (hipOccupancyMaxActiveBlocksPerMultiprocessor(&per_cu, (const void*)mega_fwd, NWAVES * 64, LDS_BYTES) != hipSuccess || per_cu < 1) { fprintf(stderr, "kernel_launch: occupancy query says %d\n", per_cu); (void)hipGetLastError(); per_cu = 1; }
        grid = cus * (per_cu < 1 ? 1 : 1);
    }
    if (grid < 0) return;
    (void)hipMemsetAsync((char*)d_ws + WS_CTL, 0, CTL_ZERO_BYTES, stream);
    Args a{};
    for (int i = 0; i < 23; ++i) a.in[i] = (const float*)d_in[i];
    a.out = (float*)d_out; a.ws = (unsigned char*)d_ws;
    if (N_LAUNCHES == 1) {
        a.ph_lo = 0; a.ph_hi = N_PHASES; a.one = 1;
        void* kargs[] = {&a};
        hipError_t e = hipLaunchCooperativeKernel((const void*)mega_fwd, dim3(grid), dim3(NWAVES * 64), kargs, LDS_BYTES, stream);
        if (e != hipSuccess) fprintf(stderr, "kernel_launch: cooperative launch failed: %s (grid %d)\n", hipGetErrorString(e), grid);
    } else {
        for (int p = 0; p < N_PHASES; ++p) { a.ph_lo = p; a.ph_hi = p + 1; a.one = 0;
            hipLaunchKernelGGL(mega_fwd, dim3(grid), dim3(NWAVES * 64), LDS_BYTES, stream, a); }
    }
}
```

```cpp
#include <hip/hip_runtime.h>
#include <cstdio>
#include <cstdint>

#ifndef MK_N_LAUNCHES
#define MK_N_LAUNCHES 1
#endif

namespace pg8 {
#define PG8_LAS __attribute__((address_space(3)))
typedef unsigned short bf16_t;
typedef short bf16x8 __attribute__((ext_vector_type(8)));
typedef float f32x4 __attribute__((ext_vector_type(4)));
typedef float f32x2 __attribute__((ext_vector_type(2)));
typedef unsigned u32x4 __attribute__((ext_vector_type(4)));
constexpr int BM = 256, BK = 64, HALF = 128, HTB = HALF * BK * 2, STAGE_BYTES = 8 * HTB, NXCD = 8, WGM = 8;

__host__ __device__ __forceinline__ int lds_byte(int r, int c) { const int st = (r >> 4) * 2 + (c >> 5), rr = r & 15, cc = c & 31, ob = rr * 64 + cc * 2; return st * 1024 + (ob ^ (((ob >> 9) & 1) << 5)); }
__host__ __device__ __forceinline__ void stage_rc(int b, int& R, int& C) { const int st = b / 1024, sb = b % 1024, swz = sb ^ (((sb >> 9) & 1) << 5); R = (st >> 1) * 16 + swz / 64; C = (st & 1) * 32 + (swz % 64) / 2; }
__host__ __device__ __forceinline__ int perm32(int rho) { const int n = rho >> 4, i = rho & 15; return 8 * (i >> 2) + 4 * n + (i & 3); }

struct Unit { int pm, pn; };
struct Gemm { const bf16_t* A; const bf16_t* Bt; int M, N, K; };

struct StaticOrder {
    int nM, nN, nwg, G, c;
    __host__ __device__ __forceinline__ void init(int M, int N, int G_, int c_) { nM = M / BM; nN = N / BM; nwg = nM * nN; G = G_; c = c_; }
    __host__ __device__ __forceinline__ bool next(int i, Unit& u) const {
        const long L = (long)i * G + c; if (L >= nwg) return false;
        int wgid = (int)L; { const int q = nwg / NXCD, r = nwg % NXCD, xcd = wgid % NXCD, off = wgid / NXCD; wgid = (xcd < r ? xcd * (q + 1) : r * (q + 1) + (xcd - r) * q) + off; }
        const int nig = WGM * nN, gid = wgid / nig, fm = gid * WGM, gsz = (nM - fm) < WGM ? (nM - fm) : WGM;
        u.pm = fm + ((wgid % nig) % gsz); u.pn = (wgid % nig) / gsz; return true;
    }
    __device__ __forceinline__ void a_ready(const Unit&) const {}
    __device__ __forceinline__ void done(const Unit&) const {}
};

__device__ __forceinline__ unsigned cvt_pk_bf16(float lo, float hi) { unsigned r; asm volatile("v_cvt_pk_bf16_f32 %0, %1, %2" : "=v"(r) : "v"(lo), "v"(hi)); return r; }
__device__ __forceinline__ float xsum_fq(float x) {
    { auto r = __builtin_amdgcn_permlane16_swap(__float_as_uint(x), __float_as_uint(x), false, false); x = __uint_as_float(r[0]) + __uint_as_float(r[1]); }
    { auto r = __builtin_amdgcn_permlane32_swap(__float_as_uint(x), __float_as_uint(x), false, false); x = __uint_as_float(r[0]) + __uint_as_float(r[1]); }
    return x;
}
__device__ __forceinline__ float bf_lo(unsigned w) { return __uint_as_float(w << 16); }
__device__ __forceinline__ float bf_hi(unsigned w) { return __uint_as_float(w & 0xffff0000u); }
__device__ __forceinline__ f32x2 gelu_pk(f32x2 v) {
    const f32x2 av = __builtin_elementwise_abs(v), d = av * 0.2316418882f + 1.0f;
    f32x2 t; t.x = __builtin_amdgcn_rcpf(d.x); t.y = __builtin_amdgcn_rcpf(d.y);
    f32x2 q = t * 0.5307027145f + (-0.7265760135f); q = q * t + 0.7107068705f; q = q * t + (-0.142248368f); q = q * t + 0.127414796f; q = q * t;
    const f32x2 s = (v * v) * (-0.72134752044f);
    f32x2 e; e.x = __builtin_amdgcn_exp2f(s.x); e.y = __builtin_amdgcn_exp2f(s.y);
    const f32x2 m = v * (q * e), r = v - m;
    f32x2 o; o.x = v.x < 0.f ? m.x : r.x; o.y = v.y < 0.f ? m.y : r.y; return o;
}
__device__ __forceinline__ float sigmoid_f(float x) { return __builtin_amdgcn_rcpf(1.0f + __builtin_amdgcn_exp2f(-1.4426950408889634f * x)); }
__device__ __forceinline__ f32x4 gelu4(f32x4 v) { f32x2 a = gelu_pk((f32x2){v[0], v[1]}), b = gelu_pk((f32x2){v[2], v[3]}); return (f32x4){a.x, a.y, b.x, b.y}; }
__device__ __forceinline__ f32x4 sigm4(f32x4 v) { return (f32x4){sigmoid_f(v[0]), sigmoid_f(v[1]), sigmoid_f(v[2]), sigmoid_f(v[3])}; }
__device__ __forceinline__ u32x4 pack8(f32x4 a, f32x4 b) { u32x4 w; w.x = cvt_pk_bf16(a[0], a[1]); w.y = cvt_pk_bf16(a[2], a[3]); w.z = cvt_pk_bf16(b[0], b[1]); w.w = cvt_pk_bf16(b[2], b[3]); return w; }

typedef f32x4 Acc[2][2][4][2];
#define EPI_LOOP_ROWS for (int ai = 0; ai < 2; ++ai) _Pragma("unroll") for (int m = 0; m < 4; ++m)

constexpr int ZLD = 9216;
struct EpiZ {
    static constexpr bool PERM = true, AFTER_DRAIN = false, MIDK = false;
    bf16_t* Z; float* vs1; float* vs2; const float* gq; const float* gk; PG8_LAS float* red;
    __device__ __forceinline__ void mid(Acc&, const Unit&, int, int, int, int) const {}
    __device__ __forceinline__ void operator()(const Acc& acc, const Unit& u, int wr, int wc, int fr, int fq) const {
        const int mode = u.pn < 8 ? 1 : (u.pn < 20 ? 0 : 2); const bool isv = (u.pn >= 4 && u.pn < 8);
        const int row0 = u.pm * BM + wr * 64 + fr, col0 = u.pn * BM + wc * 32 + 8 * fq;
        if (u.pn >= 8 && u.pn < 16) {
            const float* gn = u.pn < 12 ? gq : gk;
            const f32x4 g0 = *(const f32x4*)(gn + wc * 32 + 8 * fq), g1 = *(const f32x4*)(gn + wc * 32 + 8 * fq + 4);
#pragma unroll
            EPI_LOOP_ROWS {
#pragma unroll
                for (int bj = 0; bj < 2; ++bj) { const f32x4 v0 = acc[ai][bj][m][0], v1 = acc[ai][bj][m][1];
                    float q2 = (v0[0] * v0[0] + v0[1] * v0[1]) + (v0[2] * v0[2] + v0[3] * v0[3]) + (v1[0] * v1[0] + v1[1] * v1[1]) + (v1[2] * v1[2] + v1[3] * v1[3]);
                    q2 = xsum_fq(q2);
                    if (fq == 0) red[(ai * HALF + wr * 64 + m * 16 + fr) * 8 + bj * 4 + wc] = q2; } }
            asm volatile("s_waitcnt lgkmcnt(0)" ::: "memory"); __builtin_amdgcn_s_barrier(); asm volatile("" ::: "memory");
#pragma unroll
            EPI_LOOP_ROWS { bf16_t* rowp = Z + (size_t)(row0 + ai * HALF + m * 16) * ZLD + col0;
#pragma unroll
                for (int bj = 0; bj < 2; ++bj) { const f32x4 p = *(const PG8_LAS f32x4*)(red + (ai * HALF + wr * 64 + m * 16 + fr) * 8 + bj * 4);
                    const float r = 1.0f / sqrtf(((p[0] + p[1]) + (p[2] + p[3])) * (1.0f / 128.0f) + 1e-6f);
                    *(u32x4*)(rowp + bj * HALF) = pack8(acc[ai][bj][m][0] * r * g0, acc[ai][bj][m][1] * r * g1); } }
            return;
        }
        if (mode == 2) {
#pragma unroll
            EPI_LOOP_ROWS { bf16_t* rowp = Z + (size_t)(row0 + ai * HALF + m * 16) * ZLD + col0;
                f32x4 rt[2], sb[2];
#pragma unroll
                for (int n = 0; n < 2; ++n) { const f32x4 ga = acc[ai][0][m][n] * (-1.4426950408889634f), gb = acc[ai][1][m][n] * (-1.4426950408889634f);
#pragma unroll
                    for (int i = 0; i < 4; ++i) { const float da = 1.0f + __builtin_amdgcn_exp2f(ga[i]), db = 1.0f + __builtin_amdgcn_exp2f(gb[i]);
                        sb[n][i] = __builtin_amdgcn_rcpf(db); rt[n][i] = db * __builtin_amdgcn_rcpf(da); } }
                *(u32x4*)rowp = pack8(rt[0], rt[1]); *(u32x4*)(rowp + HALF) = pack8(sb[0], sb[1]); }
            return;
        }
#pragma unroll
        EPI_LOOP_ROWS { bf16_t* rowp = Z + (size_t)(row0 + ai * HALF + m * 16) * ZLD + col0;
            float s1 = 0.f, s2 = 0.f;
#pragma unroll
            for (int bj = 0; bj < 2; ++bj) { f32x4 v0 = acc[ai][bj][m][0], v1 = acc[ai][bj][m][1];
                if (mode == 1) { v0 = gelu4(v0); v1 = gelu4(v1); } else if (mode == 2) { v0 = sigm4(v0); v1 = sigm4(v1); }
                if (isv) { s1 += (v0[0] + v0[1]) + (v0[2] + v0[3]) + (v1[0] + v1[1]) + (v1[2] + v1[3]);
                           s2 += (v0[0] * v0[0] + v0[1] * v0[1]) + (v0[2] * v0[2] + v0[3] * v0[3]) + (v1[0] * v1[0] + v1[1] * v1[1]) + (v1[2] * v1[2] + v1[3] * v1[3]); }
                *(u32x4*)(rowp + bj * HALF) = pack8(v0, v1); }
            if (isv) { s1 = xsum_fq(s1); s2 = xsum_fq(s2);
                       if (fq == 0) { atomicAdd(vs1 + row0 + ai * HALF + m * 16, s1); atomicAdd(vs2 + row0 + ai * HALF + m * 16, s2); } } }
    }
};
struct EpiY {
    static constexpr bool PERM = true, AFTER_DRAIN = false, MIDK = true;
    const bf16_t* Z; bf16_t* Y;
    __device__ __forceinline__ void mid(Acc& acc, const Unit& u, int wr, int wc, int fr, int fq) const {
        int opq; asm volatile("v_mov_b32 %0, 0" : "=v"(opq));
        const int row0 = u.pm * BM + wr * 64 + fr + opq, gc0 = 5120 + u.pn * 512 + wc * 32 + 8 * fq;
#pragma unroll
        EPI_LOOP_ROWS { const bf16_t* rowp = Z + (size_t)(row0 + ai * HALF + m * 16) * ZLD + gc0;
#pragma unroll
            for (int bj = 0; bj < 2; ++bj) { const u32x4 a = *(const u32x4*)(rowp + bj * 256);
                acc[ai][bj][m][0] *= (f32x4){bf_lo(a.x), bf_hi(a.x), bf_lo(a.y), bf_hi(a.y)}; acc[ai][bj][m][1] *= (f32x4){bf_lo(a.z), bf_hi(a.z), bf_lo(a.w), bf_hi(a.w)}; }
            if (m & 1) asm volatile("" ::: "memory"); }
    }
    __device__ __forceinline__ void operator()(const Acc& acc, const Unit& u, int wr, int wc, int fr, int fq) const {
        int opq; asm volatile("v_mov_b32 %0, 0" : "=v"(opq));
        const int row0 = u.pm * BM + wr * 64 + fr + opq, col0 = u.pn * BM + wc * 32 + 8 * fq, gc0 = 5120 + u.pn * 512 + wc * 32 + 8 * fq + 128;
#pragma unroll
        EPI_LOOP_ROWS { const int row = row0 + ai * HALF + m * 16; const bf16_t* rowp = Z + (size_t)row * ZLD + gc0;
#pragma unroll
            for (int bj = 0; bj < 2; ++bj) { const u32x4 b = *(const u32x4*)(rowp + bj * 256);
                const f32x4 s0 = (f32x4){bf_lo(b.x), bf_hi(b.x), bf_lo(b.y), bf_hi(b.y)}, s1 = (f32x4){bf_lo(b.z), bf_hi(b.z), bf_lo(b.w), bf_hi(b.w)};
                *(u32x4*)(Y + (size_t)row * 2048 + col0 + bj * HALF) = pack8(acc[ai][bj][m][0] * s0, acc[ai][bj][m][1] * s1); }
            if (m & 1) asm volatile("" ::: "memory"); }
    }
};
template <bool BASE_F32> struct EpiRes {
    static constexpr bool PERM = true, AFTER_DRAIN = false, MIDK = false;
    const void* base; bf16_t* xn; float* ssq;
    __device__ __forceinline__ void mid(Acc&, const Unit&, int, int, int, int) const {}
    __device__ __forceinline__ void operator()(const Acc& acc, const Unit& u, int wr, int wc, int fr, int fq) const {
        const int row0 = u.pm * BM + wr * 64 + fr, col0 = u.pn * BM + wc * 32 + 8 * fq;
#pragma unroll
        EPI_LOOP_ROWS { const int row = row0 + ai * HALF + m * 16; const size_t off = (size_t)row * 2048 + col0; float s = 0.f;
#pragma unroll
            for (int bj = 0; bj < 2; ++bj) { f32x4 b0, b1;
                if (BASE_F32) { b0 = *(const f32x4*)((const float*)base + off + bj * HALF); b1 = *(const f32x4*)((const float*)base + off + bj * HALF + 4); }
                else { const u32x4 w = *(const u32x4*)((const bf16_t*)base + off + bj * HALF); b0 = (f32x4){bf_lo(w.x), bf_hi(w.x), bf_lo(w.y), bf_hi(w.y)}; b1 = (f32x4){bf_lo(w.z), bf_hi(w.z), bf_lo(w.w), bf_hi(w.w)}; }
                const f32x4 x0 = b0 + acc[ai][bj][m][0], x1 = b1 + acc[ai][bj][m][1];
                s += (x0[0] * x0[0] + x0[1] * x0[1]) + (x0[2] * x0[2] + x0[3] * x0[3]) + (x1[0] * x1[0] + x1[1] * x1[1]) + (x1[2] * x1[2] + x1[3] * x1[3]);
                *(u32x4*)(xn + off + bj * HALF) = pack8(x0, x1); }
            s = xsum_fq(s);
            if (fq == 0) atomicAdd(ssq + row, s); }
    }
};
struct EpiUpConv {
    static constexpr bool PERM = true, AFTER_DRAIN = false, MIDK = false;
    bf16_t* HM; const float* ssq; const float* cw; const float* cb; float* HALO; float* FA; float* FB; PG8_LAS float* hl;
    __device__ __forceinline__ void mid(Acc&, const Unit&, int, int, int, int) const {}
    __device__ __forceinline__ static float gelu_t(float cv) { const float inner = cv + 0.044715f * cv * cv * cv; return cv * __builtin_amdgcn_rcpf(1.0f + __builtin_amdgcn_exp2f(-2.3022081986f * inner)); }
    __device__ __forceinline__ void operator()(const Acc& acc, const Unit& u, int wr, int wc, int fr, int fq) const {
        int opq; asm volatile("v_mov_b32 %0, 0" : "=v"(opq));
        const int lane = (int)(threadIdx.x & 63);
        const int cl = wc * 32 + 8 * fq, c0 = u.pn * 128 + cl + opq;
        const int rowg = u.pm * BM + wr * 64 + fr;
        float rr[2][4];
#pragma unroll
        for (int ai = 0; ai < 2; ++ai)
#pragma unroll
            for (int m = 0; m < 4; ++m) rr[ai][m] = 1.0f / sqrtf(ssq[rowg + ai * HALF + m * 16] * (1.0f / 2048.0f) + 1e-6f);
#pragma unroll
        for (int ai = 0; ai < 2; ++ai) if (fr >= 14) { const float r = rr[ai][3]; const f32x4 x0 = acc[ai][0][3][0] * r, x1 = acc[ai][0][3][1] * r;
            PG8_LAS float* d = hl + ((2 * ai + wr) * 2 + (fr - 14)) * 128 + cl; *(PG8_LAS f32x4*)d = x0; *(PG8_LAS f32x4*)(d + 4) = x1;
            if (ai == 1 && wr == 1) { float* gp = HALO + (size_t)(u.pm * 2 + (fr - 14)) * 5632 + c0; *(f32x4*)gp = x0; *(f32x4*)(gp + 4) = x1; } }
        if (wr == 0 && fr < 2) { const float r = rr[0][0]; float* ga = FA + (size_t)(u.pm * 2 + fr) * 5632 + c0; float* gb = FB + (size_t)(u.pm * 2 + fr) * 5632 + c0;
            *(f32x4*)ga = acc[0][0][0][0] * r; *(f32x4*)(ga + 4) = acc[0][0][0][1] * r; *(f32x4*)gb = acc[0][1][0][0] * r; *(f32x4*)(gb + 4) = acc[0][1][0][1] * r; }
        f32x2 w0[4], w1[4], w2[4], cbv[4];
        { const f32x4 a = *(const f32x4*)(cw + c0), b = *(const f32x4*)(cw + c0 + 4); w0[0] = (f32x2){a[0], a[1]}; w0[1] = (f32x2){a[2], a[3]}; w0[2] = (f32x2){b[0], b[1]}; w0[3] = (f32x2){b[2], b[3]}; }
        { const f32x4 a = *(const f32x4*)(cw + 5632 + c0), b = *(const f32x4*)(cw + 5632 + c0 + 4); w1[0] = (f32x2){a[0], a[1]}; w1[1] = (f32x2){a[2], a[3]}; w1[2] = (f32x2){b[0], b[1]}; w1[3] = (f32x2){b[2], b[3]}; }
        { const f32x4 a = *(const f32x4*)(cw + 11264 + c0), b = *(const f32x4*)(cw + 11264 + c0 + 4); w2[0] = (f32x2){a[0], a[1]}; w2[1] = (f32x2){a[2], a[3]}; w2[2] = (f32x2){b[0], b[1]}; w2[3] = (f32x2){b[2], b[3]}; }
        { const f32x4 a = *(const f32x4*)(cb + c0), b = *(const f32x4*)(cb + c0 + 4); cbv[0] = (f32x2){a[0], a[1]}; cbv[1] = (f32x2){a[2], a[3]}; cbv[2] = (f32x2){b[0], b[1]}; cbv[3] = (f32x2){b[2], b[3]}; }
        asm volatile("s_waitcnt lgkmcnt(0)" ::: "memory"); __builtin_amdgcn_s_barrier(); asm volatile("" ::: "memory");
        const bool f15 = fr == 15, f14 = fr >= 14;
#pragma unroll
        for (int ai = 0; ai < 2; ++ai) {
            f32x2 xp[4];
            { const int g = 2 * ai + wr;
              if (g > 0 && fr >= 14) { const PG8_LAS float* d = hl + ((g - 1) * 2 + (fr - 14)) * 128 + cl; const f32x4 h0 = *(const PG8_LAS f32x4*)d, h1 = *(const PG8_LAS f32x4*)(d + 4);
                  xp[0] = (f32x2){h0[0], h0[1]}; xp[1] = (f32x2){h0[2], h0[3]}; xp[2] = (f32x2){h1[0], h1[1]}; xp[3] = (f32x2){h1[2], h1[3]}; }
              else {
#pragma unroll
                  for (int j = 0; j < 4; ++j) xp[j] = (f32x2){0.f, 0.f}; } }
#pragma unroll
            for (int m = 0; m < 4; ++m) { const float r = rr[ai][m]; const int row = rowg + ai * HALF + m * 16;
                f32x2 o[4];
#pragma unroll
                for (int j = 0; j < 4; ++j) {
                    const f32x4 av = acc[ai][0][m][j >> 1], bv = acc[ai][1][m][j >> 1];
                    const f32x2 x = (f32x2){av[(j & 1) * 2], av[(j & 1) * 2 + 1]} * r, bb = (f32x2){bv[(j & 1) * 2], bv[(j & 1) * 2 + 1]} * r;
                    const f32x2 s1 = f15 ? xp[j] : x, s2 = f14 ? xp[j] : x;
                    f32x2 p1, p2;
                    p1.x = __int_as_float(__builtin_amdgcn_update_dpp(0, __float_as_int(s1.x), 0x121, 0xf, 0xf, false)); p1.y = __int_as_float(__builtin_amdgcn_update_dpp(0, __float_as_int(s1.y), 0x121, 0xf, 0xf, false));
                    p2.x = __int_as_float(__builtin_amdgcn_update_dpp(0, __float_as_int(s2.x), 0x122, 0xf, 0xf, false)); p2.y = __int_as_float(__builtin_amdgcn_update_dpp(0, __float_as_int(s2.y), 0x122, 0xf, 0xf, false));
                    const f32x2 cv = ((cbv[j] + w0[j] * p2) + w1[j] * p1) + w2[j] * x;
                    const f32x2 arg = (cv * (cv * cv * 0.044715f + 1.0f)) * (-2.3022081986f);
                    f32x2 e; e.x = __builtin_amdgcn_exp2f(arg.x); e.y = __builtin_amdgcn_exp2f(arg.y);
                    const f32x2 d = e + 1.0f; f32x2 rc; rc.x = __builtin_amdgcn_rcpf(d.x); rc.y = __builtin_amdgcn_rcpf(d.y);
                    o[j] = (cv * rc) * bb; xp[j] = x; }
                *(u32x4*)(HM + (size_t)row * 5632 + c0) = pack8((f32x4){o[0].x, o[0].y, o[1].x, o[1].y}, (f32x4){o[2].x, o[2].y, o[3].x, o[3].y}); }
        }
    }
};
struct EpiE {
    static constexpr bool PERM = true, AFTER_DRAIN = false, MIDK = false;
    bf16_t* O; float* ssq;
    __device__ __forceinline__ void mid(Acc&, const Unit&, int, int, int, int) const {}
    __device__ __forceinline__ void operator()(const Acc& acc, const Unit& u, int wr, int wc, int fr, int fq) const {
        const int row0 = u.pm * BM + wr * 64 + fr, col0 = u.pn * BM + wc * 32 + 8 * fq;
#pragma unroll
        EPI_LOOP_ROWS { const int row = row0 + ai * HALF + m * 16; float s = 0.f; bf16_t* rowp = O + (size_t)row * 2048 + col0;
#pragma unroll
            for (int bj = 0; bj < 2; ++bj) { const f32x4 x0 = acc[ai][bj][m][0], x1 = acc[ai][bj][m][1];
                s += (x0[0] * x0[0] + x0[1] * x0[1]) + (x0[2] * x0[2] + x0[3] * x0[3]) + (x1[0] * x1[0] + x1[1] * x1[1]) + (x1[2] * x1[2] + x1[3] * x1[3]);
                *(u32x4*)(rowp + bj * HALF) = pack8(x0, x1); }
            s = xsum_fq(s);
            if (fq == 0) atomicAdd(ssq + row, s); }
    }
};
struct EpiFinal {
    static constexpr bool PERM = true, AFTER_DRAIN = false, MIDK = false;
    float* out; const bf16_t* xb; const bf16_t* E; const float* gp; const float* ssq2; const float* ssqE;
    __device__ __forceinline__ void mid(Acc&, const Unit&, int, int, int, int) const {}
    __device__ __forceinline__ void operator()(const Acc& acc, const Unit& u, int wr, int wc, int fr, int fq) const {
        const int row0 = u.pm * BM + wr * 64 + fr, col0 = u.pn * BM + wc * 32 + 8 * fq;
        f32x4 gv[2][2];
#pragma unroll
        for (int bj = 0; bj < 2; ++bj) { gv[bj][0] = *(const f32x4*)(gp + col0 + bj * HALF); gv[bj][1] = *(const f32x4*)(gp + col0 + bj * HALF + 4); }
#pragma unroll
        EPI_LOOP_ROWS { const int row = row0 + ai * HALF + m * 16; const size_t off = (size_t)row * 2048 + col0;
            const float r2 = 1.0f / sqrtf(ssq2[row] * (1.0f / 2048.0f) + 1e-6f), rE = 1.0f / sqrtf(ssqE[row] * (1.0f / 2048.0f) + 1e-6f);
#pragma unroll
            for (int bj = 0; bj < 2; ++bj) { const u32x4 xw = *(const u32x4*)(xb + off + bj * HALF);
                const f32x4 b0 = (f32x4){bf_lo(xw.x), bf_hi(xw.x), bf_lo(xw.y), bf_hi(xw.y)}, b1 = (f32x4){bf_lo(xw.z), bf_hi(xw.z), bf_lo(xw.w), bf_hi(xw.w)};
                const u32x4 e = *(const u32x4*)(E + off + bj * HALF);
                const f32x4 e0 = (f32x4){bf_lo(e.x), bf_hi(e.x), bf_lo(e.y), bf_hi(e.y)}, e1 = (f32x4){bf_lo(e.z), bf_hi(e.z), bf_lo(e.w), bf_hi(e.w)};
                const f32x4 g0 = sigm4(acc[ai][bj][m][0] * r2), g1 = sigm4(acc[ai][bj][m][1] * r2);
                *(f32x4*)(out + off + bj * HALF) = b0 + g0 * (e0 * rE * gv[bj][0]); *(f32x4*)(out + off + bj * HALF + 4) = b1 + g1 * (e1 * rE * gv[bj][1]); } }
    }
};

template <class Epi, class Sched, bool ALIGN_EPI = false, bool SP2 = false>
__device__ __forceinline__ void gemm_phase(PG8_LAS unsigned char* lds, const Gemm g, const Sched& S, const Epi& E) {
    const int tid = threadIdx.x, wid = __builtin_amdgcn_readfirstlane(tid >> 6), lane = tid & 63, wr = wid >> 2, wc = wid & 3, fr = lane & 15, fq = lane >> 4;
    const int K = g.K, nt = K / BK;
    unsigned voffA[2], voffB[2];
#pragma unroll
    for (int i = 0; i < 2; ++i) { int R, C; stage_rc(tid * 16 + i * 8192, R, C); const int Rb = Epi::PERM ? ((R & ~31) + perm32(R & 31)) : R;
        voffA[i] = (unsigned)(R * K + C) * 2u; voffB[i] = (unsigned)(Rb * K + C) * 2u; }
    const size_t kstep = (size_t)(BK * 2);
    const size_t hstep = (size_t)HALF * K * 2;
    const size_t tstep = 2 * hstep;
    const unsigned ldsw = (unsigned)wid * 1024u;
    const int aoff = lds_byte(wr * 64 + fr, fq * 8), boff = lds_byte(wc * 32 + fr, fq * 8);
#define PG8_SA(b, h) (((b) * 2 + (h)) * HTB)
#define PG8_SB(b, h) ((4 + (b) * 2 + (h)) * HTB)
#define PG8_STAGE(bufoff, gbase, voff) do { _Pragma("unroll") for (int _i = 0; _i < 2; ++_i) \
        __builtin_amdgcn_global_load_lds((const unsigned*)((const char*)(gbase) + (voff)[_i]), (PG8_LAS unsigned*)(lds + (bufoff) + ldsw + _i * 8192), 16, 0, 0); } while (0)
#define PG8_LDA(dst, b, h) do { _Pragma("unroll") for (int m = 0; m < 4; ++m) _Pragma("unroll") for (int k = 0; k < 2; ++k) dst[m][k] = *(const PG8_LAS bf16x8*)(lds + PG8_SA(b, h) + aoff + m * 2048 + k * 1024); } while (0)
#define PG8_LDB(dst, b, h) do { _Pragma("unroll") for (int n = 0; n < 2; ++n) _Pragma("unroll") for (int k = 0; k < 2; ++k) dst[n][k] = *(const PG8_LAS bf16x8*)(lds + PG8_SB(b, h) + boff + n * 2048 + k * 1024); } while (0)
#define PG8_MMA(ai, bj, At, Bt) do { __builtin_amdgcn_s_setprio(1); _Pragma("unroll") for (int m = 0; m < 4; ++m) _Pragma("unroll") for (int n = 0; n < 2; ++n) _Pragma("unroll") for (int k = 0; k < 2; ++k) \
        acc[ai][bj][m][n] = __builtin_amdgcn_mfma_f32_16x16x32_bf16(Bt[n][k], At[m][k], acc[ai][bj][m][n], 0, 0, 0); __builtin_amdgcn_s_setprio(0); } while (0)
#define PG8_WAIT_V(n) asm volatile("s_waitcnt vmcnt(" #n ")" ::: "memory")
#define PG8_WAIT_L(n) asm volatile("s_waitcnt lgkmcnt(" #n ")" ::: "memory")
#define PG8_BAR __builtin_amdgcn_s_barrier()
#define PG8_SCHED __builtin_amdgcn_sched_barrier(0)
    Unit cur, nxt; int ui = 0;
    if (!S.next(0, cur)) return;
    f32x4 acc[2][2][4][2];
#pragma unroll
    for (int a = 0; a < 2; ++a)
#pragma unroll
        for (int b = 0; b < 2; ++b)
#pragma unroll
            for (int m = 0; m < 4; ++m)
#pragma unroll
                for (int n = 0; n < 2; ++n) acc[a][b][m][n] = (f32x4){0.f, 0.f, 0.f, 0.f};
    bf16x8 At[4][2], B0[2][2], B1[2][2];
    const char* cA = (const char*)g.A + (size_t)cur.pm * tstep; const char* cB = (const char*)g.Bt + (size_t)cur.pn * tstep;
    S.a_ready(cur);
    if constexpr (SP2) {
        PG8_STAGE(PG8_SB(0, 0), cB, voffB); PG8_STAGE(PG8_SB(0, 1), cB + hstep, voffB); PG8_STAGE(PG8_SA(0, 0), cA, voffA); PG8_STAGE(PG8_SA(0, 1), cA + hstep, voffA);
        if (wr == 1) PG8_BAR;
        PG8_WAIT_V(2); PG8_BAR;
        PG8_STAGE(PG8_SB(1, 0), cB + kstep, voffB); PG8_STAGE(PG8_SA(1, 0), cA + kstep, voffA); PG8_STAGE(PG8_SB(1, 1), cB + hstep + kstep, voffB);
        PG8_WAIT_V(6); PG8_BAR;
    } else {
        PG8_STAGE(PG8_SB(0, 0), cB, voffB); PG8_STAGE(PG8_SA(0, 0), cA, voffA); PG8_STAGE(PG8_SB(0, 1), cB + hstep, voffB); PG8_STAGE(PG8_SA(0, 1), cA + hstep, voffA);
        if (wr == 1) PG8_BAR;
        PG8_WAIT_V(4); PG8_BAR;
        PG8_STAGE(PG8_SB(1, 0), cB + kstep, voffB); PG8_STAGE(PG8_SA(1, 0), cA + kstep, voffA); PG8_STAGE(PG8_SB(1, 1), cB + hstep + kstep, voffB);
        PG8_WAIT_V(6); PG8_BAR;
    }
    for (;;) {
        const bool has_next = S.next(ui + 1, nxt);
        const char* nA = has_next ? (const char*)g.A + (size_t)nxt.pm * tstep : cA; const char* nB = has_next ? (const char*)g.Bt + (size_t)nxt.pn * tstep : cB;
        constexpr int NSEG = Epi::MIDK ? 2 : 1;
#pragma unroll 1
        for (int seg = 0; seg < NSEG; ++seg) {
        if constexpr (Epi::MIDK) { if (seg == 1) E.mid(acc, cur, wr, wc, fr, fq); }
        const int t_hi = (NSEG == 2 && seg == 0) ? (nt >> 1) : nt;
#pragma unroll 1
        for (int t = (NSEG == 2 && seg == 1) ? (nt >> 1) : 0; t < t_hi; t += 2) {
            const bool last = (t == nt - 2);
            const char* a1 = cA + (size_t)(t + 1) * kstep;
            const char* a2 = last ? nA : cA + (size_t)(t + 2) * kstep; const char* b2 = last ? nB : cB + (size_t)(t + 2) * kstep;
            const char* a3 = a2 + kstep; const char* b3 = b2 + kstep;
            if (last && has_next) S.a_ready(nxt);
            if constexpr (SP2) {
            PG8_LDB(B0, 0, 0); PG8_LDB(B1, 0, 1); PG8_SCHED; PG8_LDA(At, 0, 0); PG8_STAGE(PG8_SA(1, 1), a1 + hstep, voffA);
            PG8_WAIT_V(8); PG8_WAIT_L(0); PG8_BAR; PG8_MMA(0, 0, At, B0); PG8_MMA(0, 1, At, B1); PG8_BAR; PG8_SCHED;
            PG8_LDA(At, 0, 1); PG8_STAGE(PG8_SB(0, 0), b2, voffB); PG8_STAGE(PG8_SB(0, 1), b2 + hstep, voffB); PG8_STAGE(PG8_SA(0, 0), a2, voffA);
            PG8_WAIT_V(8); PG8_WAIT_L(0); PG8_BAR; PG8_MMA(1, 0, At, B0); PG8_MMA(1, 1, At, B1); PG8_BAR; PG8_SCHED;
            PG8_LDB(B0, 1, 0); PG8_LDB(B1, 1, 1); PG8_SCHED; PG8_LDA(At, 1, 0); PG8_STAGE(PG8_SA(0, 1), a2 + hstep, voffA);
            PG8_WAIT_V(8); PG8_WAIT_L(0); PG8_BAR; PG8_MMA(0, 0, At, B0); PG8_MMA(0, 1, At, B1); PG8_BAR; PG8_SCHED;
            PG8_LDA(At, 1, 1); PG8_STAGE(PG8_SB(1, 0), b3, voffB); PG8_STAGE(PG8_SB(1, 1), b3 + hstep, voffB); PG8_STAGE(PG8_SA(1, 0), a3, voffA);
            PG8_WAIT_V(8); PG8_WAIT_L(0); PG8_BAR; PG8_MMA(1, 0, At, B0); PG8_MMA(1, 1, At, B1); PG8_BAR; PG8_SCHED;
            } else {
            PG8_LDB(B0, 0, 0); PG8_SCHED; PG8_LDA(At, 0, 0); PG8_STAGE(PG8_SA(1, 1), a1 + hstep, voffA);
            PG8_WAIT_L(8); PG8_BAR; PG8_WAIT_L(0); PG8_MMA(0, 0, At, B0); PG8_BAR; PG8_SCHED;
            PG8_LDB(B1, 0, 1); PG8_STAGE(PG8_SB(0, 0), b2, voffB);
            PG8_BAR; PG8_WAIT_L(0); PG8_MMA(0, 1, At, B1); PG8_BAR;
            PG8_LDA(At, 0, 1); PG8_STAGE(PG8_SA(0, 0), a2, voffA);
            PG8_BAR; PG8_WAIT_L(0); PG8_MMA(1, 0, At, B0); PG8_BAR; PG8_SCHED;
            PG8_STAGE(PG8_SB(0, 1), b2 + hstep, voffB);
            PG8_WAIT_V(6); PG8_BAR; PG8_MMA(1, 1, At, B1); PG8_BAR;
            PG8_LDB(B0, 1, 0); PG8_SCHED; PG8_LDA(At, 1, 0); PG8_STAGE(PG8_SA(0, 1), a2 + hstep, voffA);
            PG8_WAIT_L(8); PG8_BAR; PG8_WAIT_L(0); PG8_MMA(0, 0, At, B0); PG8_BAR; PG8_SCHED;
            PG8_LDB(B1, 1, 1); PG8_STAGE(PG8_SB(1, 0), b3, voffB);
            PG8_BAR; PG8_WAIT_L(0); PG8_MMA(0, 1, At, B1); PG8_BAR;
            PG8_LDA(At, 1, 1); PG8_STAGE(PG8_SA(1, 0), a3, voffA);
            PG8_BAR; PG8_WAIT_L(0); PG8_MMA(1, 0, At, B0); PG8_BAR; PG8_SCHED;
            PG8_STAGE(PG8_SB(1, 1), b3 + hstep, voffB);
            PG8_WAIT_V(6); PG8_BAR; PG8_MMA(1, 1, At, B1); PG8_BAR;
            }
        }
        }
        if constexpr (ALIGN_EPI) { if (wr == 0) PG8_BAR; }
        if constexpr (!Epi::AFTER_DRAIN) { E(acc, cur, wr, wc, fr, fq); S.done(cur); }
        if (!has_next) break;
#pragma unroll
        for (int a = 0; a < 2; ++a)
#pragma unroll
            for (int b = 0; b < 2; ++b)
#pragma unroll
                for (int m = 0; m < 4; ++m)
#pragma unroll
                    for (int n = 0; n < 2; ++n) acc[a][b][m][n] = (f32x4){0.f, 0.f, 0.f, 0.f};
        cur = nxt; cA = nA; cB = nB; ++ui;
        if constexpr (ALIGN_EPI) { if (wr == 1) PG8_BAR; }
    }
    PG8_WAIT_V(0);
    if constexpr (!ALIGN_EPI) { if (wr == 0) PG8_BAR; }
    PG8_BAR;
#undef PG8_SA
#undef PG8_SB
#undef PG8_STAGE
#undef PG8_LDA
#undef PG8_LDB
#undef PG8_MMA
#undef PG8_WAIT_V
#undef PG8_WAIT_L
#undef PG8_BAR
#undef PG8_SCHED
}
}

namespace fox {
typedef unsigned short bf16_t;
typedef short bf16x8 __attribute__((ext_vector_type(8)));
typedef short s16x4 __attribute__((ext_vector_type(4)));
typedef float f32x16 __attribute__((ext_vector_type(16)));
typedef float f32x4 __attribute__((ext_vector_type(4)));
typedef unsigned u32x4 __attribute__((ext_vector_type(4)));
constexpr int D = 128, NW = 8, QBLK = 32, KVBLK = 64, QB = NW * QBLK;
constexpr int SHM_V = KVBLK * D * 2, SHM_K = KVBLK * D * 2;
constexpr int LDS_WS = 2 * SHM_V + 2 * SHM_K;
constexpr int LDS_CUM = LDS_WS + NW * 64 * 4;
constexpr int LDS_BYTES = LDS_CUM + 2048 * 4;
constexpr int QS = 9216, OS = 2048;
constexpr float SCALE = 0.08838834764831845f;
constexpr float THR = 8.f;
constexpr unsigned WBIG = 0x40000000u;

#define KSWZ(row, colB) ((row) * 256 + ((colB) ^ (((row) & 7) << 4)))
#define SBAR() __builtin_amdgcn_sched_barrier(0)
__device__ __forceinline__ int v_st(int k, int c) { const int kk = (k & ~0xC) | ((k & 4) << 1) | ((k & 8) >> 1); return ((kk >> 3) * 4 + (c >> 5)) * 512 + ((kk & 7) * 32 + (c & 31)) * 2; }
__device__ __forceinline__ int v_rd_base(int lane) { return ((lane & 3) << 3) | (((lane >> 2) & 3) << 6) | (((lane >> 4) & 1) << 5) | (((lane >> 5) & 1) << 8); }
constexpr int v_rd_off(int d0, int ks, int half) { return d0 * 512 + ks * 4096 + half * 2048; }
__device__ __forceinline__ int crow(int r, int hi) { return (r & 3) + 8 * (r >> 2) + 4 * hi; }
__device__ __forceinline__ unsigned cvtpk(float lo, float hi) { unsigned r; asm volatile("v_cvt_pk_bf16_f32 %0, %1, %2" : "=v"(r) : "v"(lo), "v"(hi)); return r; }
__device__ __forceinline__ bf16x8 load8(const bf16_t* p) { return *reinterpret_cast<const bf16x8*>(p); }
__device__ __forceinline__ void mask_tile(f32x16& p0, f32x16& p1, int dq) {
    const float NEG = -__builtin_inff();
#pragma unroll
    for (int r = 0; r < 16; ++r) {
        const int c = (r & 3) + 8 * (r >> 2);
        if ((unsigned)(dq - c) >= WBIG) p0[r] = NEG;
        if ((unsigned)(dq - c - 32) >= WBIG) p1[r] = NEG;
    }
}
__device__ __forceinline__ void partialSM(f32x16& p0, f32x16& p1, float& m_reg, float& mn, float& alpha) {
    float pmax = p0[0]; for (int r = 1; r < 16; ++r) pmax = fmaxf(pmax, p0[r]); for (int r = 0; r < 16; ++r) pmax = fmaxf(pmax, p1[r]);
    { auto rr = __builtin_amdgcn_permlane32_swap(__float_as_uint(pmax), __float_as_uint(pmax), false, false);
      pmax = fmaxf(__uint_as_float(rr[0]), __uint_as_float(rr[1])); }
    constexpr float C2 = 1.4426950408889634f * SCALE;
    if (__builtin_expect(__all((pmax - m_reg) * SCALE <= THR), 1)) { mn = m_reg; alpha = 1.f; }
    else { mn = fmaxf(m_reg, pmax); alpha = __builtin_amdgcn_exp2f((m_reg - mn) * C2); m_reg = mn; }
    const float mnL = -mn * C2;
    for (int r = 0; r < 16; ++r) p0[r] = fmaf(p0[r], C2, mnL); for (int r = 0; r < 16; ++r) p1[r] = fmaf(p1[r], C2, mnL);
    for (int r = 0; r < 16; ++r) p0[r] = __builtin_amdgcn_exp2f(p0[r]);
}
__device__ __forceinline__ void finishSM(f32x16& p0, f32x16& p1, float alpha, float& l_reg, bf16x8& pa0, bf16x8& pa1, bf16x8& pa2, bf16x8& pa3) {
    for (int r = 0; r < 16; ++r) p1[r] = __builtin_amdgcn_exp2f(p1[r]);
    float ps = 0; for (int r = 0; r < 16; ++r) ps += p0[r]; for (int r = 0; r < 16; ++r) ps += p1[r];
    { auto rr = __builtin_amdgcn_permlane32_swap(__float_as_uint(ps), __float_as_uint(ps), false, false);
      ps = __uint_as_float(rr[0]) + __uint_as_float(rr[1]); }
    l_reg = l_reg * alpha + ps;
#define PK4(P, B_, OUT) do { unsigned a0 = cvtpk(P[B_+0], P[B_+1]), a1 = cvtpk(P[B_+2], P[B_+3]);                          \
        unsigned b0 = cvtpk(P[B_+4], P[B_+5]), b1 = cvtpk(P[B_+6], P[B_+7]);                                             \
        auto r0 = __builtin_amdgcn_permlane32_swap(a0, b0, false, false); auto r1 = __builtin_amdgcn_permlane32_swap(a1, b1, false, false); \
        u32x4 w = {r0[0], r1[0], r0[1], r1[1]}; OUT = *reinterpret_cast<bf16x8*>(&w); } while (0)
    PK4(p0, 0, pa0); PK4(p0, 8, pa1); PK4(p1, 0, pa2); PK4(p1, 8, pa3);
#undef PK4
}
template <int KB>
__device__ __forceinline__ void qkt(f32x16& p0, f32x16& p1, const char* K_lds, int r32, int hi, const bf16x8* qr, const float* cl) {
#pragma unroll
    for (int g = 0; g < 4; ++g) { const f32x4 c0 = *(const f32x4*)(cl + 8 * g), c1 = *(const f32x4*)(cl + 32 + 8 * g);
#pragma unroll
        for (int i = 0; i < 4; ++i) { p0[4 * g + i] = c0[i]; p1[4 * g + i] = c1[i]; } }
    const char* kb[4];
#pragma unroll
    for (int dd = 0; dd < 4; ++dd) kb[dd] = K_lds + KB * SHM_K + KSWZ(r32, (dd * 16 + hi * 8) * 2);
#pragma unroll
    for (int d0 = 0; d0 < 8; ++d0) { const char* a = kb[d0 & 3] + (d0 >> 2) * 128;
        bf16x8 b0 = *reinterpret_cast<const bf16x8*>(a);
        bf16x8 b1 = *reinterpret_cast<const bf16x8*>(a + 32 * 256);
        p0 = __builtin_amdgcn_mfma_f32_32x32x16_bf16(b0, qr[d0], p0, 0, 0, 0);
        p1 = __builtin_amdgcn_mfma_f32_32x32x16_bf16(b1, qr[d0], p1, 0, 0, 0); }
}
#define TRRD(dst, base, off) asm volatile("ds_read_b64_tr_b16 %0, %1 offset:%2" : "=&v"(dst) : "v"(base), "i"(off) : "memory")
template <int VB>
__device__ __forceinline__ void pv_tile(f32x16* o, int vb0, bf16x8 pa0, bf16x8 pa1, bf16x8 pa2, bf16x8 pa3) {
#define PV_D0(d0) do { s16x4 l0, l1, l2, l3, h0, h1, h2, h3; constexpr int b_ = VB * SHM_V + v_rd_off(d0, 0, 0); \
        TRRD(l0, vb0, b_); TRRD(h0, vb0, b_ + 2048); TRRD(l1, vb0, b_ + 4096); TRRD(h1, vb0, b_ + 6144); TRRD(l2, vb0, b_ + 8192); TRRD(h2, vb0, b_ + 10240); TRRD(l3, vb0, b_ + 12288); TRRD(h3, vb0, b_ + 14336); \
        asm volatile("s_waitcnt lgkmcnt(0)" ::: "memory"); SBAR();   \
        o[d0] = __builtin_amdgcn_mfma_f32_32x32x16_bf16(pa0, (bf16x8){l0[0], l0[1], l0[2], l0[3], h0[0], h0[1], h0[2], h0[3]}, o[d0], 0, 0, 0);   \
        o[d0] = __builtin_amdgcn_mfma_f32_32x32x16_bf16(pa1, (bf16x8){l1[0], l1[1], l1[2], l1[3], h1[0], h1[1], h1[2], h1[3]}, o[d0], 0, 0, 0);   \
        o[d0] = __builtin_amdgcn_mfma_f32_32x32x16_bf16(pa2, (bf16x8){l2[0], l2[1], l2[2], l2[3], h2[0], h2[1], h2[2], h2[3]}, o[d0], 0, 0, 0);   \
        o[d0] = __builtin_amdgcn_mfma_f32_32x32x16_bf16(pa3, (bf16x8){l3[0], l3[1], l3[2], l3[3], h3[0], h3[1], h3[2], h3[3]}, o[d0], 0, 0, 0); } while (0)
    PV_D0(0); PV_D0(1); PV_D0(2); PV_D0(3);
#undef PV_D0
}

struct BlockRef { const bf16_t* Q; const bf16_t* K; const bf16_t* V; bf16_t* O; int P0; };
struct Seam { bf16x8 qr[8]; bf16x8 st_v0, st_v1, st_k0, st_k1; };
#define ROW(p, k0, rr) ((p) + (size_t)((k0) + (rr)) * QS + sc)
#define VMW() asm volatile("s_waitcnt vmcnt(0)" ::: "memory")
#define VMWN(n) asm volatile("s_waitcnt vmcnt(%0)" :: "i"(n) : "memory")
#define SLOAD_H(Kp, Vp, k0) do { S.st_v0 = load8(ROW(Vp, k0, sr)); S.st_v1 = load8(ROW(Vp, k0, 32 + sr));              \
                         S.st_k0 = load8(ROW(Kp, k0, sr)); S.st_k1 = load8(ROW(Kp, k0, 32 + sr)); } while (0)
__device__ __forceinline__ bf16x8 knorm8(bf16x8 kv) {
    const u32x4 w = __builtin_bit_cast(u32x4, kv);
    float x[8] = {__uint_as_float(w.x << 16), __uint_as_float(w.x & 0xffff0000u), __uint_as_float(w.y << 16), __uint_as_float(w.y & 0xffff0000u),
                  __uint_as_float(w.z << 16), __uint_as_float(w.z & 0xffff0000u), __uint_as_float(w.w << 16), __uint_as_float(w.w & 0xffff0000u)};
    float s = 0.f;
#pragma unroll
    for (int i = 0; i < 8; ++i) s += x[i] * x[i];
    s += __shfl_xor(s, 1); s += __shfl_xor(s, 2); s += __shfl_xor(s, 4); s += __shfl_xor(s, 8);
    const float r = 1.0f / sqrtf(s * (1.0f / 128.0f) + 1e-6f);
    u32x4 o; o.x = cvtpk(x[0] * r, x[1] * r); o.y = cvtpk(x[2] * r, x[3] * r); o.z = cvtpk(x[4] * r, x[5] * r); o.w = cvtpk(x[6] * r, x[7] * r);
    return __builtin_bit_cast(bf16x8, o);
}
#define SWRITE_HK(bf) do { *(bf16x8*)(K_lds + (bf) * SHM_K + kws) = S.st_k0; *(bf16x8*)(K_lds + (bf) * SHM_K + kws + 32 * 256) = S.st_k1; } while (0)
#define SWRITE_HV(bf) do { *(bf16x8*)(V_lds + (bf) * SHM_V + vst0) = S.st_v0; *(bf16x8*)(V_lds + (bf) * SHM_V + vst1) = S.st_v1; } while (0)
#define SWRITE_H(bf) do { SWRITE_HV(bf); SWRITE_HK(bf); } while (0)
__device__ __forceinline__ void qnorm(bf16x8* qr, const float* gq, const float* gk, int hi) {
    float s = 0.f;
#pragma unroll
    for (int d0 = 0; d0 < 8; ++d0) { const u32x4 w = __builtin_bit_cast(u32x4, qr[d0]);
        const float a0 = __uint_as_float(w.x << 16), a1 = __uint_as_float(w.x & 0xffff0000u), a2 = __uint_as_float(w.y << 16), a3 = __uint_as_float(w.y & 0xffff0000u);
        const float a4 = __uint_as_float(w.z << 16), a5 = __uint_as_float(w.z & 0xffff0000u), a6 = __uint_as_float(w.w << 16), a7 = __uint_as_float(w.w & 0xffff0000u);
        s += (a0 * a0 + a1 * a1) + (a2 * a2 + a3 * a3) + (a4 * a4 + a5 * a5) + (a6 * a6 + a7 * a7); }
    { auto rr = __builtin_amdgcn_permlane32_swap(__float_as_uint(s), __float_as_uint(s), false, false); s = __uint_as_float(rr[0]) + __uint_as_float(rr[1]); }
    const float r = 1.0f / sqrtf(s * (1.0f / 128.0f) + 1e-6f);
#pragma unroll
    for (int d0 = 0; d0 < 8; ++d0) { const u32x4 w = __builtin_bit_cast(u32x4, qr[d0]); const int d = d0 * 16 + hi * 8;
        const f32x4 g0 = *(const f32x4*)(gq + d) * *(const f32x4*)(gk + d) * r, g1 = *(const f32x4*)(gq + d + 4) * *(const f32x4*)(gk + d + 4) * r;
        u32x4 o; o.x = cvtpk(__uint_as_float(w.x << 16) * g0[0], __uint_as_float(w.x & 0xffff0000u) * g0[1]); o.y = cvtpk(__uint_as_float(w.y << 16) * g0[2], __uint_as_float(w.y & 0xffff0000u) * g0[3]);
        o.z = cvtpk(__uint_as_float(w.z << 16) * g1[0], __uint_as_float(w.z & 0xffff0000u) * g1[1]); o.w = cvtpk(__uint_as_float(w.w << 16) * g1[2], __uint_as_float(w.w & 0xffff0000u) * g1[3]);
        qr[d0] = __builtin_bit_cast(bf16x8, o); }
}
__device__ __forceinline__ void fox_prime(const BlockRef& cur, char* lds, Seam& S) {
    int tid; asm volatile("v_mov_b32 %0, %1" : "=v"(tid) : "v"((int)threadIdx.x));
    const int wid = __builtin_amdgcn_readfirstlane(tid >> 6), lane = tid & 63, r32 = lane & 31, hi = lane >> 5;
    const int sr = tid >> 4, sc = (tid & 15) * 8, kws = KSWZ(sr, sc * 2); char* K_lds = lds + 2 * SHM_V;
#pragma unroll
    for (int d0 = 0; d0 < 8; ++d0) S.qr[d0] = load8(cur.Q + (size_t)(wid * QBLK + r32) * QS + d0 * 16 + hi * 8);
    SLOAD_H(cur.K, cur.V, 0); VMW(); SWRITE_HK(0);
    __syncthreads();
}
__device__ __forceinline__ void fox_block(const BlockRef& cur, char* lds, Seam& S, const float* cumL, int NT, float* plse) {
    const int tid = threadIdx.x, wid = __builtin_amdgcn_readfirstlane(tid >> 6), lane = tid & 63, r32 = lane & 31, hi = lane >> 5;
    const int qlo = cur.P0 + wid * QBLK, qm = qlo + r32 - 4 * hi;
    char* V_lds = lds; char* K_lds = lds + 2 * SHM_V;
    float* ws = (float*)(lds + LDS_WS) + wid * 64; float* li_l = ws, * al_l = ws + 32;
    float m_reg = -1e30f, l_reg = 0; f32x16 o[4] = {};
    const int sr = tid >> 4, sc = (tid & 15) * 8, vst0 = v_st(sr, sc), vst1 = vst0 + 8192  , kws = KSWZ(sr, sc * 2);
    const int vb0 = (int)(uintptr_t)V_lds + v_rd_base(lane);
    const bf16_t* Kh = cur.K; const bf16_t* Vh = cur.V;
    const float* clb = cumL + 4 * hi;
#define RESC(a) do { if (__any((a) < 1.f)) { if (hi == 0) al_l[r32] = (a); asm volatile("s_waitcnt lgkmcnt(0)" ::: "memory");              \
                     for (int d_ = 0; d_ < 4; ++d_) for (int r = 0; r < 16; ++r) o[d_][r] *= al_l[crow(r, hi)]; } } while (0)
#define KBASE(t) ((t) * KVBLK)
#define MASKT(P0_, P1_, t) do { const int kb_ = KBASE(t); if (kb_ + KVBLK - 1 > qlo) mask_tile(P0_, P1_, qm - kb_); } while (0)
    constexpr int NQL = 8;
#define SEAM_K0() do { VMWN(NQL); SWRITE_HK(0); SBAR(); } while (0)
    f32x16 pA0, pA1, pB0, pB1; float mnA, mnB, alA, alB; bf16x8 pa0, pa1, pa2, pa3;
    SWRITE_HV(0); SBAR();
    if (NT > 1) { SLOAD_H(Kh, Vh, KBASE(1)); }
    SBAR(); qkt<0>(pA0, pA1, K_lds, r32, hi, S.qr, clb + KBASE(0));
    MASKT(pA0, pA1, 0); partialSM(pA0, pA1, m_reg, mnA, alA);
    if (NT > 1) { VMW(); SWRITE_H(1); }
    __syncthreads();
#define HALF_STEP(PX0, PX1, mnX, alX, PY0, PY1, alY, t, KB, VB, SB) do {                                                      \
        SBAR(); qkt<KB>(PX0, PX1, K_lds, r32, hi, S.qr, clb + KBASE(t));                                                  \
        finishSM(PY0, PY1, alY, l_reg, pa0, pa1, pa2, pa3); SBAR();                                                           \
        if ((t) + 1 < NT) { SLOAD_H(Kh, Vh, KBASE((t) + 1)); SBAR(); }                                                        \
        pv_tile<VB>(o, vb0, pa0, pa1, pa2, pa3); MASKT(PX0, PX1, (t)); partialSM(PX0, PX1, m_reg, mnX, alX);                   \
        __syncthreads();                                                                                                      \
        if ((t) + 1 < NT) { VMW(); SWRITE_H(SB); }                                                                            \
        RESC(alX); __syncthreads(); } while (0)
    for (int t = 1; t + 1 < NT; t += 2) {
        HALF_STEP(pB0, pB1, mnB, alB, pA0, pA1, alA, t, 1, 0, 0);
        HALF_STEP(pA0, pA1, mnA, alA, pB0, pB1, alB, t + 1, 0, 1, 1);
    }
    const bool even = (NT & 1) == 0;
    if (even) { SBAR(); qkt<1>(pB0, pB1, K_lds, r32, hi, S.qr, clb + KBASE(NT - 1)); SBAR(); }
    finishSM(pA0, pA1, alA, l_reg, pa0, pa1, pa2, pa3); SBAR();
    pv_tile<0>(o, vb0, pa0, pa1, pa2, pa3);
    if (even) { MASKT(pB0, pB1, NT - 1); partialSM(pB0, pB1, m_reg, mnB, alB); __syncthreads(); RESC(alB);
        finishSM(pB0, pB1, alB, l_reg, pa0, pa1, pa2, pa3); SBAR(); pv_tile<1>(o, vb0, pa0, pa1, pa2, pa3); }
    SBAR();
    if (hi == 0) { li_l[r32] = l_reg;
        if (plse) __hip_atomic_store(plse + wid * QBLK + r32, m_reg * (1.4426950408889634f * SCALE) + __builtin_amdgcn_logf(l_reg), __ATOMIC_RELAXED, __HIP_MEMORY_SCOPE_AGENT); }
    asm volatile("s_waitcnt lgkmcnt(0)" ::: "memory");
    float rli[16];
#pragma unroll
    for (int r = 0; r < 16; ++r) rli[r] = __builtin_amdgcn_rcpf(li_l[crow(r, hi)]);
    bf16_t* Ow = cur.O + (size_t)(wid * QBLK) * OS;
#pragma unroll
    for (int r = 0; r < 16; ++r) { const int orow = crow(r, hi);
#pragma unroll
        for (int d0 = 0; d0 < 4; ++d0) { const float v = o[d0][r] * rli[r];
            const float vn = __int_as_float(__builtin_amdgcn_update_dpp(0, __float_as_int(v), 0xB1, 0xf, 0xf, false));
            if ((r32 & 1) == 0) { unsigned* op_ = (unsigned*)(Ow + (size_t)orow * OS + d0 * 32 + r32);
                if (plse) __hip_atomic_store(op_, cvtpk(v, vn), __ATOMIC_RELAXED, __HIP_MEMORY_SCOPE_AGENT); else *op_ = cvtpk(v, vn); } } }
    __syncthreads();
#undef RESC
#undef KBASE
#undef MASKT
#undef SEAM_K0
#undef HALF_STEP
}
#undef ROW
#undef VMWN
#undef SLOAD_H
#undef SWRITE_HK
#undef SWRITE_HV
#undef SWRITE_H

constexpr int GM_U = 2 * SHM_V;
constexpr int GM_UP = 264;
__device__ __forceinline__ void gmlp_unit(char* lds, int idx, const bf16_t* Z, const bf16_t* Wb, const float* b_s, bf16_t* OAB, const float* vs1, const float* vs2, const float* lng, const float* lnb) {
    int tid; asm volatile("v_mov_b32 %0, %1" : "=v"(tid) : "v"((int)threadIdx.x));
    const int wid = __builtin_amdgcn_readfirstlane(tid >> 6), lane = tid & 63, r32 = lane & 31, hi = lane >> 5;
    const int g = idx & 7, row0 = (idx >> 3) * 128;
    char* V_lds = lds;
    const int sr = tid >> 4, sc = (tid & 15) * 8;
    const int rg = wid & 3, dh = wid >> 2, nks = 2 * (rg + 1);
    u32x4 vraw[4], uraw[4]; float s1[4], s2[4];
#pragma unroll
    for (int q = 0; q < 4; ++q) { const int s = q * 32 + sr; const bf16_t* zr = Z + (size_t)(row0 + s) * QS + g * 128 + sc;
        vraw[q] = __builtin_bit_cast(u32x4, load8(zr + 1024)); uraw[q] = __builtin_bit_cast(u32x4, load8(zr)); s1[q] = vs1[row0 + s]; s2[q] = vs2[row0 + s]; }
    const f32x4 lg0 = *(const f32x4*)(lng + g * 128 + sc), lg1 = *(const f32x4*)(lng + g * 128 + sc + 4), lb0 = *(const f32x4*)(lnb + g * 128 + sc), lb1 = *(const f32x4*)(lnb + g * 128 + sc + 4);
    bf16x8 wf[8];
    const bf16_t* wrow = Wb + (size_t)(g * 128 + 32 * rg + r32) * 128 + 8 * hi;
#pragma unroll
    for (int ks = 0; ks < 8; ++ks) wf[ks] = load8(wrow + 16 * ks);
    float bias[16];
#pragma unroll
    for (int r = 0; r < 16; ++r) bias[r] = b_s[g * 128 + 32 * rg + crow(r, hi)];
#pragma unroll
    for (int q = 0; q < 4; ++q) { const int s = q * 32 + sr; const u32x4 w = vraw[q];
        const float mu = s1[q] * (1.0f / 1024.0f), var = s2[q] * (1.0f / 1024.0f) - mu * mu, rs = 1.0f / sqrtf(var + 1e-6f), nm = -mu * rs;
        const f32x4 a0 = (f32x4){__uint_as_float(w.x << 16), __uint_as_float(w.x & 0xffff0000u), __uint_as_float(w.y << 16), __uint_as_float(w.y & 0xffff0000u)};
        const f32x4 a1 = (f32x4){__uint_as_float(w.z << 16), __uint_as_float(w.z & 0xffff0000u), __uint_as_float(w.w << 16), __uint_as_float(w.w & 0xffff0000u)};
        const f32x4 y0 = (a0 * rs + nm) * lg0 + lb0, y1 = (a1 * rs + nm) * lg1 + lb1;
        u32x4 o; o.x = cvtpk(y0[0], y0[1]); o.y = cvtpk(y0[2], y0[3]); o.z = cvtpk(y1[0], y1[1]); o.w = cvtpk(y1[2], y1[3]);
        *(bf16x8*)(V_lds + (q >> 1) * SHM_V + v_st((q & 1) * 32 + sr, sc)) = __builtin_bit_cast(bf16x8, o);
        char* up = lds + GM_U + s * GM_UP + sc * 2; *(unsigned long long*)up = (unsigned long long)uraw[q].x | ((unsigned long long)uraw[q].y << 32);
        *(unsigned long long*)(up + 8) = (unsigned long long)uraw[q].z | ((unsigned long long)uraw[q].w << 32); }
    __syncthreads();
    f32x16 o0 = {}, o1 = {};
    const int vb = (int)(uintptr_t)V_lds + v_rd_base(lane) + dh * 1024;
#define GM_STEP(ks) do { if ((ks) < nks) { s16x4 l0, h0, l1, h1; constexpr int b_ = ((ks) >> 2) * SHM_V + v_rd_off(0, (ks) & 3, 0); \
        TRRD(l0, vb, b_); TRRD(h0, vb, b_ + 2048); TRRD(l1, vb, b_ + 512); TRRD(h1, vb, b_ + 512 + 2048); \
        asm volatile("s_waitcnt lgkmcnt(0)" ::: "memory"); SBAR(); \
        o0 = __builtin_amdgcn_mfma_f32_32x32x16_bf16(wf[ks], (bf16x8){l0[0], l0[1], l0[2], l0[3], h0[0], h0[1], h0[2], h0[3]}, o0, 0, 0, 0); \
        o1 = __builtin_amdgcn_mfma_f32_32x32x16_bf16(wf[ks], (bf16x8){l1[0], l1[1], l1[2], l1[3], h1[0], h1[1], h1[2], h1[3]}, o1, 0, 0, 0); } } while (0)
    GM_STEP(0); GM_STEP(1); GM_STEP(2); GM_STEP(3); GM_STEP(4); GM_STEP(5); GM_STEP(6); GM_STEP(7);
#undef GM_STEP
#pragma unroll
    for (int r = 0; r < 16; ++r) { const int t = 32 * rg + crow(r, hi);
        const size_t ooff = (size_t)(row0 + t) * OS + g * 128;
#pragma unroll
        for (int dd = 0; dd < 2; ++dd) { const int d = (2 * dh + dd) * 32 + r32;
            const float uu = __uint_as_float((unsigned)(*(const unsigned short*)(lds + GM_U + t * GM_UP + d * 2)) << 16);
            const float v = uu * ((dd ? o1[r] : o0[r]) + bias[r]);
            const float vn = __int_as_float(__builtin_amdgcn_update_dpp(0, __float_as_int(v), 0xB1, 0xf, 0xf, false));
            if ((r32 & 1) == 0) *(unsigned*)(OAB + ooff + d) = cvtpk(v, vn); } }
    __syncthreads();
}
#undef TRRD
#undef SBAR
#undef VMW
}

constexpr int NWAVES = 8;
constexpr int N_LAUNCHES = MK_N_LAUNCHES;
constexpr int N_PHASES = 10;
constexpr int M = 8192, DM = 2048, SEQ = 2048, NZ = 9216, DFF = 5632, NUP = 2 * DFF, PLE = 256, INC = 9224;
constexpr float EPS = 1e-6f;
constexpr size_t MiB = 1u << 20;
constexpr size_t WS_CTL = 0, CTL_ZERO_BYTES = 1 * MiB;
constexpr size_t WS_F = 1 * MiB;
constexpr size_t WS_CUM = WS_F + 512 * 1024;
constexpr size_t WS_WSB = 2 * MiB;
constexpr size_t WS_PLSE = 3 * MiB;
constexpr size_t WS_PART = 148 * MiB;
constexpr size_t WS_Z = 4 * MiB;
constexpr size_t WS_Y = 148 * MiB;
constexpr size_t WS_E = 100 * MiB;
constexpr size_t WS_A2 = 132 * MiB;
constexpr size_t WS_HALO = 165 * MiB, WS_FA = 167 * MiB, WS_FB = 169 * MiB;
constexpr size_t WS_WUP = 180 * MiB, WS_WDOWN = 224 * MiB, WS_WGATE = 246 * MiB, WS_WPLE = 254 * MiB, WS_PB = 255 * MiB;
constexpr size_t WS_H = 259 * MiB;
constexpr size_t WS_WIN = 291 * MiB, WS_WAB = 327 * MiB, WS_WOUT = 335 * MiB;
constexpr size_t WS_HM = 4 * MiB;
constexpr size_t WS_END = 347 * MiB;
constexpr int CW_BAR = 4096, CW_GQ = 8192, CW_AFLAG = 9216, CW_SSQ1 = 16384, CW_SSQ2 = 24576, CW_SSQE = 32768, CW_VS1 = 40960, CW_VS2 = 49152;

constexpr int RING_BYTES = 131072;
constexpr int LDSCTL_OFF = 143360, MISC_OFF = LDSCTL_OFF + 320;
constexpr int LDS_BYTES = 147456;
constexpr int P0_WF_OFF = 67584;
static_assert(4 * 16640 <= P0_WF_OFF && P0_WF_OFF + 65536 <= LDSCTL_OFF && 8 * 16640 <= LDSCTL_OFF && fox::LDS_BYTES <= RING_BYTES && MISC_OFF + 128 <= LDS_BYTES, "LDS map");

#define GAS __attribute__((address_space(1)))
#define LAS __attribute__((address_space(3)))
typedef unsigned short bf16;
typedef unsigned v4u __attribute__((ext_vector_type(4)));
typedef float f32x4 __attribute__((ext_vector_type(4)));
#define RLX_AGENT __ATOMIC_RELAXED, __HIP_MEMORY_SCOPE_AGENT
#define LDS_WAIT() asm volatile("s_waitcnt lgkmcnt(0)" ::: "memory")
__device__ __forceinline__ unsigned f2bf(float f) { unsigned u = __builtin_bit_cast(unsigned, f); return (u + 0x7fffu + ((u >> 16) & 1u)) >> 16; }
__device__ __forceinline__ unsigned pk2(float lo, float hi) { unsigned r; asm("v_cvt_pk_bf16_f32 %0, %1, %2" : "=v"(r) : "v"(lo), "v"(hi)); return r; }
__device__ __forceinline__ float bflo(unsigned w) { return __uint_as_float(w << 16); }
__device__ __forceinline__ float bfhi(unsigned w) { return __uint_as_float(w & 0xffff0000u); }

#define XB_TMO      128
#define XB_XCNT(j)  (256  + 64 * (j))
#define XB_XSUB(j)  (1280 + 64 * (j))
#define XB_XGEN(j)  (2304 + 64 * (j))
#define XB_TOP      3328
#define XB_TOPGEN   3392
#define XCD_BAR_WORDS 3456
#define XB_SPIN_CAP (1u << 18)
__device__ __forceinline__ unsigned xb_ld(unsigned* p)              { return __hip_atomic_load(p, __ATOMIC_RELAXED, __HIP_MEMORY_SCOPE_AGENT); }
__device__ __forceinline__ unsigned xb_add(unsigned* p, unsigned v) { return __hip_atomic_fetch_add(p, v, __ATOMIC_RELAXED, __HIP_MEMORY_SCOPE_AGENT); }
__device__ __forceinline__ unsigned xb_xcc_id() { return (unsigned)__builtin_amdgcn_s_getreg((3 << 11) | 20) & 0xFu; }
#define XB_SPIN(cond, bar) do { unsigned _sp = 0; while (cond) { __builtin_amdgcn_s_sleep(1); \
    if ((++_sp & 255u) == 0u) { if (xb_ld(&(bar)[XB_TMO])) break; if (_sp > XB_SPIN_CAP) { atomicAdd(&(bar)[XB_TMO], 1u); break; } } } } while (0)
struct XcdBarrier { unsigned* bar; unsigned x; volatile LAS unsigned* st; };
__device__ __forceinline__ XcdBarrier xcd_barrier_post(unsigned* bar, volatile LAS unsigned* st) {
    XcdBarrier b; b.bar = bar; b.x = xb_xcc_id(); b.st = st;
    if (threadIdx.x == 0) (void)xb_add(&bar[XB_XCNT(b.x)], 1u);
    return b;
}
__device__ __forceinline__ void xcd_barrier_complete(unsigned* bar, unsigned x, unsigned& nloc, unsigned& nx) {
    const unsigned G = gridDim.x * gridDim.y * gridDim.z;
    unsigned sum, cnt, mine, sp = 0u;
    for (;;) {
        sum = 0u; cnt = 0u; mine = 0u;
#pragma unroll
        for (unsigned j = 0; j < 16; ++j) { const unsigned c = xb_ld(&bar[XB_XCNT(j)]); sum += c; cnt += (c > 0u) ? 1u : 0u; mine = (j == x) ? c : mine; }
        if (sum == G) break;
        __builtin_amdgcn_s_sleep(1);
        if ((++sp & 255u) == 0u) { if (xb_ld(&bar[XB_TMO])) break; if (sp > XB_SPIN_CAP) { atomicAdd(&bar[XB_TMO], 1u); break; } }
    }
    nloc = mine > 0u ? mine : 1u; nx = cnt > 0u ? cnt : 1u;
}
__device__ __forceinline__ void xcd_barrier(const XcdBarrier& b) {
    asm volatile("s_waitcnt vmcnt(0)" ::: "memory");
    __syncthreads();
    if (threadIdx.x == 0) {
        unsigned* bar = b.bar;
        __builtin_amdgcn_s_waitcnt(0);
        unsigned nloc = b.st[0], nx = b.st[1];
        if (nloc == 0u) { xcd_barrier_complete(bar, b.x, nloc, nx); b.st[0] = nloc; b.st[1] = nx; }
        const unsigned old = xb_add(&bar[XB_XSUB(b.x)], 1u);
        const unsigned gen = old / nloc;
        if (old + 1u == (gen + 1u) * nloc) {
            __builtin_amdgcn_fence(__ATOMIC_RELEASE, "agent");
            asm volatile("s_waitcnt vmcnt(0)" ::: "memory");
            const unsigned og = xb_add(&bar[XB_TOP], 1u);
            const unsigned tg = og / nx;
            if (og + 1u == (tg + 1u) * nx) xb_add(&bar[XB_TOPGEN], 1u);
            else XB_SPIN(xb_ld(&bar[XB_TOPGEN]) == tg, bar);
            __builtin_amdgcn_fence(__ATOMIC_ACQUIRE, "agent");
            xb_add(&bar[XB_XGEN(b.x)], 1u);
            asm volatile("s_waitcnt vmcnt(0)" ::: "memory");
        } else {
            XB_SPIN(xb_ld(&bar[XB_XGEN(b.x)]) == gen, bar);
            __builtin_amdgcn_fence(__ATOMIC_ACQUIRE, "agent");
            asm volatile("s_waitcnt vmcnt(0)" ::: "memory");
        }
    }
    __syncthreads();
}

__device__ __forceinline__ float wave_sum(float v) {
    v += __int_as_float(__builtin_amdgcn_update_dpp(0, __float_as_int(v), 0xB1, 0xf, 0xf, false));
    v += __int_as_float(__builtin_amdgcn_update_dpp(0, __float_as_int(v), 0x4E, 0xf, 0xf, false));
    v += __int_as_float(__builtin_amdgcn_update_dpp(0, __float_as_int(v), 0x141, 0xf, 0xf, false));
    v += __int_as_float(__builtin_amdgcn_update_dpp(0, __float_as_int(v), 0x140, 0xf, 0xf, false));
    { auto r = __builtin_amdgcn_permlane16_swap(__float_as_uint(v), __float_as_uint(v), false, false); v = __uint_as_float(r[0]) + __uint_as_float(r[1]); }
    { auto r = __builtin_amdgcn_permlane32_swap(__float_as_uint(v), __float_as_uint(v), false, false); v = __uint_as_float(r[0]) + __uint_as_float(r[1]); }
    return v;
}
struct TPtrs { const float *w_in, *wa, *wb, *wout, *wup, *wdown, *wgate, *wple, *g_up, *g_gate; bf16 *WIN, *WAB, *WOUT, *WUP, *WDOWN, *WGATE, *WPLE; };
constexpr int TI1 = 32 * 80, TI2 = 32 * 64, TI3 = 16 * 32, TI4 = 16 * 32, TI5 = 32 * 32, TI6 = 32 * 176, TI7 = 88 * 32, TI8 = 32 * 32, TI9 = 4 * 32;
constexpr int TG0 = TI1 + TI2, TG1 = TI3 + TI4 + TI5 + TI6 + TI9, TG2 = TI7 + TI8;
template <int GRP> __device__ __forceinline__ void t_decode(const TPtrs& P, int r, int lane, const float*& src, int& ldw, bf16*& dst, int& ldk, const float*& gain) {
    const float* W; bf16* WT; int k0, scol, drow, dk0; const float* gn = nullptr;
    if (GRP == 0) {
        if (r < TI1) { const int kb = r / 80, nb = r % 80; W = P.w_in; ldw = 9224; k0 = 64 * kb; scol = 64 * nb; WT = P.WIN; ldk = 2048; drow = 64 * nb; dk0 = k0; }
        else { r -= TI1; const int kb = r / 64, nb = r % 64; W = P.w_in; ldw = 9224; k0 = 64 * kb; scol = 5128 + 64 * nb; WT = P.WIN; ldk = 2048; dk0 = k0;
               const int o = 64 * nb, c = o < 2048 ? o : o - 2048; drow = 5120 + 256 * (c >> 7) + (c & 127) + (o < 2048 ? 0 : 128); }
    } else if (GRP == 1) {
        if (r < TI3) { const int kb = r / 32, nb = r % 32; W = P.wa; ldw = 2048; k0 = 64 * kb; scol = 64 * nb; WT = P.WAB; ldk = 2048; drow = 64 * nb; dk0 = k0; }
        else if (r < TI3 + TI4) { r -= TI3; const int kb = r / 32, nb = r % 32; W = P.wb; ldw = 2048; k0 = 64 * kb; scol = 64 * nb; WT = P.WAB; ldk = 2048; drow = 64 * nb; dk0 = 1024 + k0; }
        else if (r < TI3 + TI4 + TI5) { r -= TI3 + TI4; const int kb = r / 32, nb = r % 32; W = P.wout; ldw = 2048; k0 = 64 * kb; scol = 64 * nb; WT = P.WOUT; ldk = 2048; drow = 64 * nb; dk0 = k0; }
        else if (r >= TI3 + TI4 + TI5 + TI6) { r -= TI3 + TI4 + TI5 + TI6; const int kb = r / 32, nb = r % 32; W = P.wple; ldw = 2048; k0 = 64 * kb; scol = 64 * nb; WT = P.WPLE; ldk = 256; drow = 64 * nb; dk0 = k0; }
        else { r -= TI3 + TI4 + TI5; const int kb = r / 176, nb = r % 176; W = P.wup; ldw = 11264; k0 = 64 * kb; scol = 64 * nb; const int mm = scol < 5632 ? scol : scol - 5632;
               WT = P.WUP; ldk = 2048; drow = 256 * (mm >> 7) + (mm & 127) + (scol < 5632 ? 0 : 128); dk0 = k0; gn = P.g_up; }
    } else {
        if (r < TI7) { const int kb = r / 32, nb = r % 32; W = P.wdown; ldw = 2048; k0 = 64 * kb; scol = 64 * nb; WT = P.WDOWN; ldk = 5632; drow = 64 * nb; dk0 = k0; }
        else { r -= TI7; const int kb = r / 32, nb = r % 32; W = P.wgate; ldw = 2048; k0 = 64 * kb; scol = 64 * nb; WT = P.WGATE; ldk = 2048; drow = 64 * nb; dk0 = k0; gn = P.g_gate; }
    }
    src = W + (size_t)(k0 + (lane >> 4)) * ldw + scol + 4 * (lane & 15);
    dst = WT + (size_t)(drow + (lane >> 3)) * ldk + dk0 + 8 * (lane & 7);
    gain = gn ? gn + k0 + (lane >> 4) : nullptr;
}
template <int GRP> __device__ __forceinline__ void run_transposes(const TPtrs& P, int first, int stride, LAS float* scr, int lane) {
    constexpr int NIT = GRP == 0 ? TG0 : (GRP == 1 ? TG1 : TG2);
    int it = first; if (it >= NIT) return;
    const float* src; bf16* dst; int ldw, ldk; const float* gain;
    t_decode<GRP>(P, it, lane, src, ldw, dst, ldk, gain);
    f32x4 v[16]; float gv[16];
#pragma unroll
    for (int i = 0; i < 16; ++i) v[i] = __builtin_nontemporal_load((const GAS f32x4*)(src + (size_t)(4 * i) * ldw));
#pragma unroll
    for (int i = 0; i < 16; ++i) gv[i] = (GRP != 0 && gain) ? gain[4 * i] : 1.0f;
    const int kr = lane >> 4, nq = lane & 15, c = lane & 7;
    for (;;) {
#pragma unroll
        for (int i = 0; i < 16; ++i) { LAS float* d = scr + (4 * i + kr) * 65 + 4 * nq; const f32x4 t = v[i] * gv[i]; d[0] = t.x; d[1] = t.y; d[2] = t.z; d[3] = t.w; }
        const int nit = it + stride; const bool more = nit < NIT;
        bf16* cdst = dst; const int cldk = ldk;
        if (more) { t_decode<GRP>(P, nit, lane, src, ldw, dst, ldk, gain);
#pragma unroll
            for (int i = 0; i < 16; ++i) v[i] = __builtin_nontemporal_load((const GAS f32x4*)(src + (size_t)(4 * i) * ldw));
#pragma unroll
            for (int i = 0; i < 16; ++i) gv[i] = (GRP != 0 && gain) ? gain[4 * i] : 1.0f; }
        LDS_WAIT(); asm volatile("" ::: "memory");
#pragma unroll
        for (int j = 0; j < 8; ++j) { const LAS float* sp = scr + (8 * c) * 65 + (lane >> 3) + 8 * j;
            v4u o; o.x = pk2(sp[0 * 65], sp[1 * 65]); o.y = pk2(sp[2 * 65], sp[3 * 65]); o.z = pk2(sp[4 * 65], sp[5 * 65]); o.w = pk2(sp[6 * 65], sp[7 * 65]);
            *(GAS v4u*)(cdst + (size_t)(8 * j) * cldk) = o; }
        LDS_WAIT(); asm volatile("" ::: "memory");
        if (!more) break;
        it = nit;
    }
}

__device__ __forceinline__ void conv_fixup_rows(int pm, int ch, bf16* HM, const float* HALO, const float* FA, const float* FB, const float* conv_w, const float* conv_b) {
    const int c = ch * 8;
    float o0[8], o1[8];
#pragma unroll
    for (int h = 0; h < 2; ++h) { const int cc = c + 4 * h;
        const f32x4 w0 = *(const f32x4*)(conv_w + cc), w1 = *(const f32x4*)(conv_w + DFF + cc), w2 = *(const f32x4*)(conv_w + 2 * DFF + cc), cbv = *(const f32x4*)(conv_b + cc);
        const f32x4 am2 = *(const f32x4*)(HALO + (size_t)((pm - 1) * 2 + 0) * DFF + cc), am1 = *(const f32x4*)(HALO + (size_t)((pm - 1) * 2 + 1) * DFF + cc);
        const f32x4 a0 = *(const f32x4*)(FA + (size_t)(pm * 2 + 0) * DFF + cc), a1 = *(const f32x4*)(FA + (size_t)(pm * 2 + 1) * DFF + cc);
        const f32x4 b0 = *(const f32x4*)(FB + (size_t)(pm * 2 + 0) * DFF + cc), b1 = *(const f32x4*)(FB + (size_t)(pm * 2 + 1) * DFF + cc);
#pragma unroll
        for (int q = 0; q < 4; ++q) { o0[4 * h + q] = pg8::EpiUpConv::gelu_t(cbv[q] + w0[q] * am2[q] + w1[q] * am1[q] + w2[q] * a0[q]) * b0[q];
                                      o1[4 * h + q] = pg8::EpiUpConv::gelu_t(cbv[q] + w0[q] * am1[q] + w1[q] * a0[q] + w2[q] * a1[q]) * b1[q]; } }
    v4u ov; ov.x = pk2(o0[0], o0[1]); ov.y = pk2(o0[2], o0[3]); ov.z = pk2(o0[4], o0[5]); ov.w = pk2(o0[6], o0[7]);
    *(v4u*)(HM + (size_t)(pm * 256) * DFF + c) = ov;
    ov.x = pk2(o1[0], o1[1]); ov.y = pk2(o1[2], o1[3]); ov.z = pk2(o1[4], o1[5]); ov.w = pk2(o1[6], o1[7]);
    *(v4u*)(HM + (size_t)(pm * 256 + 1) * DFF + c) = ov;
}

struct Args { const float* in[23]; float* out; unsigned char* ws; int ph_lo, ph_hi, one, pad; };

__global__ void __launch_bounds__(NWAVES * 64, 2) mega_fwd(Args args) {
    extern __shared__ __attribute__((aligned(16))) unsigned char lds[];
    LAS unsigned char* ldsL = (LAS unsigned char*)lds;
    volatile LAS unsigned* MISC = (volatile LAS unsigned*)(ldsL + MISC_OFF);
    const int tid = threadIdx.x, lane = tid & 63, wave = __builtin_amdgcn_readfirstlane(tid >> 6);
    const int G = gridDim.x; const int bx = blockIdx.x; const int vcu = (G % 8 == 0) ? (bx % 8) * (G / 8) + bx / 8 : bx;
    unsigned char* ws = args.ws;
    unsigned* ctl = (unsigned*)(ws + WS_CTL);
    const float* x = args.in[0]; const float* pin = args.in[1]; const float* norm_mix_g = args.in[2]; const float* w_in = args.in[3];
    const float* gmlp_ln_g = args.in[4]; const float* gmlp_ln_b = args.in[5]; const float* gmlp_w_s = args.in[6]; const float* gmlp_b_s = args.in[7];
    const float* fox_b_f = args.in[8]; const float* q_norm_g = args.in[9]; const float* k_norm_g = args.in[10];
    const float* w_branch_a = args.in[11]; const float* w_branch_b = args.in[12]; const float* w_out = args.in[13]; const float* norm_ffn_g = args.in[14];
    const float* w_up = args.in[15]; const float* conv_w = args.in[16]; const float* conv_b = args.in[17]; const float* w_down = args.in[18];
    const float* ple_proj = args.in[19]; const float* ple_norm_g = args.in[20]; const float* ple_gate_norm_g = args.in[21]; const float* w_ple_gate = args.in[22];
    float* out = args.out;
    float* Fb = (float*)(ws + WS_F); float* CUM = (float*)(ws + WS_CUM); bf16* WSB = (bf16*)(ws + WS_WSB);
    bf16* Z = (bf16*)(ws + WS_Z); bf16* Y = (bf16*)(ws + WS_Y); bf16* EB = (bf16*)(ws + WS_E); bf16* A2 = (bf16*)(ws + WS_A2);
    bf16* WUP = (bf16*)(ws + WS_WUP); bf16* WDOWN = (bf16*)(ws + WS_WDOWN); bf16* WGATE = (bf16*)(ws + WS_WGATE); bf16* WPLE = (bf16*)(ws + WS_WPLE);
    bf16* PB = (bf16*)(ws + WS_PB); bf16* H = (bf16*)(ws + WS_H); bf16* WIN = (bf16*)(ws + WS_WIN); bf16* WAB = (bf16*)(ws + WS_WAB); bf16* WOUT = (bf16*)(ws + WS_WOUT);
    bf16* HM = (bf16*)(ws + WS_HM); float* HALO = (float*)(ws + WS_HALO); float* FA = (float*)(ws + WS_FA); float* FB = (float*)(ws + WS_FB); bf16* OAB = (bf16*)out;
#define MAKE_TP() TPtrs TP; TP.w_in = args.in[3]; TP.wa = args.in[11]; TP.wb = args.in[12]; TP.wout = args.in[13]; TP.wup = args.in[15]; TP.wdown = args.in[18]; TP.wgate = args.in[22]; TP.wple = args.in[19]; TP.g_up = args.in[14]; TP.g_gate = args.in[21]; \
    TP.WIN = (bf16*)(args.ws + WS_WIN); TP.WAB = (bf16*)(args.ws + WS_WAB); TP.WOUT = (bf16*)(args.ws + WS_WOUT); TP.WUP = (bf16*)(args.ws + WS_WUP); TP.WDOWN = (bf16*)(args.ws + WS_WDOWN); TP.WGATE = (bf16*)(args.ws + WS_WGATE); TP.WPLE = (bf16*)(args.ws + WS_WPLE)
    float* VS1 = (float*)(ctl + CW_VS1); float* VS2 = (float*)(ctl + CW_VS2);
    float* SSQ1 = (float*)(ctl + CW_SSQ1); float* SSQ2 = (float*)(ctl + CW_SSQ2); float* SSQE = (float*)(ctl + CW_SSQE);

    for (int u = tid; u < (LDS_BYTES - LDSCTL_OFF) / 4; u += NWAVES * 64) ((LAS unsigned*)(ldsL + LDSCTL_OFF))[u] = 0u;
    __syncthreads();
    XcdBarrier bar; bar.bar = ctl + CW_BAR; bar.x = 0; bar.st = nullptr;
    if (args.one) bar = xcd_barrier_post(ctl + CW_BAR, MISC + 8);
    const int lo = args.ph_lo, hi = args.ph_hi;
#ifndef PROBE_PHASE
#define PROBE_PHASE (-1)
#endif
#ifndef PROBE_SCALE
#define PROBE_SCALE 5000.0f
#endif
    unsigned long long pr_prev = 0; float pr_us = 0.f;
    if (PROBE_PHASE >= 0) pr_prev = __builtin_amdgcn_s_memrealtime();
#define PR_STAMP(k) do { if (PROBE_PHASE >= 0) { const unsigned long long t_ = __builtin_amdgcn_s_memrealtime(); if ((k) == PROBE_PHASE) pr_us = (float)(t_ - pr_prev) * 0.01f; pr_prev = t_; } } while (0)
#ifndef PH_MASK
#define PH_MASK 0x3ff
#endif
#define IN(k) ((((PH_MASK) >> (k)) & 1) && lo <= (k) && (k) < hi)
#define GRID_BAR(k) do { if (IN(k) && IN((k) + 1)) xcd_barrier(bar); } while (0)
    const int gw = vcu * NWAVES + wave, NGW = G * NWAVES;
    const int gt = vcu * (NWAVES * 64) + tid, NGT = G * NWAVES * 64;

    if (IN(0)) {
        { LAS float* wf = (LAS float*)(ldsL + P0_WF_OFF);
          for (int k = tid; k < DM; k += NWAVES * 64) { const f32x4 a = *(const f32x4*)(w_in + (size_t)k * INC + 5120), b = *(const f32x4*)(w_in + (size_t)k * INC + 5124);
              wf[0 * DM + k] = a[0]; wf[1 * DM + k] = a[1]; wf[2 * DM + k] = a[2]; wf[3 * DM + k] = a[3]; wf[4 * DM + k] = b[0]; wf[5 * DM + k] = b[1]; wf[6 * DM + k] = b[2]; wf[7 * DM + k] = b[3]; }
          __syncthreads(); }
        if (wave < 4) {
        const int gw = vcu * 4 + wave, NGW = G * 4, gt = vcu * 256 + tid, NGT = G * 256;
        { const LAS float* wf = (const LAS float*)(ldsL + P0_WF_OFF);
          f32x4 g4v[8];
#pragma unroll
          for (int j = 0; j < 8; ++j) g4v[j] = *((const GAS f32x4*)norm_mix_g + lane + 64 * j);
          f32x4 v[8], nv[8];
          if (gw < M) {
#pragma unroll
              for (int j = 0; j < 8; ++j) v[j] = __builtin_nontemporal_load((const GAS f32x4*)(x + (size_t)gw * DM) + lane + 64 * j); }
          for (int m = gw; m < M; m += NGW) {
            if (m + NGW < M) {
#pragma unroll
                for (int j = 0; j < 8; ++j) nv[j] = __builtin_nontemporal_load((const GAS f32x4*)(x + (size_t)(m + NGW) * DM) + lane + 64 * j); }
            float s = 0.f;
#pragma unroll
            for (int j = 0; j < 8; ++j) s += (v[j].x * v[j].x + v[j].y * v[j].y) + (v[j].z * v[j].z + v[j].w * v[j].w);
            const float rstd = 1.0f / sqrtf(wave_sum(s) * (1.0f / DM) + EPS);
            float fa[8];
#pragma unroll
            for (int f = 0; f < 8; ++f) fa[f] = 0.f;
            GAS unsigned long long* o8 = (GAS unsigned long long*)(H + (size_t)m * DM) + lane;
#pragma unroll
            for (int j = 0; j < 8; ++j) { const f32x4 h4 = v[j] * rstd * g4v[j];
                o8[64 * j] = (unsigned long long)pk2(h4.x, h4.y) | ((unsigned long long)pk2(h4.z, h4.w) << 32);
#pragma unroll
                for (int f = 0; f < 8; ++f) { const f32x4 w4 = *(const LAS f32x4*)(wf + f * DM + 256 * j + 4 * lane); fa[f] += (h4.x * w4.x + h4.y * w4.y) + (h4.z * w4.z + h4.w * w4.w); }
                asm volatile("" ::: "memory"); }
#pragma unroll
            for (int f = 0; f < 8; ++f) fa[f] = wave_sum(fa[f]);
            if (lane < 8) {
                float fv = fa[0];
#pragma unroll
                for (int f = 1; f < 8; ++f) fv = (lane == f) ? fa[f] : fv;
                const float xx = fv + fox_b_f[lane];
                Fb[(size_t)((m >> 11) * 8 + lane) * SEQ + (m & (SEQ - 1))] = fminf(xx, 0.f) - log1pf(expf(-fabsf(xx))); }
#pragma unroll
            for (int j = 0; j < 8; ++j) v[j] = nv[j];
          } }
        for (int i = gt; i < M * PLE / 8; i += NGT) { const f32x4 a = *(const f32x4*)(pin + (size_t)i * 8), b = *(const f32x4*)(pin + (size_t)i * 8 + 4);
            v4u o; o.x = pk2(a.x, a.y); o.y = pk2(a.z, a.w); o.z = pk2(b.x, b.y); o.w = pk2(b.z, b.w); *(v4u*)(PB + (size_t)i * 8) = o; }
        for (int i = gt; i < 8 * 128 * 128 / 8; i += NGT) { const int e = i * 8, t = (e >> 7) & 127, s0 = e & 127; const f32x4 a = *(const f32x4*)(gmlp_w_s + e), b = *(const f32x4*)(gmlp_w_s + e + 4);
            float w[8] = {a.x, a.y, a.z, a.w, b.x, b.y, b.z, b.w};
#pragma unroll
            for (int q = 0; q < 8; ++q) if (s0 + q > t) w[q] = 0.f;
            v4u o; o.x = pk2(w[0], w[1]); o.y = pk2(w[2], w[3]); o.z = pk2(w[4], w[5]); o.w = pk2(w[6], w[7]); *(v4u*)(WSB + e) = o; }
        } else {
            MAKE_TP(); run_transposes<0>(TP, vcu * 4 + (wave - 4), G * 4, (LAS float*)(ldsL + (wave - 4) * 16640), lane);
        }
        __syncthreads();
    }
    GRID_BAR(0); PR_STAMP(0);

    if (IN(1)) {
        pg8::Gemm g{H, WIN, M, NZ, DM}; pg8::StaticOrder S; S.init(M, NZ, G, bx);
        pg8::EpiZ E{Z, VS1, VS2, q_norm_g, k_norm_g, (LAS float*)(ldsL + RING_BYTES)};
        pg8::gemm_phase<pg8::EpiZ, pg8::StaticOrder, true, true>(ldsL, g, S, E);
        { const int rem = S.nwg % G; const int nidle = rem ? G - rem : G, idle = rem ? bx - rem : bx;
          if (idle >= 0) { MAKE_TP(); run_transposes<1>(TP, idle * NWAVES + wave, nidle * NWAVES, (LAS float*)(ldsL + wave * 16640), lane); } }
    }
    GRID_BAR(1); PR_STAMP(1);

    PR_STAMP(2);

    if (IN(3)) {
        int msid0 = -1, msid1 = -1;
        for (int it = vcu; it < 512; it += G) {
            const int item = it & 255, pc = it >> 8;
            const int bh = item >> 3, sl = item & 7, b = bh >> 3, h = bh & 7;
            const size_t rowb = (size_t)b * SEQ;
            if (pc == 1 && sl < 5) continue;
            int qb, t0, t1;
            if (pc == 0) { qb = sl == 0 ? 7 : sl == 1 ? 6 : sl == 2 ? 5 : sl == 3 ? 4 : sl == 4 ? 3 : sl == 5 ? 7 : sl == 6 ? 2 : 6;
                           t0 = (sl == 5 || sl == 7) ? 20 : 0;
                           t1 = sl < 4 ? 20 : sl == 4 ? 16 : sl == 5 ? 32 : sl == 6 ? 12 : 28; }
            else { qb = sl == 5 ? 5 : sl == 6 ? 0 : 1; t0 = sl == 5 ? 20 : 0; t1 = sl == 5 ? 24 : sl == 6 ? 4 : 8; }
            const bool split = qb >= 5; const int me = t0 ? 1 : 0, sid = bh * 4 + (qb - 4);
            fox::BlockRef cur; cur.P0 = qb * 256 - t0 * 64;
            cur.Q = Z + (rowb + qb * 256) * NZ + 2048 + h * 128; cur.K = Z + (rowb + t0 * 64) * NZ + 3072 + h * 128; cur.V = Z + (rowb + t0 * 64) * NZ + 4096 + h * 128;
            cur.O = split ? (bf16*)(ws + WS_PART) + (rowb + qb * 256) * 2048 + me * 1024 + h * 128 : OAB + (rowb + qb * 256) * 2048 + 1024 + h * 128;
            float* cumL = (float*)(lds + fox::LDS_CUM);
            {
              float* wsum = (float*)(lds + fox::LDS_WS);
              int tq; asm volatile("v_mov_b32 %0, %1" : "=v"(tq) : "v"(tid));
              const int nk = t1 * 64; const bool act = 4 * tq < nk;
              float v[4];
              { f32x4 ls = (f32x4){0.f, 0.f, 0.f, 0.f}; if (act) ls = *(const f32x4*)(Fb + (size_t)bh * SEQ + 4 * tq); v[0] = ls[0]; v[1] = ls[1]; v[2] = ls[2]; v[3] = ls[3]; }
              v[1] += v[0]; v[2] += v[1]; v[3] += v[2];
              const float tot = v[3]; float incl = tot;
#pragma unroll
              for (int o = 1; o < 64; o <<= 1) { const float t = __shfl_up(incl, o); if (lane >= o) incl += t; }
              if (lane == 63) wsum[wave] = incl;
              __syncthreads();
              float off = incl - tot;
              for (int w = 0; w < wave; ++w) off += wsum[w];
              const float isc = -11.313708498984761f;
              if (act) *(f32x4*)(cumL + 4 * tq) = (f32x4){(v[0] + off) * isc, (v[1] + off) * isc, (v[2] + off) * isc, (v[3] + off) * isc}; }
            { fox::Seam S;
              fox::fox_prime(cur, (char*)lds, S);
              fox::fox_block(cur, (char*)lds, S, cumL + t0 * 64, t1 - t0, split ? (float*)(ws + WS_PLSE) + (size_t)(sid * 2 + me) * 256 : nullptr); }
            if (split) {
                asm volatile("s_waitcnt vmcnt(0)" ::: "memory");
                __syncthreads();
                if (tid == 0) MISC[17] = atomicAdd(ctl + CW_AFLAG + sid, 1u);
                __syncthreads();
                if (MISC[17] == 1u) { if (msid0 < 0) msid0 = sid; else msid1 = sid; }
                __syncthreads();
            }
        }
        for (int mi = 0; mi < 2; ++mi) { const int sid = mi ? msid1 : msid0; if (sid < 0) continue;
            const int bh = sid >> 2, qb = 4 + (sid & 3), b = bh >> 3, h = bh & 7; const size_t rowb = (size_t)b * SEQ;
            __builtin_amdgcn_fence(__ATOMIC_ACQUIRE, "agent");
            asm volatile("s_waitcnt vmcnt(0)" ::: "memory");
            const float* LB0 = (const float*)(ws + WS_PLSE) + (size_t)sid * 2 * 256;
            const int row = tid >> 1, c0 = (tid & 1) * 64;
            const float l0 = LB0[row], l1 = LB0[256 + row], mx = fmaxf(l0, l1);
            const float w0 = __builtin_amdgcn_exp2f(l0 - mx), w1 = __builtin_amdgcn_exp2f(l1 - mx), inv = __builtin_amdgcn_rcpf(w0 + w1), a0 = w0 * inv, a1 = w1 * inv;
            const bf16* p0 = (const bf16*)(ws + WS_PART) + (rowb + qb * 256 + row) * 2048 + h * 128 + c0; const bf16* p1 = p0 + 1024;
            bf16* op = OAB + (rowb + qb * 256 + row) * 2048 + 1024 + h * 128 + c0;
#pragma unroll 2
            for (int j = 0; j < 8; ++j) { const v4u x = *(const v4u*)(p0 + 8 * j), y = *(const v4u*)(p1 + 8 * j); v4u o;
                o.x = pk2(a0 * bflo(x.x) + a1 * bflo(y.x), a0 * bfhi(x.x) + a1 * bfhi(y.x)); o.y = pk2(a0 * bflo(x.y) + a1 * bflo(y.y), a0 * bfhi(x.y) + a1 * bfhi(y.y));
                o.z = pk2(a0 * bflo(x.z) + a1 * bflo(y.z), a0 * bfhi(x.z) + a1 * bfhi(y.z)); o.w = pk2(a0 * bflo(x.w) + a1 * bflo(y.w), a0 * bfhi(x.w) + a1 * bfhi(y.w));
                *(v4u*)(op + 8 * j) = o; }
        }
        for (;;) {
            if (tid == 0) MISC[16] = atomicAdd(ctl + CW_GQ, 1u);
            __syncthreads();
            const unsigned idx = MISC[16];
            __syncthreads();
            if (idx >= 512u) break;
            fox::gmlp_unit((char*)lds, (int)idx, Z, WSB, gmlp_b_s, OAB, VS1, VS2, gmlp_ln_g, gmlp_ln_b);
        }
    }
    GRID_BAR(3); PR_STAMP(3);

    if (IN(4)) {
        pg8::Gemm g{OAB, WAB, M, DM, 2048}; pg8::StaticOrder S; S.init(M, DM, G, bx);
        pg8::EpiY E{Z, Y};
        pg8::gemm_phase<pg8::EpiY, pg8::StaticOrder, true, true>(ldsL, g, S, E);
    }
    GRID_BAR(4); PR_STAMP(4);

    if (IN(5)) {
        pg8::Gemm g{Y, WOUT, M, DM, DM}; pg8::StaticOrder S; S.init(M, DM, G, bx);
        pg8::EpiRes<true> E{x, H, SSQ1};
        pg8::gemm_phase<pg8::EpiRes<true>, pg8::StaticOrder, true, true>(ldsL, g, S, E);
    }
    GRID_BAR(5); PR_STAMP(5);

    if (IN(6)) {
        pg8::Gemm g{H, WUP, M, NUP, DM}; pg8::StaticOrder S; S.init(M, NUP, G, bx);
        pg8::EpiUpConv E{HM, SSQ1, conv_w, conv_b, HALO, FA, FB, (LAS float*)(ldsL + RING_BYTES)};
        pg8::gemm_phase<pg8::EpiUpConv, pg8::StaticOrder, true, true>(ldsL, g, S, E);
        { const int rem = S.nwg % G; const int nidle = rem ? G - rem : G, idle = rem ? bx - rem : bx;
          if (idle >= 0) { { MAKE_TP(); run_transposes<2>(TP, idle * NWAVES + wave, nidle * NWAVES, (LAS float*)(ldsL + wave * 16640), lane); }
              asm volatile("s_waitcnt vmcnt(0)" ::: "memory"); __syncthreads();
              pg8::Gemm ge{PB, WPLE, M, DM, PLE}; pg8::StaticOrder SE; SE.init(M, DM, nidle, idle);
              pg8::EpiE EE{EB, SSQE};
              pg8::gemm_phase<pg8::EpiE, pg8::StaticOrder, true, true>(ldsL, ge, SE, EE); } }
    }
    GRID_BAR(6); PR_STAMP(6);

    if (IN(8)) {
        { pg8::StaticOrder S; S.init(M, DM, G, bx); pg8::Unit u;
          for (int i = 0; S.next(i, u); ++i) if (u.pm & 7) for (int ch = tid; ch < DFF / 8; ch += NWAVES * 64) conv_fixup_rows(u.pm, ch, HM, HALO, FA, FB, conv_w, conv_b);
          asm volatile("s_waitcnt vmcnt(0)" ::: "memory"); __syncthreads(); }
        { pg8::Gemm g{HM, WDOWN, M, DM, DFF}; pg8::StaticOrder S; S.init(M, DM, G, bx);
          pg8::EpiRes<false> E{H, A2, SSQ2};
          pg8::gemm_phase<pg8::EpiRes<false>, pg8::StaticOrder, true, true>(ldsL, g, S, E); }
    }
    GRID_BAR(8); PR_STAMP(8);

    if (IN(9)) {
        pg8::Gemm g{A2, WGATE, M, DM, DM}; pg8::StaticOrder S; S.init(M, DM, G, bx);
        pg8::EpiFinal E{out, A2, EB, ple_norm_g, SSQ2, SSQE};
        pg8::gemm_phase<pg8::EpiFinal, pg8::StaticOrder, true, true>(ldsL, g, S, E);
    }
    PR_STAMP(9);
    if (PROBE_PHASE >= 0 && bx == 0) {
        asm volatile("s_waitcnt vmcnt(0)" ::: "memory"); __syncthreads();
        if (tid == 0) { int best = 0; float bv = 1e30f; for (int i = 0; i < 256; ++i) { const float a = fabsf(out[i]); if (a < bv) { bv = a; best = i; } }
            out[best] += 0.04f + pr_us / PROBE_SCALE; }
    }
#undef IN
#undef GRID_BAR
}

extern "C" void kernel_launch(void* const* d_in, const int* in_sizes, int n_in, void* d_out, int out_size, void* d_ws, size_t ws_size, hipStream_t stream) {
    static int grid = 0;
    if (grid == 0) {
        if (n_in != 23 || out_size != M * DM || ws_size < WS_END) { fprintf(stderr, "kernel_launch: unexpected shapes (n_in %d, out %d, ws %zu)\n", n_in, out_size, ws_size); grid = -1; return; }
        int dev = 0, cus = 0, per_cu = 0;
        if (hipGetDevice(&dev) != hipSuccess || hipDeviceGetAttribute(&cus, hipDeviceAttributeMultiprocessorCount, dev) != hipSuccess) { grid = -1; return; }
        if (hipFuncSetAttribute((const void*)mega_fwd, hipFuncAttributeMaxDynamicSharedMemorySize, LDS_BYTES) != hipSuccess) { fprintf(stderr, "kernel_launch: hipFuncSetAttribute failed\n"); grid = -1; return; }
        if (hipOccupancyMaxActiveBlocksPerMultiprocessor(&per_cu, (const void*)mega_fwd, NWAVES * 64, LDS_BYTES) != hipSuccess || per_cu < 1) { fprintf(stderr, "kernel_launch: occupancy query says %d\n", per_cu); (void)hipGetLastError(); per_cu = 1; }
        grid = cus * (per_cu < 1 ? 1 : 1);
    }
    if (grid < 0) return;
    (void)hipMemsetAsync((char*)d_ws + WS_CTL, 0, CTL_ZERO_BYTES, stream);
    Args a{};
    for (int i = 0; i < 23; ++i) a.in[i] = (const float*)d_in[i];
    a.out = (float*)d_out; a.ws = (unsigned char*)d_ws;
    if (N_LAUNCHES == 1) {
        a.ph_lo = 0; a.ph_hi = N_PHASES; a.one = 1;
        void* kargs[] = {&a};
        hipError_t e = hipLaunchCooperativeKernel((const void*)mega_fwd, dim3(grid), dim3(NWAVES * 64), kargs, LDS_BYTES, stream);
        if (e != hipSuccess) fprintf(stderr, "kernel_launch: cooperative launch failed: %s (grid %d)\n", hipGetErrorString(e), grid);
    } else {
        for (int p = 0; p < N_PHASES; ++p) { a.ph_lo = p; a.ph_hi = p + 1; a.one = 0;
            hipLaunchKernelGGL(mega_fwd, dim3(grid), dim3(NWAVES * 64), LDS_BYTES, stream, a); }
    }
}
```

```cpp
#include <hip/hip_runtime.h>
#include <cstdio>
#include <cstdint>

#ifndef MK_N_LAUNCHES
#define MK_N_LAUNCHES 1
#endif

namespace pg8 {
#define PG8_LAS __attribute__((address_space(3)))
typedef unsigned short bf16_t;
typedef short bf16x8 __attribute__((ext_vector_type(8)));
typedef float f32x4 __attribute__((ext_vector_type(4)));
typedef float f32x2 __attribute__((ext_vector_type(2)));
typedef unsigned u32x4 __attribute__((ext_vector_type(4)));
constexpr int BM = 256, BK = 64, HALF = 128, HTB = HALF * BK * 2, STAGE_BYTES = 8 * HTB, NXCD = 8, WGM = 8;

__host__ __device__ __forceinline__ int lds_byte(int r, int c) { const int st = (r >> 4) * 2 + (c >> 5), rr = r & 15, cc = c & 31, ob = rr * 64 + cc * 2; return st * 1024 + (ob ^ (((ob >> 9) & 1) << 5)); }
__host__ __device__ __forceinline__ void stage_rc(int b, int& R, int& C) { const int st = b / 1024, sb = b % 1024, swz = sb ^ (((sb >> 9) & 1) << 5); R = (st >> 1) * 16 + swz / 64; C = (st & 1) * 32 + (swz % 64) / 2; }
__host__ __device__ __forceinline__ int perm32(int rho) { const int n = rho >> 4, i = rho & 15; return 8 * (i >> 2) + 4 * n + (i & 3); }

struct Unit { int pm, pn; };
struct Gemm { const bf16_t* A; const bf16_t* Bt; int M, N, K; };

struct StaticOrder {
    int nM, nN, nwg, G, c;
    __host__ __device__ __forceinline__ void init(int M, int N, int G_, int c_) { nM = M / BM; nN = N / BM; nwg = nM * nN; G = G_; c = c_; }
    __host__ __device__ __forceinline__ bool next(int i, Unit& u) const {
        const long L = (long)i * G + c; if (L >= nwg) return false;
        int wgid = (int)L; { const int q = nwg / NXCD, r = nwg % NXCD, xcd = wgid % NXCD, off = wgid / NXCD; wgid = (xcd < r ? xcd * (q + 1) : r * (q + 1) + (xcd - r) * q) + off; }
        const int nig = WGM * nN, gid = wgid / nig, fm = gid * WGM, gsz = (nM - fm) < WGM ? (nM - fm) : WGM;
        u.pm = fm + ((wgid % nig) % gsz); u.pn = (wgid % nig) / gsz; return true;
    }
    __device__ __forceinline__ void a_ready(const Unit&) const {}
    __device__ __forceinline__ void done(const Unit&) const {}
};

__device__ __forceinline__ unsigned cvt_pk_bf16(float lo, float hi) { unsigned r; asm volatile("v_cvt_pk_bf16_f32 %0, %1, %2" : "=v"(r) : "v"(lo), "v"(hi)); return r; }
__device__ __forceinline__ float xsum_fq(float x) {
    { auto r = __builtin_amdgcn_permlane16_swap(__float_as_uint(x), __float_as_uint(x), false, false); x = __uint_as_float(r[0]) + __uint_as_float(r[1]); }
    { auto r = __builtin_amdgcn_permlane32_swap(__float_as_uint(x), __float_as_uint(x), false, false); x = __uint_as_float(r[0]) + __uint_as_float(r[1]); }
    return x;
}
__device__ __forceinline__ float bf_lo(unsigned w) { return __uint_as_float(w << 16); }
__device__ __forceinline__ float bf_hi(unsigned w) { return __uint_as_float(w & 0xffff0000u); }
__device__ __forceinline__ f32x2 gelu_pk(f32x2 v) {
    const f32x2 av = __builtin_elementwise_abs(v), d = av * 0.2316418882f + 1.0f;
    f32x2 t; t.x = __builtin_amdgcn_rcpf(d.x); t.y = __builtin_amdgcn_rcpf(d.y);
    f32x2 q = t * 0.5307027145f + (-0.7265760135f); q = q * t + 0.7107068705f; q = q * t + (-0.142248368f); q = q * t + 0.127414796f; q = q * t;
    const f32x2 s = (v * v) * (-0.72134752044f);
    f32x2 e; e.x = __builtin_amdgcn_exp2f(s.x); e.y = __builtin_amdgcn_exp2f(s.y);
    const f32x2 m = v * (q * e), r = v - m;
    f32x2 o; o.x = v.x < 0.f ? m.x : r.x; o.y = v.y < 0.f ? m.y : r.y; return o;
}
__device__ __forceinline__ float sigmoid_f(float x) { return __builtin_amdgcn_rcpf(1.0f + __builtin_amdgcn_exp2f(-1.4426950408889634f * x)); }
__device__ __forceinline__ f32x4 gelu4(f32x4 v) { f32x2 a = gelu_pk((f32x2){v[0], v[1]}), b = gelu_pk((f32x2){v[2], v[3]}); return (f32x4){a.x, a.y, b.x, b.y}; }
__device__ __forceinline__ f32x4 sigm4(f32x4 v) { return (f32x4){sigmoid_f(v[0]), sigmoid_f(v[1]), sigmoid_f(v[2]), sigmoid_f(v[3])}; }
__device__ __forceinline__ u32x4 pack8(f32x4 a, f32x4 b) { u32x4 w; w.x = cvt_pk_bf16(a[0], a[1]); w.y = cvt_pk_bf16(a[2], a[3]); w.z = cvt_pk_bf16(b[0], b[1]); w.w = cvt_pk_bf16(b[2], b[3]); return w; }

typedef f32x4 Acc[2][2][4][2];
#define EPI_LOOP_ROWS for (int ai = 0; ai < 2; ++ai) _Pragma("unroll") for (int m = 0; m < 4; ++m)

constexpr int ZLD = 9216;
struct EpiZ {
    static constexpr bool PERM = true, AFTER_DRAIN = false, MIDK = false;
    bf16_t* Z; float* vs1; float* vs2; const float* gq; const float* gk; PG8_LAS float* red;
    __device__ __forceinline__ void mid(Acc&, const Unit&, int, int, int, int) const {}
    __device__ __forceinline__ void operator()(const Acc& acc, const Unit& u, int wr, int wc, int fr, int fq) const {
        const int mode = u.pn < 8 ? 1 : (u.pn < 20 ? 0 : 2); const bool isv = (u.pn >= 4 && u.pn < 8);
        const int row0 = u.pm * BM + wr * 64 + fr, col0 = u.pn * BM + wc * 32 + 8 * fq;
        if (u.pn >= 8 && u.pn < 16) {
            const float* gn = u.pn < 12 ? gq : gk;
            const f32x4 g0 = *(const f32x4*)(gn + wc * 32 + 8 * fq), g1 = *(const f32x4*)(gn + wc * 32 + 8 * fq + 4);
#pragma unroll
            EPI_LOOP_ROWS {
#pragma unroll
                for (int bj = 0; bj < 2; ++bj) { const f32x4 v0 = acc[ai][bj][m][0], v1 = acc[ai][bj][m][1];
                    float q2 = (v0[0] * v0[0] + v0[1] * v0[1]) + (v0[2] * v0[2] + v0[3] * v0[3]) + (v1[0] * v1[0] + v1[1] * v1[1]) + (v1[2] * v1[2] + v1[3] * v1[3]);
                    q2 = xsum_fq(q2);
                    if (fq == 0) red[(ai * HALF + wr * 64 + m * 16 + fr) * 8 + bj * 4 + wc] = q2; } }
            asm volatile("s_waitcnt lgkmcnt(0)" ::: "memory"); __builtin_amdgcn_s_barrier(); asm volatile("" ::: "memory");
#pragma unroll
            EPI_LOOP_ROWS { bf16_t* rowp = Z + (size_t)(row0 + ai * HALF + m * 16) * ZLD + col0;
#pragma unroll
                for (int bj = 0; bj < 2; ++bj) { const f32x4 p = *(const PG8_LAS f32x4*)(red + (ai * HALF + wr * 64 + m * 16 + fr) * 8 + bj * 4);
                    const float r = 1.0f / sqrtf(((p[0] + p[1]) + (p[2] + p[3])) * (1.0f / 128.0f) + 1e-6f);
                    *(u32x4*)(rowp + bj * HALF) = pack8(acc[ai][bj][m][0] * r * g0, acc[ai][bj][m][1] * r * g1); } }
            return;
        }
        if (mode == 2) {
#pragma unroll
            EPI_LOOP_ROWS { bf16_t* rowp = Z + (size_t)(row0 + ai * HALF + m * 16) * ZLD + col0;
                f32x4 rt[2], sb[2];
#pragma unroll
                for (int n = 0; n < 2; ++n) { const f32x4 ga = acc[ai][0][m][n] * (-1.4426950408889634f), gb = acc[ai][1][m][n] * (-1.4426950408889634f);
#pragma unroll
                    for (int i = 0; i < 4; ++i) { const float da = 1.0f + __builtin_amdgcn_exp2f(ga[i]), db = 1.0f + __builtin_amdgcn_exp2f(gb[i]);
                        sb[n][i] = __builtin_amdgcn_rcpf(db); rt[n][i] = db * __builtin_amdgcn_rcpf(da); } }
                *(u32x4*)rowp = pack8(rt[0], rt[1]); *(u32x4*)(rowp + HALF) = pack8(sb[0], sb[1]); }
            return;
        }
#pragma unroll
        EPI_LOOP_ROWS { bf16_t* rowp = Z + (size_t)(row0 + ai * HALF + m * 16) * ZLD + col0;
            float s1 = 0.f, s2 = 0.f;
#pragma unroll
            for (int bj = 0; bj < 2; ++bj) { f32x4 v0 = acc[ai][bj][m][0], v1 = acc[ai][bj][m][1];
                if (mode == 1) { v0 = gelu4(v0); v1 = gelu4(v1); } else if (mode == 2) { v0 = sigm4(v0); v1 = sigm4(v1); }
                if (isv) { s1 += (v0[0] + v0[1]) + (v0[2] + v0[3]) + (v1[0] + v1[1]) + (v1[2] + v1[3]);
                           s2 += (v0[0] * v0[0] + v0[1] * v0[1]) + (v0[2] * v0[2] + v0[3] * v0[3]) + (v1[0] * v1[0] + v1[1] * v1[1]) + (v1[2] * v1[2] + v1[3] * v1[3]); }
                *(u32x4*)(rowp + bj * HALF) = pack8(v0, v1); }
            if (isv) { s1 = xsum_fq(s1); s2 = xsum_fq(s2);
                       if (fq == 0) { atomicAdd(vs1 + row0 + ai * HALF + m * 16, s1); atomicAdd(vs2 + row0 + ai * HALF + m * 16, s2); } } }
    }
};
struct EpiY {
    static constexpr bool PERM = true, AFTER_DRAIN = false, MIDK = true;
    const bf16_t* Z; bf16_t* Y;
    __device__ __forceinline__ void mid(Acc& acc, const Unit& u, int wr, int wc, int fr, int fq) const {
        int opq; asm volatile("v_mov_b32 %0, 0" : "=v"(opq));
        const int row0 = u.pm * BM + wr * 64 + fr + opq, gc0 = 5120 + u.pn * 512 + wc * 32 + 8 * fq;
#pragma unroll
        EPI_LOOP_ROWS { const bf16_t* rowp = Z + (size_t)(row0 + ai * HALF + m * 16) * ZLD + gc0;
#pragma unroll
            for (int bj = 0; bj < 2; ++bj) { const u32x4 a = *(const u32x4*)(rowp + bj * 256);
                acc[ai][bj][m][0] *= (f32x4){bf_lo(a.x), bf_hi(a.x), bf_lo(a.y), bf_hi(a.y)}; acc[ai][bj][m][1] *= (f32x4){bf_lo(a.z), bf_hi(a.z), bf_lo(a.w), bf_hi(a.w)}; }
            if (m & 1) asm volatile("" ::: "memory"); }
    }
    __device__ __forceinline__ void operator()(const Acc& acc, const Unit& u, int wr, int wc, int fr, int fq) const {
        int opq; asm volatile("v_mov_b32 %0, 0" : "=v"(opq));
        const int row0 = u.pm * BM + wr * 64 + fr + opq, col0 = u.pn * BM + wc * 32 + 8 * fq, gc0 = 5120 + u.pn * 512 + wc * 32 + 8 * fq + 128;
#pragma unroll
        EPI_LOOP_ROWS { const int row = row0 + ai * HALF + m * 16; const bf16_t* rowp = Z + (size_t)row * ZLD + gc0;
#pragma unroll
            for (int bj = 0; bj < 2; ++bj) { const u32x4 b = *(const u32x4*)(rowp + bj * 256);
                const f32x4 s0 = (f32x4){bf_lo(b.x), bf_hi(b.x), bf_lo(b.y), bf_hi(b.y)}, s1 = (f32x4){bf_lo(b.z), bf_hi(b.z), bf_lo(b.w), bf_hi(b.w)};
                *(u32x4*)(Y + (size_t)row * 2048 + col0 + bj * HALF) = pack8(acc[ai][bj][m][0] * s0, acc[ai][bj][m][1] * s1); }
            if (m & 1) asm volatile("" ::: "memory"); }
    }
};
template <bool BASE_F32> struct EpiRes {
    static constexpr bool PERM = true, AFTER_DRAIN = false, MIDK = false;
    const void* base; bf16_t* xn; float* ssq;
    __device__ __forceinline__ void mid(Acc&, const Unit&, int, int, int, int) const {}
    __device__ __forceinline__ void operator()(const Acc& acc, const Unit& u, int wr, int wc, int fr, int fq) const {
        const int row0 = u.pm * BM + wr * 64 + fr, col0 = u.pn * BM + wc * 32 + 8 * fq;
#pragma unroll
        EPI_LOOP_ROWS { const int row = row0 + ai * HALF + m * 16; const size_t off = (size_t)row * 2048 + col0; float s = 0.f;
#pragma unroll
            for (int bj = 0; bj < 2; ++bj) { f32x4 b0, b1;
                if (BASE_F32) { b0 = __builtin_nontemporal_load((const f32x4*)((const float*)base + off + bj * HALF)); b1 = __builtin_nontemporal_load((const f32x4*)((const float*)base + off + bj * HALF + 4)); }
                else { const u32x4 w = *(const u32x4*)((const bf16_t*)base + off + bj * HALF); b0 = (f32x4){bf_lo(w.x), bf_hi(w.x), bf_lo(w.y), bf_hi(w.y)}; b1 = (f32x4){bf_lo(w.z), bf_hi(w.z), bf_lo(w.w), bf_hi(w.w)}; }
                const f32x4 x0 = b0 + acc[ai][bj][m][0], x1 = b1 + acc[ai][bj][m][1];
                s += (x0[0] * x0[0] + x0[1] * x0[1]) + (x0[2] * x0[2] + x0[3] * x0[3]) + (x1[0] * x1[0] + x1[1] * x1[1]) + (x1[2] * x1[2] + x1[3] * x1[3]);
                *(u32x4*)(xn + off + bj * HALF) = pack8(x0, x1); }
            s = xsum_fq(s);
            if (fq == 0) atomicAdd(ssq + row, s); }
    }
};
struct EpiUpConv {
    static constexpr bool PERM = true, AFTER_DRAIN = false, MIDK = false;
    bf16_t* HM; const float* ssq; const float* cw; const float* cb; float* HALO; float* FA; float* FB; PG8_LAS float* hl;
    __device__ __forceinline__ void mid(Acc&, const Unit&, int, int, int, int) const {}
    __device__ __forceinline__ static float gelu_t(float cv) { const float inner = cv + 0.044715f * cv * cv * cv; return cv * __builtin_amdgcn_rcpf(1.0f + __builtin_amdgcn_exp2f(-2.3022081986f * inner)); }
    __device__ __forceinline__ void operator()(const Acc& acc, const Unit& u, int wr, int wc, int fr, int fq) const {
        int opq; asm volatile("v_mov_b32 %0, 0" : "=v"(opq));
        const int lane = (int)(threadIdx.x & 63);
        const int cl = wc * 32 + 8 * fq, c0 = u.pn * 128 + cl + opq;
        const int rowg = u.pm * BM + wr * 64 + fr;
        float rr[2][4];
#pragma unroll
        for (int ai = 0; ai < 2; ++ai)
#pragma unroll
            for (int m = 0; m < 4; ++m) rr[ai][m] = 1.0f / sqrtf(ssq[rowg + ai * HALF + m * 16] * (1.0f / 2048.0f) + 1e-6f);
#pragma unroll
        for (int ai = 0; ai < 2; ++ai) if (fr >= 14) { const float r = rr[ai][3]; const f32x4 x0 = acc[ai][0][3][0] * r, x1 = acc[ai][0][3][1] * r;
            PG8_LAS float* d = hl + ((2 * ai + wr) * 2 + (fr - 14)) * 128 + cl; *(PG8_LAS f32x4*)d = x0; *(PG8_LAS f32x4*)(d + 4) = x1;
            if (ai == 1 && wr == 1) { float* gp = HALO + (size_t)(u.pm * 2 + (fr - 14)) * 5632 + c0; *(f32x4*)gp = x0; *(f32x4*)(gp + 4) = x1; } }
        if (wr == 0 && fr < 2) { const float r = rr[0][0]; float* ga = FA + (size_t)(u.pm * 2 + fr) * 5632 + c0; float* gb = FB + (size_t)(u.pm * 2 + fr) * 5632 + c0;
            *(f32x4*)ga = acc[0][0][0][0] * r; *(f32x4*)(ga + 4) = acc[0][0][0][1] * r; *(f32x4*)gb = acc[0][1][0][0] * r; *(f32x4*)(gb + 4) = acc[0][1][0][1] * r; }
        f32x2 w0[4], w1[4], w2[4], cbv[4];
        { const f32x4 a = *(const f32x4*)(cw + c0), b = *(const f32x4*)(cw + c0 + 4); w0[0] = (f32x2){a[0], a[1]}; w0[1] = (f32x2){a[2], a[3]}; w0[2] = (f32x2){b[0], b[1]}; w0[3] = (f32x2){b[2], b[3]}; }
        { const f32x4 a = *(const f32x4*)(cw + 5632 + c0), b = *(const f32x4*)(cw + 5632 + c0 + 4); w1[0] = (f32x2){a[0], a[1]}; w1[1] = (f32x2){a[2], a[3]}; w1[2] = (f32x2){b[0], b[1]}; w1[3] = (f32x2){b[2], b[3]}; }
        { const f32x4 a = *(const f32x4*)(cw + 11264 + c0), b = *(const f32x4*)(cw + 11264 + c0 + 4); w2[0] = (f32x2){a[0], a[1]}; w2[1] = (f32x2){a[2], a[3]}; w2[2] = (f32x2){b[0], b[1]}; w2[3] = (f32x2){b[2], b[3]}; }
        { const f32x4 a = *(const f32x4*)(cb + c0), b = *(const f32x4*)(cb + c0 + 4); cbv[0] = (f32x2){a[0], a[1]}; cbv[1] = (f32x2){a[2], a[3]}; cbv[2] = (f32x2){b[0], b[1]}; cbv[3] = (f32x2){b[2], b[3]}; }
        asm volatile("s_waitcnt lgkmcnt(0)" ::: "memory"); __builtin_amdgcn_s_barrier(); asm volatile("" ::: "memory");
        const bool f15 = fr == 15, f14 = fr >= 14;
#pragma unroll
        for (int ai = 0; ai < 2; ++ai) {
            f32x2 xp[4];
            { const int g = 2 * ai + wr;
              if (g > 0 && fr >= 14) { const PG8_LAS float* d = hl + ((g - 1) * 2 + (fr - 14)) * 128 + cl; const f32x4 h0 = *(const PG8_LAS f32x4*)d, h1 = *(const PG8_LAS f32x4*)(d + 4);
                  xp[0] = (f32x2){h0[0], h0[1]}; xp[1] = (f32x2){h0[2], h0[3]}; xp[2] = (f32x2){h1[0], h1[1]}; xp[3] = (f32x2){h1[2], h1[3]}; }
              else {
#pragma unroll
                  for (int j = 0; j < 4; ++j) xp[j] = (f32x2){0.f, 0.f}; } }
#pragma unroll
            for (int m = 0; m < 4; ++m) { const float r = rr[ai][m]; const int row = rowg + ai * HALF + m * 16;
                f32x2 o[4];
#pragma unroll
                for (int j = 0; j < 4; ++j) {
                    const f32x4 av = acc[ai][0][m][j >> 1], bv = acc[ai][1][m][j >> 1];
                    const f32x2 x = (f32x2){av[(j & 1) * 2], av[(j & 1) * 2 + 1]} * r, bb = (f32x2){bv[(j & 1) * 2], bv[(j & 1) * 2 + 1]} * r;
                    const f32x2 s1 = f15 ? xp[j] : x, s2 = f14 ? xp[j] : x;
                    f32x2 p1, p2;
                    p1.x = __int_as_float(__builtin_amdgcn_update_dpp(0, __float_as_int(s1.x), 0x121, 0xf, 0xf, false)); p1.y = __int_as_float(__builtin_amdgcn_update_dpp(0, __float_as_int(s1.y), 0x121, 0xf, 0xf, false));
                    p2.x = __int_as_float(__builtin_amdgcn_update_dpp(0, __float_as_int(s2.x), 0x122, 0xf, 0xf, false)); p2.y = __int_as_float(__builtin_amdgcn_update_dpp(0, __float_as_int(s2.y), 0x122, 0xf, 0xf, false));
                    const f32x2 cv = ((cbv[j] + w0[j] * p2) + w1[j] * p1) + w2[j] * x;
                    const f32x2 arg = (cv * (cv * cv * 0.044715f + 1.0f)) * (-2.3022081986f);
                    f32x2 e; e.x = __builtin_amdgcn_exp2f(arg.x); e.y = __builtin_amdgcn_exp2f(arg.y);
                    const f32x2 d = e + 1.0f; f32x2 rc; rc.x = __builtin_amdgcn_rcpf(d.x); rc.y = __builtin_amdgcn_rcpf(d.y);
                    o[j] = (cv * rc) * bb; xp[j] = x; }
                *(u32x4*)(HM + (size_t)row * 5632 + c0) = pack8((f32x4){o[0].x, o[0].y, o[1].x, o[1].y}, (f32x4){o[2].x, o[2].y, o[3].x, o[3].y}); }
        }
    }
};
struct EpiE {
    static constexpr bool PERM = true, AFTER_DRAIN = false, MIDK = false;
    bf16_t* O; float* ssq;
    __device__ __forceinline__ void mid(Acc&, const Unit&, int, int, int, int) const {}
    __device__ __forceinline__ void operator()(const Acc& acc, const Unit& u, int wr, int wc, int fr, int fq) const {
        const int row0 = u.pm * BM + wr * 64 + fr, col0 = u.pn * BM + wc * 32 + 8 * fq;
#pragma unroll
        EPI_LOOP_ROWS { const int row = row0 + ai * HALF + m * 16; float s = 0.f; bf16_t* rowp = O + (size_t)row * 2048 + col0;
#pragma unroll
            for (int bj = 0; bj < 2; ++bj) { const f32x4 x0 = acc[ai][bj][m][0], x1 = acc[ai][bj][m][1];
                s += (x0[0] * x0[0] + x0[1] * x0[1]) + (x0[2] * x0[2] + x0[3] * x0[3]) + (x1[0] * x1[0] + x1[1] * x1[1]) + (x1[2] * x1[2] + x1[3] * x1[3]);
                *(u32x4*)(rowp + bj * HALF) = pack8(x0, x1); }
            s = xsum_fq(s);
            if (fq == 0) atomicAdd(ssq + row, s); }
    }
};
struct EpiFinal {
    static constexpr bool PERM = true, AFTER_DRAIN = false, MIDK = false;
    float* out; const bf16_t* xb; const bf16_t* E; const float* gp; const float* ssq2; const float* ssqE;
    __device__ __forceinline__ void mid(Acc&, const Unit&, int, int, int, int) const {}
    __device__ __forceinline__ void operator()(const Acc& acc, const Unit& u, int wr, int wc, int fr, int fq) const {
        const int row0 = u.pm * BM + wr * 64 + fr, col0 = u.pn * BM + wc * 32 + 8 * fq;
        f32x4 gv[2][2];
#pragma unroll
        for (int bj = 0; bj < 2; ++bj) { gv[bj][0] = *(const f32x4*)(gp + col0 + bj * HALF); gv[bj][1] = *(const f32x4*)(gp + col0 + bj * HALF + 4); }
#pragma unroll
        EPI_LOOP_ROWS { const int row = row0 + ai * HALF + m * 16; const size_t off = (size_t)row * 2048 + col0;
            const float r2 = 1.0f / sqrtf(ssq2[row] * (1.0f / 2048.0f) + 1e-6f), rE = 1.0f / sqrtf(ssqE[row] * (1.0f / 2048.0f) + 1e-6f);
#pragma unroll
            for (int bj = 0; bj < 2; ++bj) { const u32x4 xw = *(const u32x4*)(xb + off + bj * HALF);
                const f32x4 b0 = (f32x4){bf_lo(xw.x), bf_hi(xw.x), bf_lo(xw.y), bf_hi(xw.y)}, b1 = (f32x4){bf_lo(xw.z), bf_hi(xw.z), bf_lo(xw.w), bf_hi(xw.w)};
                const u32x4 e = *(const u32x4*)(E + off + bj * HALF);
                const f32x4 e0 = (f32x4){bf_lo(e.x), bf_hi(e.x), bf_lo(e.y), bf_hi(e.y)}, e1 = (f32x4){bf_lo(e.z), bf_hi(e.z), bf_lo(e.w), bf_hi(e.w)};
                const f32x4 g0 = sigm4(acc[ai][bj][m][0] * r2), g1 = sigm4(acc[ai][bj][m][1] * r2);
                __builtin_nontemporal_store(b0 + g0 * (e0 * rE * gv[bj][0]), (f32x4*)(out + off + bj * HALF)); __builtin_nontemporal_store(b1 + g1 * (e1 * rE * gv[bj][1]), (f32x4*)(out + off + bj * HALF + 4)); } }
    }
};

template <class Epi, class Sched, bool ALIGN_EPI = false, bool SP2 = false>
__device__ __forceinline__ void gemm_phase(PG8_LAS unsigned char* lds, const Gemm g, const Sched& S, const Epi& E) {
    const int tid = threadIdx.x, wid = __builtin_amdgcn_readfirstlane(tid >> 6), lane = tid & 63, wr = wid >> 2, wc = wid & 3, fr = lane & 15, fq = lane >> 4;
    const int K = g.K, nt = K / BK;
    unsigned voffA[2], voffB[2];
#pragma unroll
    for (int i = 0; i < 2; ++i) { int R, C; stage_rc(tid * 16 + i * 8192, R, C); const int Rb = Epi::PERM ? ((R & ~31) + perm32(R & 31)) : R;
        voffA[i] = (unsigned)(R * K + C) * 2u; voffB[i] = (unsigned)(Rb * K + C) * 2u; }
    const size_t kstep = (size_t)(BK * 2);
    const size_t hstep = (size_t)HALF * K * 2;
    const size_t tstep = 2 * hstep;
    const unsigned ldsw = (unsigned)wid * 1024u;
    const int aoff = lds_byte(wr * 64 + fr, fq * 8), boff = lds_byte(wc * 32 + fr, fq * 8);
#define PG8_SA(b, h) (((b) * 2 + (h)) * HTB)
#define PG8_SB(b, h) ((4 + (b) * 2 + (h)) * HTB)
#define PG8_STAGE(bufoff, gbase, voff) do { _Pragma("unroll") for (int _i = 0; _i < 2; ++_i) \
        __builtin_amdgcn_global_load_lds((const unsigned*)((const char*)(gbase) + (voff)[_i]), (PG8_LAS unsigned*)(lds + (bufoff) + ldsw + _i * 8192), 16, 0, 0); } while (0)
#define PG8_LDA(dst, b, h) do { _Pragma("unroll") for (int m = 0; m < 4; ++m) _Pragma("unroll") for (int k = 0; k < 2; ++k) dst[m][k] = *(const PG8_LAS bf16x8*)(lds + PG8_SA(b, h) + aoff + m * 2048 + k * 1024); } while (0)
#define PG8_LDB(dst, b, h) do { _Pragma("unroll") for (int n = 0; n < 2; ++n) _Pragma("unroll") for (int k = 0; k < 2; ++k) dst[n][k] = *(const PG8_LAS bf16x8*)(lds + PG8_SB(b, h) + boff + n * 2048 + k * 1024); } while (0)
#define PG8_MMA(ai, bj, At, Bt) do { __builtin_amdgcn_s_setprio(1); _Pragma("unroll") for (int m = 0; m < 4; ++m) _Pragma("unroll") for (int n = 0; n < 2; ++n) _Pragma("unroll") for (int k = 0; k < 2; ++k) \
        acc[ai][bj][m][n] = __builtin_amdgcn_mfma_f32_16x16x32_bf16(Bt[n][k], At[m][k], acc[ai][bj][m][n], 0, 0, 0); __builtin_amdgcn_s_setprio(0); } while (0)
#define PG8_WAIT_V(n) asm volatile("s_waitcnt vmcnt(" #n ")" ::: "memory")
#define PG8_WAIT_L(n) asm volatile("s_waitcnt lgkmcnt(" #n ")" ::: "memory")
#define PG8_BAR __builtin_amdgcn_s_barrier()
#define PG8_SCHED __builtin_amdgcn_sched_barrier(0)
    Unit cur, nxt; int ui = 0;
    if (!S.next(0, cur)) return;
    f32x4 acc[2][2][4][2];
#pragma unroll
    for (int a = 0; a < 2; ++a)
#pragma unroll
        for (int b = 0; b < 2; ++b)
#pragma unroll
            for (int m = 0; m < 4; ++m)
#pragma unroll
                for (int n = 0; n < 2; ++n) acc[a][b][m][n] = (f32x4){0.f, 0.f, 0.f, 0.f};
    bf16x8 At[4][2], B0[2][2], B1[2][2];
    const char* cA = (const char*)g.A + (size_t)cur.pm * tstep; const char* cB = (const char*)g.Bt + (size_t)cur.pn * tstep;
    S.a_ready(cur);
    if constexpr (SP2) {
        PG8_STAGE(PG8_SB(0, 0), cB, voffB); PG8_STAGE(PG8_SB(0, 1), cB + hstep, voffB); PG8_STAGE(PG8_SA(0, 0), cA, voffA); PG8_STAGE(PG8_SA(0, 1), cA + hstep, voffA);
        if (wr == 1) PG8_BAR;
        PG8_WAIT_V(2); PG8_BAR;
        PG8_STAGE(PG8_SB(1, 0), cB + kstep, voffB); PG8_STAGE(PG8_SA(1, 0), cA + kstep, voffA); PG8_STAGE(PG8_SB(1, 1), cB + hstep + kstep, voffB);
        PG8_WAIT_V(6); PG8_BAR;
    } else {
        PG8_STAGE(PG8_SB(0, 0), cB, voffB); PG8_STAGE(PG8_SA(0, 0), cA, voffA); PG8_STAGE(PG8_SB(0, 1), cB + hstep, voffB); PG8_STAGE(PG8_SA(0, 1), cA + hstep, voffA);
        if (wr == 1) PG8_BAR;
        PG8_WAIT_V(4); PG8_BAR;
        PG8_STAGE(PG8_SB(1, 0), cB + kstep, voffB); PG8_STAGE(PG8_SA(1, 0), cA + kstep, voffA); PG8_STAGE(PG8_SB(1, 1), cB + hstep + kstep, voffB);
        PG8_WAIT_V(6); PG8_BAR;
    }
    for (;;) {
        const bool has_next = S.next(ui + 1, nxt);
        const char* nA = has_next ? (const char*)g.A + (size_t)nxt.pm * tstep : cA; const char* nB = has_next ? (const char*)g.Bt + (size_t)nxt.pn * tstep : cB;
        constexpr int NSEG = Epi::MIDK ? 2 : 1;
#pragma unroll 1
        for (int seg = 0; seg < NSEG; ++seg) {
        if constexpr (Epi::MIDK) { if (seg == 1) E.mid(acc, cur, wr, wc, fr, fq); }
        const int t_hi = (NSEG == 2 && seg == 0) ? (nt >> 1) : nt;
#pragma unroll 1
        for (int t = (NSEG == 2 && seg == 1) ? (nt >> 1) : 0; t < t_hi; t += 2) {
            const bool last = (t == nt - 2);
            const char* a1 = cA + (size_t)(t + 1) * kstep;
            const char* a2 = last ? nA : cA + (size_t)(t + 2) * kstep; const char* b2 = last ? nB : cB + (size_t)(t + 2) * kstep;
            const char* a3 = a2 + kstep; const char* b3 = b2 + kstep;
            if (last && has_next) S.a_ready(nxt);
            if constexpr (SP2) {
            PG8_LDB(B0, 0, 0); PG8_LDB(B1, 0, 1); PG8_SCHED; PG8_LDA(At, 0, 0); PG8_STAGE(PG8_SA(1, 1), a1 + hstep, voffA);
            PG8_WAIT_V(8); PG8_WAIT_L(0); PG8_BAR; PG8_MMA(0, 0, At, B0); PG8_MMA(0, 1, At, B1); PG8_BAR; PG8_SCHED;
            PG8_LDA(At, 0, 1); PG8_STAGE(PG8_SB(0, 0), b2, voffB); PG8_STAGE(PG8_SB(0, 1), b2 + hstep, voffB); PG8_STAGE(PG8_SA(0, 0), a2, voffA);
            PG8_WAIT_V(8); PG8_WAIT_L(0); PG8_BAR; PG8_MMA(1, 0, At, B0); PG8_MMA(1, 1, At, B1); PG8_BAR; PG8_SCHED;
            PG8_LDB(B0, 1, 0); PG8_LDB(B1, 1, 1); PG8_SCHED; PG8_LDA(At, 1, 0); PG8_STAGE(PG8_SA(0, 1), a2 + hstep, voffA);
            PG8_WAIT_V(8); PG8_WAIT_L(0); PG8_BAR; PG8_MMA(0, 0, At, B0); PG8_MMA(0, 1, At, B1); PG8_BAR; PG8_SCHED;
            PG8_LDA(At, 1, 1); PG8_STAGE(PG8_SB(1, 0), b3, voffB); PG8_STAGE(PG8_SB(1, 1), b3 + hstep, voffB); PG8_STAGE(PG8_SA(1, 0), a3, voffA);
            PG8_WAIT_V(8); PG8_WAIT_L(0); PG8_BAR; PG8_MMA(1, 0, At, B0); PG8_MMA(1, 1, At, B1); PG8_BAR; PG8_SCHED;
            } else {
            PG8_LDB(B0, 0, 0); PG8_SCHED; PG8_LDA(At, 0, 0); PG8_STAGE(PG8_SA(1, 1), a1 + hstep, voffA);
            PG8_WAIT_L(8); PG8_BAR; PG8_WAIT_L(0); PG8_MMA(0, 0, At, B0); PG8_BAR; PG8_SCHED;
            PG8_LDB(B1, 0, 1); PG8_STAGE(PG8_SB(0, 0), b2, voffB);
            PG8_BAR; PG8_WAIT_L(0); PG8_MMA(0, 1, At, B1); PG8_BAR;
            PG8_LDA(At, 0, 1); PG8_STAGE(PG8_SA(0, 0), a2, voffA);
            PG8_BAR; PG8_WAIT_L(0); PG8_MMA(1, 0, At, B0); PG8_BAR; PG8_SCHED;
            PG8_STAGE(PG8_SB(0, 1), b2 + hstep, voffB);
            PG8_WAIT_V(6); PG8_BAR; PG8_MMA(1, 1, At, B1); PG8_BAR;
            PG8_LDB(B0, 1, 0); PG8_SCHED; PG8_LDA(At, 1, 0); PG8_STAGE(PG8_SA(0, 1), a2 + hstep, voffA);
            PG8_WAIT_L(8); PG8_BAR; PG8_WAIT_L(0); PG8_MMA(0, 0, At, B0); PG8_BAR; PG8_SCHED;
            PG8_LDB(B1, 1, 1); PG8_STAGE(PG8_SB(1, 0), b3, voffB);
            PG8_BAR; PG8_WAIT_L(0); PG8_MMA(0, 1, At, B1); PG8_BAR;
            PG8_LDA(At, 1, 1); PG8_STAGE(PG8_SA(1, 0), a3, voffA);
            PG8_BAR; PG8_WAIT_L(0); PG8_MMA(1, 0, At, B0); PG8_BAR; PG8_SCHED;
            PG8_STAGE(PG8_SB(1, 1), b3 + hstep, voffB);
            PG8_WAIT_V(6); PG8_BAR; PG8_MMA(1, 1, At, B1); PG8_BAR;
            }
        }
        }
        if constexpr (ALIGN_EPI) { if (wr == 0) PG8_BAR; }
        if constexpr (!Epi::AFTER_DRAIN) { E(acc, cur, wr, wc, fr, fq); S.done(cur); }
        if (!has_next) break;
#pragma unroll
        for (int a = 0; a < 2; ++a)
#pragma unroll
            for (int b = 0; b < 2; ++b)
#pragma unroll
                for (int m = 0; m < 4; ++m)
#pragma unroll
                    for (int n = 0; n < 2; ++n) acc[a][b][m][n] = (f32x4){0.f, 0.f, 0.f, 0.f};
        cur = nxt; cA = nA; cB = nB; ++ui;
        if constexpr (ALIGN_EPI) { if (wr == 1) PG8_BAR; }
    }
    PG8_WAIT_V(0);
    if constexpr (!ALIGN_EPI) { if (wr == 0) PG8_BAR; }
    PG8_BAR;
#undef PG8_SA
#undef PG8_SB
#undef PG8_STAGE
#undef PG8_LDA
#undef PG8_LDB
#undef PG8_MMA
#undef PG8_WAIT_V
#undef PG8_WAIT_L
#undef PG8_BAR
#undef PG8_SCHED
}
}

namespace fox {
typedef unsigned short bf16_t;
typedef short bf16x8 __attribute__((ext_vector_type(8)));
typedef short s16x4 __attribute__((ext_vector_type(4)));
typedef float f32x16 __attribute__((ext_vector_type(16)));
typedef float f32x4 __attribute__((ext_vector_type(4)));
typedef unsigned u32x4 __attribute__((ext_vector_type(4)));
constexpr int D = 128, NW = 8, QBLK = 32, KVBLK = 64, QB = NW * QBLK;
constexpr int SHM_V = KVBLK * D * 2, SHM_K = KVBLK * D * 2;
constexpr int LDS_WS = 2 * SHM_V + 2 * SHM_K;
constexpr int LDS_CUM = LDS_WS + NW * 64 * 4;
constexpr int LDS_BYTES = LDS_CUM + 2048 * 4;
constexpr int QS = 9216, OS = 2048;
constexpr float SCALE = 0.08838834764831845f;
constexpr float THR = 8.f;
constexpr unsigned WBIG = 0x40000000u;

#define KSWZ(row, colB) ((row) * 256 + ((colB) ^ (((row) & 7) << 4)))
#define SBAR() __builtin_amdgcn_sched_barrier(0)
__device__ __forceinline__ int v_st(int k, int c) { const int kk = (k & ~0xC) | ((k & 4) << 1) | ((k & 8) >> 1); return ((kk >> 3) * 4 + (c >> 5)) * 512 + ((kk & 7) * 32 + (c & 31)) * 2; }
__device__ __forceinline__ int v_rd_base(int lane) { return ((lane & 3) << 3) | (((lane >> 2) & 3) << 6) | (((lane >> 4) & 1) << 5) | (((lane >> 5) & 1) << 8); }
constexpr int v_rd_off(int d0, int ks, int half) { return d0 * 512 + ks * 4096 + half * 2048; }
__device__ __forceinline__ int crow(int r, int hi) { return (r & 3) + 8 * (r >> 2) + 4 * hi; }
__device__ __forceinline__ unsigned cvtpk(float lo, float hi) { unsigned r; asm volatile("v_cvt_pk_bf16_f32 %0, %1, %2" : "=v"(r) : "v"(lo), "v"(hi)); return r; }
__device__ __forceinline__ bf16x8 load8(const bf16_t* p) { return *reinterpret_cast<const bf16x8*>(p); }
__device__ __forceinline__ void mask_tile(f32x16& p0, f32x16& p1, int dq) {
    const float NEG = -__builtin_inff();
#pragma unroll
    for (int r = 0; r < 16; ++r) {
        const int c = (r & 3) + 8 * (r >> 2);
        if ((unsigned)(dq - c) >= WBIG) p0[r] = NEG;
        if ((unsigned)(dq - c - 32) >= WBIG) p1[r] = NEG;
    }
}
__device__ __forceinline__ void partialSM(f32x16& p0, f32x16& p1, float& m_reg, float& mn, float& alpha) {
    float pmax = p0[0]; for (int r = 1; r < 16; ++r) pmax = fmaxf(pmax, p0[r]); for (int r = 0; r < 16; ++r) pmax = fmaxf(pmax, p1[r]);
    { auto rr = __builtin_amdgcn_permlane32_swap(__float_as_uint(pmax), __float_as_uint(pmax), false, false);
      pmax = fmaxf(__uint_as_float(rr[0]), __uint_as_float(rr[1])); }
    constexpr float C2 = 1.4426950408889634f * SCALE;
    if (__builtin_expect(__all((pmax - m_reg) * SCALE <= THR), 1)) { mn = m_reg; alpha = 1.f; }
    else { mn = fmaxf(m_reg, pmax); alpha = __builtin_amdgcn_exp2f((m_reg - mn) * C2); m_reg = mn; }
    const float mnL = -mn * C2;
    for (int r = 0; r < 16; ++r) p0[r] = fmaf(p0[r], C2, mnL); for (int r = 0; r < 16; ++r) p1[r] = fmaf(p1[r], C2, mnL);
    for (int r = 0; r < 16; ++r) p0[r] = __builtin_amdgcn_exp2f(p0[r]);
}
__device__ __forceinline__ void finishSM(f32x16& p0, f32x16& p1, float alpha, float& l_reg, bf16x8& pa0, bf16x8& pa1, bf16x8& pa2, bf16x8& pa3) {
    for (int r = 0; r < 16; ++r) p1[r] = __builtin_amdgcn_exp2f(p1[r]);
    float ps = 0; for (int r = 0; r < 16; ++r) ps += p0[r]; for (int r = 0; r < 16; ++r) ps += p1[r];
    { auto rr = __builtin_amdgcn_permlane32_swap(__float_as_uint(ps), __float_as_uint(ps), false, false);
      ps = __uint_as_float(rr[0]) + __uint_as_float(rr[1]); }
    l_reg = l_reg * alpha + ps;
#define PK4(P, B_, OUT) do { unsigned a0 = cvtpk(P[B_+0], P[B_+1]), a1 = cvtpk(P[B_+2], P[B_+3]);                          \
        unsigned b0 = cvtpk(P[B_+4], P[B_+5]), b1 = cvtpk(P[B_+6], P[B_+7]);                                             \
        auto r0 = __builtin_amdgcn_permlane32_swap(a0, b0, false, false); auto r1 = __builtin_amdgcn_permlane32_swap(a1, b1, false, false); \
        u32x4 w = {r0[0], r1[0], r0[1], r1[1]}; OUT = *reinterpret_cast<bf16x8*>(&w); } while (0)
    PK4(p0, 0, pa0); PK4(p0, 8, pa1); PK4(p1, 0, pa2); PK4(p1, 8, pa3);
#undef PK4
}
template <int KB>
__device__ __forceinline__ void qkt(f32x16& p0, f32x16& p1, const char* K_lds, int r32, int hi, const bf16x8* qr, const float* cl) {
#pragma unroll
    for (int g = 0; g < 4; ++g) { const f32x4 c0 = *(const f32x4*)(cl + 8 * g), c1 = *(const f32x4*)(cl + 32 + 8 * g);
#pragma unroll
        for (int i = 0; i < 4; ++i) { p0[4 * g + i] = c0[i]; p1[4 * g + i] = c1[i]; } }
    const char* kb[4];
#pragma unroll
    for (int dd = 0; dd < 4; ++dd) kb[dd] = K_lds + KB * SHM_K + KSWZ(r32, (dd * 16 + hi * 8) * 2);
#pragma unroll
    for (int d0 = 0; d0 < 8; ++d0) { const char* a = kb[d0 & 3] + (d0 >> 2) * 128;
        bf16x8 b0 = *reinterpret_cast<const bf16x8*>(a);
        bf16x8 b1 = *reinterpret_cast<const bf16x8*>(a + 32 * 256);
        p0 = __builtin_amdgcn_mfma_f32_32x32x16_bf16(b0, qr[d0], p0, 0, 0, 0);
        p1 = __builtin_amdgcn_mfma_f32_32x32x16_bf16(b1, qr[d0], p1, 0, 0, 0); }
}
#define TRRD(dst, base, off) asm volatile("ds_read_b64_tr_b16 %0, %1 offset:%2" : "=&v"(dst) : "v"(base), "i"(off) : "memory")
template <int VB>
__device__ __forceinline__ void pv_tile(f32x16* o, int vb0, bf16x8 pa0, bf16x8 pa1, bf16x8 pa2, bf16x8 pa3) {
#define PV_D0(d0) do { s16x4 l0, l1, l2, l3, h0, h1, h2, h3; constexpr int b_ = VB * SHM_V + v_rd_off(d0, 0, 0); \
        TRRD(l0, vb0, b_); TRRD(h0, vb0, b_ + 2048); TRRD(l1, vb0, b_ + 4096); TRRD(h1, vb0, b_ + 6144); TRRD(l2, vb0, b_ + 8192); TRRD(h2, vb0, b_ + 10240); TRRD(l3, vb0, b_ + 12288); TRRD(h3, vb0, b_ + 14336); \
        asm volatile("s_waitcnt lgkmcnt(0)" ::: "memory"); SBAR();   \
        o[d0] = __builtin_amdgcn_mfma_f32_32x32x16_bf16(pa0, (bf16x8){l0[0], l0[1], l0[2], l0[3], h0[0], h0[1], h0[2], h0[3]}, o[d0], 0, 0, 0);   \
        o[d0] = __builtin_amdgcn_mfma_f32_32x32x16_bf16(pa1, (bf16x8){l1[0], l1[1], l1[2], l1[3], h1[0], h1[1], h1[2], h1[3]}, o[d0], 0, 0, 0);   \
        o[d0] = __builtin_amdgcn_mfma_f32_32x32x16_bf16(pa2, (bf16x8){l2[0], l2[1], l2[2], l2[3], h2[0], h2[1], h2[2], h2[3]}, o[d0], 0, 0, 0);   \
        o[d0] = __builtin_amdgcn_mfma_f32_32x32x16_bf16(pa3, (bf16x8){l3[0], l3[1], l3[2], l3[3], h3[0], h3[1], h3[2], h3[3]}, o[d0], 0, 0, 0); } while (0)
    PV_D0(0); PV_D0(1); PV_D0(2); PV_D0(3);
#undef PV_D0
}

struct BlockRef { const bf16_t* Q; const bf16_t* K; const bf16_t* V; bf16_t* O; int P0; };
struct Seam { bf16x8 qr[8]; bf16x8 st_v0, st_v1, st_k0, st_k1; };
#define ROW(p, k0, rr) ((p) + (size_t)((k0) + (rr)) * QS + sc)
#define VMW() asm volatile("s_waitcnt vmcnt(0)" ::: "memory")
#define VMWN(n) asm volatile("s_waitcnt vmcnt(%0)" :: "i"(n) : "memory")
#define SLOAD_H(Kp, Vp, k0) do { S.st_v0 = load8(ROW(Vp, k0, sr)); S.st_v1 = load8(ROW(Vp, k0, 32 + sr));              \
                         S.st_k0 = load8(ROW(Kp, k0, sr)); S.st_k1 = load8(ROW(Kp, k0, 32 + sr)); } while (0)
__device__ __forceinline__ bf16x8 knorm8(bf16x8 kv) {
    const u32x4 w = __builtin_bit_cast(u32x4, kv);
    float x[8] = {__uint_as_float(w.x << 16), __uint_as_float(w.x & 0xffff0000u), __uint_as_float(w.y << 16), __uint_as_float(w.y & 0xffff0000u),
                  __uint_as_float(w.z << 16), __uint_as_float(w.z & 0xffff0000u), __uint_as_float(w.w << 16), __uint_as_float(w.w & 0xffff0000u)};
    float s = 0.f;
#pragma unroll
    for (int i = 0; i < 8; ++i) s += x[i] * x[i];
    s += __shfl_xor(s, 1); s += __shfl_xor(s, 2); s += __shfl_xor(s, 4); s += __shfl_xor(s, 8);
    const float r = 1.0f / sqrtf(s * (1.0f / 128.0f) + 1e-6f);
    u32x4 o; o.x = cvtpk(x[0] * r, x[1] * r); o.y = cvtpk(x[2] * r, x[3] * r); o.z = cvtpk(x[4] * r, x[5] * r); o.w = cvtpk(x[6] * r, x[7] * r);
    return __builtin_bit_cast(bf16x8, o);
}
#define SWRITE_HK(bf) do { *(bf16x8*)(K_lds + (bf) * SHM_K + kws) = S.st_k0; *(bf16x8*)(K_lds + (bf) * SHM_K + kws + 32 * 256) = S.st_k1; } while (0)
#define SWRITE_HV(bf) do { *(bf16x8*)(V_lds + (bf) * SHM_V + vst0) = S.st_v0; *(bf16x8*)(V_lds + (bf) * SHM_V + vst1) = S.st_v1; } while (0)
#define SWRITE_H(bf) do { SWRITE_HV(bf); SWRITE_HK(bf); } while (0)
__device__ __forceinline__ void qnorm(bf16x8* qr, const float* gq, const float* gk, int hi) {
    float s = 0.f;
#pragma unroll
    for (int d0 = 0; d0 < 8; ++d0) { const u32x4 w = __builtin_bit_cast(u32x4, qr[d0]);
        const float a0 = __uint_as_float(w.x << 16), a1 = __uint_as_float(w.x & 0xffff0000u), a2 = __uint_as_float(w.y << 16), a3 = __uint_as_float(w.y & 0xffff0000u);
        const float a4 = __uint_as_float(w.z << 16), a5 = __uint_as_float(w.z & 0xffff0000u), a6 = __uint_as_float(w.w << 16), a7 = __uint_as_float(w.w & 0xffff0000u);
        s += (a0 * a0 + a1 * a1) + (a2 * a2 + a3 * a3) + (a4 * a4 + a5 * a5) + (a6 * a6 + a7 * a7); }
    { auto rr = __builtin_amdgcn_permlane32_swap(__float_as_uint(s), __float_as_uint(s), false, false); s = __uint_as_float(rr[0]) + __uint_as_float(rr[1]); }
    const float r = 1.0f / sqrtf(s * (1.0f / 128.0f) + 1e-6f);
#pragma unroll
    for (int d0 = 0; d0 < 8; ++d0) { const u32x4 w = __builtin_bit_cast(u32x4, qr[d0]); const int d = d0 * 16 + hi * 8;
        const f32x4 g0 = *(const f32x4*)(gq + d) * *(const f32x4*)(gk + d) * r, g1 = *(const f32x4*)(gq + d + 4) * *(const f32x4*)(gk + d + 4) * r;
        u32x4 o; o.x = cvtpk(__uint_as_float(w.x << 16) * g0[0], __uint_as_float(w.x & 0xffff0000u) * g0[1]); o.y = cvtpk(__uint_as_float(w.y << 16) * g0[2], __uint_as_float(w.y & 0xffff0000u) * g0[3]);
        o.z = cvtpk(__uint_as_float(w.z << 16) * g1[0], __uint_as_float(w.z & 0xffff0000u) * g1[1]); o.w = cvtpk(__uint_as_float(w.w << 16) * g1[2], __uint_as_float(w.w & 0xffff0000u) * g1[3]);
        qr[d0] = __builtin_bit_cast(bf16x8, o); }
}
__device__ __forceinline__ void fox_prime(const BlockRef& cur, char* lds, Seam& S) {
    int tid; asm volatile("v_mov_b32 %0, %1" : "=v"(tid) : "v"((int)threadIdx.x));
    const int wid = __builtin_amdgcn_readfirstlane(tid >> 6), lane = tid & 63, r32 = lane & 31, hi = lane >> 5;
    const int sr = tid >> 4, sc = (tid & 15) * 8, kws = KSWZ(sr, sc * 2); char* K_lds = lds + 2 * SHM_V;
#pragma unroll
    for (int d0 = 0; d0 < 8; ++d0) S.qr[d0] = load8(cur.Q + (size_t)(wid * QBLK + r32) * QS + d0 * 16 + hi * 8);
    SLOAD_H(cur.K, cur.V, 0); VMW(); SWRITE_HK(0);
    __syncthreads();
}
__device__ __forceinline__ void fox_block(const BlockRef& cur, char* lds, Seam& S, const float* cumL, int NT, float* plse) {
    const int tid = threadIdx.x, wid = __builtin_amdgcn_readfirstlane(tid >> 6), lane = tid & 63, r32 = lane & 31, hi = lane >> 5;
    const int qlo = cur.P0 + wid * QBLK, qm = qlo + r32 - 4 * hi;
    char* V_lds = lds; char* K_lds = lds + 2 * SHM_V;
    float* ws = (float*)(lds + LDS_WS) + wid * 64; float* li_l = ws, * al_l = ws + 32;
    float m_reg = -1e30f, l_reg = 0; f32x16 o[4] = {};
    const int sr = tid >> 4, sc = (tid & 15) * 8, vst0 = v_st(sr, sc), vst1 = vst0 + 8192  , kws = KSWZ(sr, sc * 2);
    const int vb0 = (int)(uintptr_t)V_lds + v_rd_base(lane);
    const bf16_t* Kh = cur.K; const bf16_t* Vh = cur.V;
    const float* clb = cumL + 4 * hi;
#define RESC(a) do { if (__any((a) < 1.f)) { if (hi == 0) al_l[r32] = (a); asm volatile("s_waitcnt lgkmcnt(0)" ::: "memory");              \
                     for (int d_ = 0; d_ < 4; ++d_) for (int r = 0; r < 16; ++r) o[d_][r] *= al_l[crow(r, hi)]; } } while (0)
#define KBASE(t) ((t) * KVBLK)
#define MASKT(P0_, P1_, t) do { const int kb_ = KBASE(t); if (kb_ + KVBLK - 1 > qlo) mask_tile(P0_, P1_, qm - kb_); } while (0)
    constexpr int NQL = 8;
#define SEAM_K0() do { VMWN(NQL); SWRITE_HK(0); SBAR(); } while (0)
    f32x16 pA0, pA1, pB0, pB1; float mnA, mnB, alA, alB; bf16x8 pa0, pa1, pa2, pa3;
    SWRITE_HV(0); SBAR();
    if (NT > 1) { SLOAD_H(Kh, Vh, KBASE(1)); }
    SBAR(); qkt<0>(pA0, pA1, K_lds, r32, hi, S.qr, clb + KBASE(0));
    MASKT(pA0, pA1, 0); partialSM(pA0, pA1, m_reg, mnA, alA);
    if (NT > 1) { VMW(); SWRITE_H(1); }
    __syncthreads();
#define HALF_STEP(PX0, PX1, mnX, alX, PY0, PY1, alY, t, KB, VB, SB) do {                                                      \
        SBAR(); qkt<KB>(PX0, PX1, K_lds, r32, hi, S.qr, clb + KBASE(t));                                                  \
        finishSM(PY0, PY1, alY, l_reg, pa0, pa1, pa2, pa3); SBAR();                                                           \
        if ((t) + 1 < NT) { SLOAD_H(Kh, Vh, KBASE((t) + 1)); SBAR(); }                                                        \
        pv_tile<VB>(o, vb0, pa0, pa1, pa2, pa3); MASKT(PX0, PX1, (t)); partialSM(PX0, PX1, m_reg, mnX, alX);                   \
        __syncthreads();                                                                                                      \
        if ((t) + 1 < NT) { VMW(); SWRITE_H(SB); }                                                                            \
        RESC(alX); __syncthreads(); } while (0)
    for (int t = 1; t + 1 < NT; t += 2) {
        HALF_STEP(pB0, pB1, mnB, alB, pA0, pA1, alA, t, 1, 0, 0);
        HALF_STEP(pA0, pA1, mnA, alA, pB0, pB1, alB, t + 1, 0, 1, 1);
    }
    const bool even = (NT & 1) == 0;
    if (even) { SBAR(); qkt<1>(pB0, pB1, K_lds, r32, hi, S.qr, clb + KBASE(NT - 1)); SBAR(); }
    finishSM(pA0, pA1, alA, l_reg, pa0, pa1, pa2, pa3); SBAR();
    pv_tile<0>(o, vb0, pa0, pa1, pa2, pa3);
    if (even) { MASKT(pB0, pB1, NT - 1); partialSM(pB0, pB1, m_reg, mnB, alB); __syncthreads(); RESC(alB);
        finishSM(pB0, pB1, alB, l_reg, pa0, pa1, pa2, pa3); SBAR(); pv_tile<1>(o, vb0, pa0, pa1, pa2, pa3); }
    SBAR();
    if (hi == 0) { li_l[r32] = l_reg;
        if (plse) __hip_atomic_store(plse + wid * QBLK + r32, m_reg * (1.4426950408889634f * SCALE) + __builtin_amdgcn_logf(l_reg), __ATOMIC_RELAXED, __HIP_MEMORY_SCOPE_AGENT); }
    asm volatile("s_waitcnt lgkmcnt(0)" ::: "memory");
    float rli[16];
#pragma unroll
    for (int r = 0; r < 16; ++r) rli[r] = __builtin_amdgcn_rcpf(li_l[crow(r, hi)]);
    bf16_t* Ow = cur.O + (size_t)(wid * QBLK) * OS;
#pragma unroll
    for (int r = 0; r < 16; ++r) { const int orow = crow(r, hi);
#pragma unroll
        for (int d0 = 0; d0 < 4; ++d0) { const float v = o[d0][r] * rli[r];
            const float vn = __int_as_float(__builtin_amdgcn_update_dpp(0, __float_as_int(v), 0xB1, 0xf, 0xf, false));
            if ((r32 & 1) == 0) { unsigned* op_ = (unsigned*)(Ow + (size_t)orow * OS + d0 * 32 + r32);
                if (plse) __hip_atomic_store(op_, cvtpk(v, vn), __ATOMIC_RELAXED, __HIP_MEMORY_SCOPE_AGENT); else *op_ = cvtpk(v, vn); } } }
    __syncthreads();
#undef RESC
#undef KBASE
#undef MASKT
#undef SEAM_K0
#undef HALF_STEP
}
#undef ROW
#undef VMWN
#undef SLOAD_H
#undef SWRITE_HK
#undef SWRITE_HV
#undef SWRITE_H

constexpr int GM_U = 2 * SHM_V;
constexpr int GM_UP = 264;
__device__ __forceinline__ void gmlp_unit(char* lds, int idx, const bf16_t* Z, const bf16_t* Wb, const float* b_s, bf16_t* OAB, const float* vs1, const float* vs2, const float* lng, const float* lnb) {
    int tid; asm volatile("v_mov_b32 %0, %1" : "=v"(tid) : "v"((int)threadIdx.x));
    const int wid = __builtin_amdgcn_readfirstlane(tid >> 6), lane = tid & 63, r32 = lane & 31, hi = lane >> 5;
    const int g = idx & 7, row0 = (idx >> 3) * 128;
    char* V_lds = lds;
    const int sr = tid >> 4, sc = (tid & 15) * 8;
    const int rg = wid & 3, dh = wid >> 2, nks = 2 * (rg + 1);
    u32x4 vraw[4], uraw[4]; float s1[4], s2[4];
#pragma unroll
    for (int q = 0; q < 4; ++q) { const int s = q * 32 + sr; const bf16_t* zr = Z + (size_t)(row0 + s) * QS + g * 128 + sc;
        vraw[q] = __builtin_bit_cast(u32x4, load8(zr + 1024)); uraw[q] = __builtin_bit_cast(u32x4, load8(zr)); s1[q] = vs1[row0 + s]; s2[q] = vs2[row0 + s]; }
    const f32x4 lg0 = *(const f32x4*)(lng + g * 128 + sc), lg1 = *(const f32x4*)(lng + g * 128 + sc + 4), lb0 = *(const f32x4*)(lnb + g * 128 + sc), lb1 = *(const f32x4*)(lnb + g * 128 + sc + 4);
    bf16x8 wf[8];
    const bf16_t* wrow = Wb + (size_t)(g * 128 + 32 * rg + r32) * 128 + 8 * hi;
#pragma unroll
    for (int ks = 0; ks < 8; ++ks) wf[ks] = load8(wrow + 16 * ks);
    float bias[16];
#pragma unroll
    for (int r = 0; r < 16; ++r) bias[r] = b_s[g * 128 + 32 * rg + crow(r, hi)];
#pragma unroll
    for (int q = 0; q < 4; ++q) { const int s = q * 32 + sr; const u32x4 w = vraw[q];
        const float mu = s1[q] * (1.0f / 1024.0f), var = s2[q] * (1.0f / 1024.0f) - mu * mu, rs = 1.0f / sqrtf(var + 1e-6f), nm = -mu * rs;
        const f32x4 a0 = (f32x4){__uint_as_float(w.x << 16), __uint_as_float(w.x & 0xffff0000u), __uint_as_float(w.y << 16), __uint_as_float(w.y & 0xffff0000u)};
        const f32x4 a1 = (f32x4){__uint_as_float(w.z << 16), __uint_as_float(w.z & 0xffff0000u), __uint_as_float(w.w << 16), __uint_as_float(w.w & 0xffff0000u)};
        const f32x4 y0 = (a0 * rs + nm) * lg0 + lb0, y1 = (a1 * rs + nm) * lg1 + lb1;
        u32x4 o; o.x = cvtpk(y0[0], y0[1]); o.y = cvtpk(y0[2], y0[3]); o.z = cvtpk(y1[0], y1[1]); o.w = cvtpk(y1[2], y1[3]);
        *(bf16x8*)(V_lds + (q >> 1) * SHM_V + v_st((q & 1) * 32 + sr, sc)) = __builtin_bit_cast(bf16x8, o);
        char* up = lds + GM_U + s * GM_UP + sc * 2; *(unsigned long long*)up = (unsigned long long)uraw[q].x | ((unsigned long long)uraw[q].y << 32);
        *(unsigned long long*)(up + 8) = (unsigned long long)uraw[q].z | ((unsigned long long)uraw[q].w << 32); }
    __syncthreads();
    f32x16 o0 = {}, o1 = {};
    const int vb = (int)(uintptr_t)V_lds + v_rd_base(lane) + dh * 1024;
#define GM_STEP(ks) do { if ((ks) < nks) { s16x4 l0, h0, l1, h1; constexpr int b_ = ((ks) >> 2) * SHM_V + v_rd_off(0, (ks) & 3, 0); \
        TRRD(l0, vb, b_); TRRD(h0, vb, b_ + 2048); TRRD(l1, vb, b_ + 512); TRRD(h1, vb, b_ + 512 + 2048); \
        asm volatile("s_waitcnt lgkmcnt(0)" ::: "memory"); SBAR(); \
        o0 = __builtin_amdgcn_mfma_f32_32x32x16_bf16(wf[ks], (bf16x8){l0[0], l0[1], l0[2], l0[3], h0[0], h0[1], h0[2], h0[3]}, o0, 0, 0, 0); \
        o1 = __builtin_amdgcn_mfma_f32_32x32x16_bf16(wf[ks], (bf16x8){l1[0], l1[1], l1[2], l1[3], h1[0], h1[1], h1[2], h1[3]}, o1, 0, 0, 0); } } while (0)
    GM_STEP(0); GM_STEP(1); GM_STEP(2); GM_STEP(3); GM_STEP(4); GM_STEP(5); GM_STEP(6); GM_STEP(7);
#undef GM_STEP
#pragma unroll
    for (int r = 0; r < 16; ++r) { const int t = 32 * rg + crow(r, hi);
        const size_t ooff = (size_t)(row0 + t) * OS + g * 128;
#pragma unroll
        for (int dd = 0; dd < 2; ++dd) { const int d = (2 * dh + dd) * 32 + r32;
            const float uu = __uint_as_float((unsigned)(*(const unsigned short*)(lds + GM_U + t * GM_UP + d * 2)) << 16);
            const float v = uu * ((dd ? o1[r] : o0[r]) + bias[r]);
            const float vn = __int_as_float(__builtin_amdgcn_update_dpp(0, __float_as_int(v), 0xB1, 0xf, 0xf, false));
            if ((r32 & 1) == 0) *(unsigned*)(OAB + ooff + d) = cvtpk(v, vn); } }
    __syncthreads();
}
#undef TRRD
#undef SBAR
#undef VMW
}

constexpr int NWAVES = 8;
constexpr int N_LAUNCHES = MK_N_LAUNCHES;
constexpr int N_PHASES = 10;
constexpr int M = 8192, DM = 2048, SEQ = 2048, NZ = 9216, DFF = 5632, NUP = 2 * DFF, PLE = 256, INC = 9224;
constexpr float EPS = 1e-6f;
constexpr size_t MiB = 1u << 20;
constexpr size_t WS_CTL = 0, CTL_ZERO_BYTES = 1 * MiB;
constexpr size_t WS_F = 1 * MiB;
constexpr size_t WS_CUM = WS_F + 512 * 1024;
constexpr size_t WS_WSB = 2 * MiB;
constexpr size_t WS_PLSE = 3 * MiB;
constexpr size_t WS_PART = 148 * MiB;
constexpr size_t WS_Z = 4 * MiB;
constexpr size_t WS_Y = 148 * MiB;
constexpr size_t WS_E = 100 * MiB;
constexpr size_t WS_A2 = 132 * MiB;
constexpr size_t WS_HALO = 165 * MiB, WS_FA = 167 * MiB, WS_FB = 169 * MiB;
constexpr size_t WS_WUP = 180 * MiB, WS_WDOWN = 224 * MiB, WS_WGATE = 246 * MiB, WS_WPLE = 254 * MiB, WS_PB = 255 * MiB;
constexpr size_t WS_H = 259 * MiB;
constexpr size_t WS_WIN = 291 * MiB, WS_WAB = 327 * MiB, WS_WOUT = 335 * MiB;
constexpr size_t WS_HM = 4 * MiB;
constexpr size_t WS_END = 347 * MiB;
constexpr int CW_BAR = 4096, CW_GQ = 8192, CW_AFLAG = 9216, CW_SSQ1 = 16384, CW_SSQ2 = 24576, CW_SSQE = 32768, CW_VS1 = 40960, CW_VS2 = 49152;

constexpr int RING_BYTES = 131072;
constexpr int LDSCTL_OFF = 143360, MISC_OFF = LDSCTL_OFF + 320;
constexpr int LDS_BYTES = 147456;
constexpr int P0_WF_OFF = 67584;
static_assert(4 * 16640 <= P0_WF_OFF && P0_WF_OFF + 65536 <= LDSCTL_OFF && 8 * 16640 <= LDSCTL_OFF && fox::LDS_BYTES <= RING_BYTES && MISC_OFF + 128 <= LDS_BYTES, "LDS map");

#define GAS __attribute__((address_space(1)))
#define LAS __attribute__((address_space(3)))
typedef unsigned short bf16;
typedef unsigned v4u __attribute__((ext_vector_type(4)));
typedef float f32x4 __attribute__((ext_vector_type(4)));
#define RLX_AGENT __ATOMIC_RELAXED, __HIP_MEMORY_SCOPE_AGENT
#define LDS_WAIT() asm volatile("s_waitcnt lgkmcnt(0)" ::: "memory")
__device__ __forceinline__ unsigned f2bf(float f) { unsigned u = __builtin_bit_cast(unsigned, f); return (u + 0x7fffu + ((u >> 16) & 1u)) >> 16; }
__device__ __forceinline__ unsigned pk2(float lo, float hi) { unsigned r; asm("v_cvt_pk_bf16_f32 %0, %1, %2" : "=v"(r) : "v"(lo), "v"(hi)); return r; }
__device__ __forceinline__ float bflo(unsigned w) { return __uint_as_float(w << 16); }
__device__ __forceinline__ float bfhi(unsigned w) { return __uint_as_float(w & 0xffff0000u); }

#define XB_TMO      128
#define XB_XCNT(j)  (256  + 64 * (j))
#define XB_XSUB(j)  (1280 + 64 * (j))
#define XB_XGEN(j)  (2304 + 64 * (j))
#define XB_TOP      3328
#define XB_TOPGEN   3392
#define XCD_BAR_WORDS 3456
#define XB_SPIN_CAP (1u << 18)
__device__ __forceinline__ unsigned xb_ld(unsigned* p)              { return __hip_atomic_load(p, __ATOMIC_RELAXED, __HIP_MEMORY_SCOPE_AGENT); }
__device__ __forceinline__ unsigned xb_add(unsigned* p, unsigned v) { return __hip_atomic_fetch_add(p, v, __ATOMIC_RELAXED, __HIP_MEMORY_SCOPE_AGENT); }
__device__ __forceinline__ unsigned xb_xcc_id() { return (unsigned)__builtin_amdgcn_s_getreg((3 << 11) | 20) & 0xFu; }
#define XB_SPIN(cond, bar) do { unsigned _sp = 0; while (cond) { __builtin_amdgcn_s_sleep(1); \
    if ((++_sp & 255u) == 0u) { if (xb_ld(&(bar)[XB_TMO])) break; if (_sp > XB_SPIN_CAP) { atomicAdd(&(bar)[XB_TMO], 1u); break; } } } } while (0)
struct XcdBarrier { unsigned* bar; unsigned x; volatile LAS unsigned* st; };
__device__ __forceinline__ XcdBarrier xcd_barrier_post(unsigned* bar, volatile LAS unsigned* st) {
    XcdBarrier b; b.bar = bar; b.x = xb_xcc_id(); b.st = st;
    if (threadIdx.x == 0) (void)xb_add(&bar[XB_XCNT(b.x)], 1u);
    return b;
}
__device__ __forceinline__ void xcd_barrier_complete(unsigned* bar, unsigned x, unsigned& nloc, unsigned& nx) {
    const unsigned G = gridDim.x * gridDim.y * gridDim.z;
    unsigned sum, cnt, mine, sp = 0u;
    for (;;) {
        sum = 0u; cnt = 0u; mine = 0u;
#pragma unroll
        for (unsigned j = 0; j < 16; ++j) { const unsigned c = xb_ld(&bar[XB_XCNT(j)]); sum += c; cnt += (c > 0u) ? 1u : 0u; mine = (j == x) ? c : mine; }
        if (sum == G) break;
        __builtin_amdgcn_s_sleep(1);
        if ((++sp & 255u) == 0u) { if (xb_ld(&bar[XB_TMO])) break; if (sp > XB_SPIN_CAP) { atomicAdd(&bar[XB_TMO], 1u); break; } }
    }
    nloc = mine > 0u ? mine : 1u; nx = cnt > 0u ? cnt : 1u;
}
__device__ __forceinline__ void xcd_barrier(const XcdBarrier& b) {
    asm volatile("s_waitcnt vmcnt(0)" ::: "memory");
    __syncthreads();
    if (threadIdx.x == 0) {
        unsigned* bar = b.bar;
        __builtin_amdgcn_s_waitcnt(0);
        unsigned nloc = b.st[0], nx = b.st[1];
        if (nloc == 0u) { xcd_barrier_complete(bar, b.x, nloc, nx); b.st[0] = nloc; b.st[1] = nx; }
        const unsigned old = xb_add(&bar[XB_XSUB(b.x)], 1u);
        const unsigned gen = old / nloc;
        if (old + 1u == (gen + 1u) * nloc) {
            __builtin_amdgcn_fence(__ATOMIC_RELEASE, "agent");
            asm volatile("s_waitcnt vmcnt(0)" ::: "memory");
            const unsigned og = xb_add(&bar[XB_TOP], 1u);
            const unsigned tg = og / nx;
            if (og + 1u == (tg + 1u) * nx) xb_add(&bar[XB_TOPGEN], 1u);
            else XB_SPIN(xb_ld(&bar[XB_TOPGEN]) == tg, bar);
            __builtin_amdgcn_fence(__ATOMIC_ACQUIRE, "agent");
            xb_add(&bar[XB_XGEN(b.x)], 1u);
            asm volatile("s_waitcnt vmcnt(0)" ::: "memory");
        } else {
            XB_SPIN(xb_ld(&bar[XB_XGEN(b.x)]) == gen, bar);
            __builtin_amdgcn_fence(__ATOMIC_ACQUIRE, "agent");
            asm volatile("s_waitcnt vmcnt(0)" ::: "memory");
        }
    }
    __syncthreads();
}

__device__ __forceinline__ float wave_sum(float v) {
    v += __int_as_float(__builtin_amdgcn_update_dpp(0, __float_as_int(v), 0xB1, 0xf, 0xf, false));
    v += __int_as_float(__builtin_amdgcn_update_dpp(0, __float_as_int(v), 0x4E, 0xf, 0xf, false));
    v += __int_as_float(__builtin_amdgcn_update_dpp(0, __float_as_int(v), 0x141, 0xf, 0xf, false));
    v += __int_as_float(__builtin_amdgcn_update_dpp(0, __float_as_int(v), 0x140, 0xf, 0xf, false));
    { auto r = __builtin_amdgcn_permlane16_swap(__float_as_uint(v), __float_as_uint(v), false, false); v = __uint_as_float(r[0]) + __uint_as_float(r[1]); }
    { auto r = __builtin_amdgcn_permlane32_swap(__float_as_uint(v), __float_as_uint(v), false, false); v = __uint_as_float(r[0]) + __uint_as_float(r[1]); }
    return v;
}
struct TPtrs { const float *w_in, *wa, *wb, *wout, *wup, *wdown, *wgate, *wple, *g_up, *g_gate; bf16 *WIN, *WAB, *WOUT, *WUP, *WDOWN, *WGATE, *WPLE; };
constexpr int TI1 = 32 * 80, TI2 = 32 * 64, TI3 = 16 * 32, TI4 = 16 * 32, TI5 = 32 * 32, TI6 = 32 * 176, TI7 = 88 * 32, TI8 = 32 * 32, TI9 = 4 * 32;
constexpr int TG0 = TI1 + TI2, TG1 = TI3 + TI4 + TI5 + TI6 + TI9, TG2 = TI7 + TI8;
template <int GRP> __device__ __forceinline__ void t_decode(const TPtrs& P, int r, int lane, const float*& src, int& ldw, bf16*& dst, int& ldk, const float*& gain) {
    const float* W; bf16* WT; int k0, scol, drow, dk0; const float* gn = nullptr;
    if (GRP == 0) {
        if (r < TI1) { const int kb = r / 80, nb = r % 80; W = P.w_in; ldw = 9224; k0 = 64 * kb; scol = 64 * nb; WT = P.WIN; ldk = 2048; drow = 64 * nb; dk0 = k0; }
        else { r -= TI1; const int kb = r / 64, nb = r % 64; W = P.w_in; ldw = 9224; k0 = 64 * kb; scol = 5128 + 64 * nb; WT = P.WIN; ldk = 2048; dk0 = k0;
               const int o = 64 * nb, c = o < 2048 ? o : o - 2048; drow = 5120 + 256 * (c >> 7) + (c & 127) + (o < 2048 ? 0 : 128); }
    } else if (GRP == 1) {
        if (r < TI3) { const int kb = r / 32, nb = r % 32; W = P.wa; ldw = 2048; k0 = 64 * kb; scol = 64 * nb; WT = P.WAB; ldk = 2048; drow = 64 * nb; dk0 = k0; }
        else if (r < TI3 + TI4) { r -= TI3; const int kb = r / 32, nb = r % 32; W = P.wb; ldw = 2048; k0 = 64 * kb; scol = 64 * nb; WT = P.WAB; ldk = 2048; drow = 64 * nb; dk0 = 1024 + k0; }
        else if (r < TI3 + TI4 + TI5) { r -= TI3 + TI4; const int kb = r / 32, nb = r % 32; W = P.wout; ldw = 2048; k0 = 64 * kb; scol = 64 * nb; WT = P.WOUT; ldk = 2048; drow = 64 * nb; dk0 = k0; }
        else if (r >= TI3 + TI4 + TI5 + TI6) { r -= TI3 + TI4 + TI5 + TI6; const int kb = r / 32, nb = r % 32; W = P.wple; ldw = 2048; k0 = 64 * kb; scol = 64 * nb; WT = P.WPLE; ldk = 256; drow = 64 * nb; dk0 = k0; }
        else { r -= TI3 + TI4 + TI5; const int kb = r / 176, nb = r % 176; W = P.wup; ldw = 11264; k0 = 64 * kb; scol = 64 * nb; const int mm = scol < 5632 ? scol : scol - 5632;
               WT = P.WUP; ldk = 2048; drow = 256 * (mm >> 7) + (mm & 127) + (scol < 5632 ? 0 : 128); dk0 = k0; gn = P.g_up; }
    } else {
        if (r < TI7) { const int kb = r / 32, nb = r % 32; W = P.wdown; ldw = 2048; k0 = 64 * kb; scol = 64 * nb; WT = P.WDOWN; ldk = 5632; drow = 64 * nb; dk0 = k0; }
        else { r -= TI7; const int kb = r / 32, nb = r % 32; W = P.wgate; ldw = 2048; k0 = 64 * kb; scol = 64 * nb; WT = P.WGATE; ldk = 2048; drow = 64 * nb; dk0 = k0; gn = P.g_gate; }
    }
    src = W + (size_t)(k0 + (lane >> 4)) * ldw + scol + 4 * (lane & 15);
    dst = WT + (size_t)(drow + (lane >> 3)) * ldk + dk0 + 8 * (lane & 7);
    gain = gn ? gn + k0 + (lane >> 4) : nullptr;
}
template <int GRP> __device__ __forceinline__ void run_transposes(const TPtrs& P, int first, int stride, LAS float* scr, int lane) {
    constexpr int NIT = GRP == 0 ? TG0 : (GRP == 1 ? TG1 : TG2);
    int it = first; if (it >= NIT) return;
    const float* src; bf16* dst; int ldw, ldk; const float* gain;
    t_decode<GRP>(P, it, lane, src, ldw, dst, ldk, gain);
    f32x4 v[16]; float gv[16];
#pragma unroll
    for (int i = 0; i < 16; ++i) v[i] = __builtin_nontemporal_load((const GAS f32x4*)(src + (size_t)(4 * i) * ldw));
#pragma unroll
    for (int i = 0; i < 16; ++i) gv[i] = (GRP != 0 && gain) ? gain[4 * i] : 1.0f;
    const int kr = lane >> 4, nq = lane & 15, c = lane & 7;
    for (;;) {
#pragma unroll
        for (int i = 0; i < 16; ++i) { LAS float* d = scr + (4 * i + kr) * 65 + 4 * nq; const f32x4 t = v[i] * gv[i]; d[0] = t.x; d[1] = t.y; d[2] = t.z; d[3] = t.w; }
        const int nit = it + stride; const bool more = nit < NIT;
        bf16* cdst = dst; const int cldk = ldk;
        if (more) { t_decode<GRP>(P, nit, lane, src, ldw, dst, ldk, gain);
#pragma unroll
            for (int i = 0; i < 16; ++i) v[i] = __builtin_nontemporal_load((const GAS f32x4*)(src + (size_t)(4 * i) * ldw));
#pragma unroll
            for (int i = 0; i < 16; ++i) gv[i] = (GRP != 0 && gain) ? gain[4 * i] : 1.0f; }
        LDS_WAIT(); asm volatile("" ::: "memory");
#pragma unroll
        for (int j = 0; j < 8; ++j) { const LAS float* sp = scr + (8 * c) * 65 + (lane >> 3) + 8 * j;
            v4u o; o.x = pk2(sp[0 * 65], sp[1 * 65]); o.y = pk2(sp[2 * 65], sp[3 * 65]); o.z = pk2(sp[4 * 65], sp[5 * 65]); o.w = pk2(sp[6 * 65], sp[7 * 65]);
            *(GAS v4u*)(cdst + (size_t)(8 * j) * cldk) = o; }
        LDS_WAIT(); asm volatile("" ::: "memory");
        if (!more) break;
        it = nit;
    }
}

__device__ __forceinline__ void conv_fixup_rows(int pm, int ch, bf16* HM, const float* HALO, const float* FA, const float* FB, const float* conv_w, const float* conv_b) {
    const int c = ch * 8;
    float o0[8], o1[8];
#pragma unroll
    for (int h = 0; h < 2; ++h) { const int cc = c + 4 * h;
        const f32x4 w0 = *(const f32x4*)(conv_w + cc), w1 = *(const f32x4*)(conv_w + DFF + cc), w2 = *(const f32x4*)(conv_w + 2 * DFF + cc), cbv = *(const f32x4*)(conv_b + cc);
        const f32x4 am2 = *(const f32x4*)(HALO + (size_t)((pm - 1) * 2 + 0) * DFF + cc), am1 = *(const f32x4*)(HALO + (size_t)((pm - 1) * 2 + 1) * DFF + cc);
        const f32x4 a0 = *(const f32x4*)(FA + (size_t)(pm * 2 + 0) * DFF + cc), a1 = *(const f32x4*)(FA + (size_t)(pm * 2 + 1) * DFF + cc);
        const f32x4 b0 = *(const f32x4*)(FB + (size_t)(pm * 2 + 0) * DFF + cc), b1 = *(const f32x4*)(FB + (size_t)(pm * 2 + 1) * DFF + cc);
#pragma unroll
        for (int q = 0; q < 4; ++q) { o0[4 * h + q] = pg8::EpiUpConv::gelu_t(cbv[q] + w0[q] * am2[q] + w1[q] * am1[q] + w2[q] * a0[q]) * b0[q];
                                      o1[4 * h + q] = pg8::EpiUpConv::gelu_t(cbv[q] + w0[q] * am1[q] + w1[q] * a0[q] + w2[q] * a1[q]) * b1[q]; } }
    v4u ov; ov.x = pk2(o0[0], o0[1]); ov.y = pk2(o0[2], o0[3]); ov.z = pk2(o0[4], o0[5]); ov.w = pk2(o0[6], o0[7]);
    *(v4u*)(HM + (size_t)(pm * 256) * DFF + c) = ov;
    ov.x = pk2(o1[0], o1[1]); ov.y = pk2(o1[2], o1[3]); ov.z = pk2(o1[4], o1[5]); ov.w = pk2(o1[6], o1[7]);
    *(v4u*)(HM + (size_t)(pm * 256 + 1) * DFF + c) = ov;
}

struct Args { const float* in[23]; float* out; unsigned char* ws; int ph_lo, ph_hi, one, pad; };

__global__ void __launch_bounds__(NWAVES * 64, 2) mega_fwd(Args args) {
    extern __shared__ __attribute__((aligned(16))) unsigned char lds[];
    LAS unsigned char* ldsL = (LAS unsigned char*)lds;
    volatile LAS unsigned* MISC = (volatile LAS unsigned*)(ldsL + MISC_OFF);
    const int tid = threadIdx.x, lane = tid & 63, wave = __builtin_amdgcn_readfirstlane(tid >> 6);
    const int G = gridDim.x; const int bx = blockIdx.x; const int vcu = (G % 8 == 0) ? (bx % 8) * (G / 8) + bx / 8 : bx;
    unsigned char* ws = args.ws;
    unsigned* ctl = (unsigned*)(ws + WS_CTL);
    const float* x = args.in[0]; const float* pin = args.in[1]; const float* norm_mix_g = args.in[2]; const float* w_in = args.in[3];
    const float* gmlp_ln_g = args.in[4]; const float* gmlp_ln_b = args.in[5]; const float* gmlp_w_s = args.in[6]; const float* gmlp_b_s = args.in[7];
    const float* fox_b_f = args.in[8]; const float* q_norm_g = args.in[9]; const float* k_norm_g = args.in[10];
    const float* w_branch_a = args.in[11]; const float* w_branch_b = args.in[12]; const float* w_out = args.in[13]; const float* norm_ffn_g = args.in[14];
    const float* w_up = args.in[15]; const float* conv_w = args.in[16]; const float* conv_b = args.in[17]; const float* w_down = args.in[18];
    const float* ple_proj = args.in[19]; const float* ple_norm_g = args.in[20]; const float* ple_gate_norm_g = args.in[21]; const float* w_ple_gate = args.in[22];
    float* out = args.out;
    float* Fb = (float*)(ws + WS_F); float* CUM = (float*)(ws + WS_CUM); bf16* WSB = (bf16*)(ws + WS_WSB);
    bf16* Z = (bf16*)(ws + WS_Z); bf16* Y = (bf16*)(ws + WS_Y); bf16* EB = (bf16*)(ws + WS_E); bf16* A2 = (bf16*)(ws + WS_A2);
    bf16* WUP = (bf16*)(ws + WS_WUP); bf16* WDOWN = (bf16*)(ws + WS_WDOWN); bf16* WGATE = (bf16*)(ws + WS_WGATE); bf16* WPLE = (bf16*)(ws + WS_WPLE);
    bf16* PB = (bf16*)(ws + WS_PB); bf16* H = (bf16*)(ws + WS_H); bf16* WIN = (bf16*)(ws + WS_WIN); bf16* WAB = (bf16*)(ws + WS_WAB); bf16* WOUT = (bf16*)(ws + WS_WOUT);
    bf16* HM = (bf16*)(ws + WS_HM); float* HALO = (float*)(ws + WS_HALO); float* FA = (float*)(ws + WS_FA); float* FB = (float*)(ws + WS_FB); bf16* OAB = (bf16*)out;
#define MAKE_TP() TPtrs TP; TP.w_in = args.in[3]; TP.wa = args.in[11]; TP.wb = args.in[12]; TP.wout = args.in[13]; TP.wup = args.in[15]; TP.wdown = args.in[18]; TP.wgate = args.in[22]; TP.wple = args.in[19]; TP.g_up = args.in[14]; TP.g_gate = args.in[21]; \
    TP.WIN = (bf16*)(args.ws + WS_WIN); TP.WAB = (bf16*)(args.ws + WS_WAB); TP.WOUT = (bf16*)(args.ws + WS_WOUT); TP.WUP = (bf16*)(args.ws + WS_WUP); TP.WDOWN = (bf16*)(args.ws + WS_WDOWN); TP.WGATE = (bf16*)(args.ws + WS_WGATE); TP.WPLE = (bf16*)(args.ws + WS_WPLE)
    float* VS1 = (float*)(ctl + CW_VS1); float* VS2 = (float*)(ctl + CW_VS2);
    float* SSQ1 = (float*)(ctl + CW_SSQ1); float* SSQ2 = (float*)(ctl + CW_SSQ2); float* SSQE = (float*)(ctl + CW_SSQE);

    for (int u = tid; u < (LDS_BYTES - LDSCTL_OFF) / 4; u += NWAVES * 64) ((LAS unsigned*)(ldsL + LDSCTL_OFF))[u] = 0u;
    __syncthreads();
    XcdBarrier bar; bar.bar = ctl + CW_BAR; bar.x = 0; bar.st = nullptr;
    if (args.one) bar = xcd_barrier_post(ctl + CW_BAR, MISC + 8);
    const int lo = args.ph_lo, hi = args.ph_hi;
#ifndef PROBE_PHASE
#define PROBE_PHASE (-1)
#endif
#ifndef PROBE_SCALE
#define PROBE_SCALE 5000.0f
#endif
    unsigned long long pr_prev = 0; float pr_us = 0.f;
    if (PROBE_PHASE >= 0) pr_prev = __builtin_amdgcn_s_memrealtime();
#define PR_STAMP(k) do { if (PROBE_PHASE >= 0) { const unsigned long long t_ = __builtin_amdgcn_s_memrealtime(); if ((k) == PROBE_PHASE) pr_us = (float)(t_ - pr_prev) * 0.01f; pr_prev = t_; } } while (0)
#ifndef PH_MASK
#define PH_MASK 0x3ff
#endif
#define IN(k) ((((PH_MASK) >> (k)) & 1) && lo <= (k) && (k) < hi)
#define GRID_BAR(k) do { if (IN(k) && IN((k) + 1)) xcd_barrier(bar); } while (0)
    const int gw = vcu * NWAVES + wave, NGW = G * NWAVES;
    const int gt = vcu * (NWAVES * 64) + tid, NGT = G * NWAVES * 64;

    if (IN(0)) {
        { LAS float* wf = (LAS float*)(ldsL + P0_WF_OFF);
          for (int k = tid; k < DM; k += NWAVES * 64) { const f32x4 a = *(const f32x4*)(w_in + (size_t)k * INC + 5120), b = *(const f32x4*)(w_in + (size_t)k * INC + 5124);
              wf[0 * DM + k] = a[0]; wf[1 * DM + k] = a[1]; wf[2 * DM + k] = a[2]; wf[3 * DM + k] = a[3]; wf[4 * DM + k] = b[0]; wf[5 * DM + k] = b[1]; wf[6 * DM + k] = b[2]; wf[7 * DM + k] = b[3]; }
          __syncthreads(); }
        if (wave < 4) {
        const int gw = vcu * 4 + wave, NGW = G * 4, gt = vcu * 256 + tid, NGT = G * 256;
        { const LAS float* wf = (const LAS float*)(ldsL + P0_WF_OFF);
          f32x4 g4v[8];
#pragma unroll
          for (int j = 0; j < 8; ++j) g4v[j] = *((const GAS f32x4*)norm_mix_g + lane + 64 * j);
          f32x4 v[8], nv[8];
          if (gw < M) {
#pragma unroll
              for (int j = 0; j < 8; ++j) v[j] = __builtin_nontemporal_load((const GAS f32x4*)(x + (size_t)gw * DM) + lane + 64 * j); }
          for (int m = gw; m < M; m += NGW) {
            if (m + NGW < M) {
#pragma unroll
                for (int j = 0; j < 8; ++j) nv[j] = __builtin_nontemporal_load((const GAS f32x4*)(x + (size_t)(m + NGW) * DM) + lane + 64 * j); }
            float s = 0.f;
#pragma unroll
            for (int j = 0; j < 8; ++j) s += (v[j].x * v[j].x + v[j].y * v[j].y) + (v[j].z * v[j].z + v[j].w * v[j].w);
            const float rstd = 1.0f / sqrtf(wave_sum(s) * (1.0f / DM) + EPS);
            float fa[8];
#pragma unroll
            for (int f = 0; f < 8; ++f) fa[f] = 0.f;
            GAS unsigned long long* o8 = (GAS unsigned long long*)(H + (size_t)m * DM) + lane;
#pragma unroll
            for (int j = 0; j < 8; ++j) { const f32x4 h4 = v[j] * rstd * g4v[j];
                o8[64 * j] = (unsigned long long)pk2(h4.x, h4.y) | ((unsigned long long)pk2(h4.z, h4.w) << 32);
#pragma unroll
                for (int f = 0; f < 8; ++f) { const f32x4 w4 = *(const LAS f32x4*)(wf + f * DM + 256 * j + 4 * lane); fa[f] += (h4.x * w4.x + h4.y * w4.y) + (h4.z * w4.z + h4.w * w4.w); }
                asm volatile("" ::: "memory"); }
#pragma unroll
            for (int f = 0; f < 8; ++f) fa[f] = wave_sum(fa[f]);
            if (lane < 8) {
                float fv = fa[0];
#pragma unroll
                for (int f = 1; f < 8; ++f) fv = (lane == f) ? fa[f] : fv;
                const float xx = fv + fox_b_f[lane];
                Fb[(size_t)((m >> 11) * 8 + lane) * SEQ + (m & (SEQ - 1))] = fminf(xx, 0.f) - log1pf(expf(-fabsf(xx))); }
#pragma unroll
            for (int j = 0; j < 8; ++j) v[j] = nv[j];
          } }
        for (int i = gt; i < M * PLE / 8; i += NGT) { const f32x4 a = __builtin_nontemporal_load((const f32x4*)(pin + (size_t)i * 8)), b = __builtin_nontemporal_load((const f32x4*)(pin + (size_t)i * 8 + 4));
            v4u o; o.x = pk2(a.x, a.y); o.y = pk2(a.z, a.w); o.z = pk2(b.x, b.y); o.w = pk2(b.z, b.w); *(v4u*)(PB + (size_t)i * 8) = o; }
        for (int i = gt; i < 8 * 128 * 128 / 8; i += NGT) { const int e = i * 8, t = (e >> 7) & 127, s0 = e & 127; const f32x4 a = *(const f32x4*)(gmlp_w_s + e), b = *(const f32x4*)(gmlp_w_s + e + 4);
            float w[8] = {a.x, a.y, a.z, a.w, b.x, b.y, b.z, b.w};
#pragma unroll
            for (int q = 0; q < 8; ++q) if (s0 + q > t) w[q] = 0.f;
            v4u o; o.x = pk2(w[0], w[1]); o.y = pk2(w[2], w[3]); o.z = pk2(w[4], w[5]); o.w = pk2(w[6], w[7]); *(v4u*)(WSB + e) = o; }
        } else {
            MAKE_TP(); run_transposes<0>(TP, vcu * 4 + (wave - 4), G * 4, (LAS float*)(ldsL + (wave - 4) * 16640), lane);
        }
        __syncthreads();
    }
    GRID_BAR(0); PR_STAMP(0);

    if (IN(1)) {
        pg8::Gemm g{H, WIN, M, NZ, DM}; pg8::StaticOrder S; S.init(M, NZ, G, bx);
        pg8::EpiZ E{Z, VS1, VS2, q_norm_g, k_norm_g, (LAS float*)(ldsL + RING_BYTES)};
        pg8::gemm_phase<pg8::EpiZ, pg8::StaticOrder, true, true>(ldsL, g, S, E);
        { const int rem = S.nwg % G; const int nidle = rem ? G - rem : G, idle = rem ? bx - rem : bx;
          if (idle >= 0) { MAKE_TP(); run_transposes<1>(TP, idle * NWAVES + wave, nidle * NWAVES, (LAS float*)(ldsL + wave * 16640), lane); } }
    }
    GRID_BAR(1); PR_STAMP(1);

    PR_STAMP(2);

    if (IN(3)) {
        int msid0 = -1, msid1 = -1;
        for (int it = vcu; it < 512; it += G) {
            const int item = it & 255, pc = it >> 8;
            const int bh = item >> 3, sl = item & 7, b = bh >> 3, h = bh & 7;
            const size_t rowb = (size_t)b * SEQ;
            if (pc == 1 && sl < 5) continue;
            int qb, t0, t1;
            if (pc == 0) { qb = sl == 0 ? 7 : sl == 1 ? 6 : sl == 2 ? 5 : sl == 3 ? 4 : sl == 4 ? 3 : sl == 5 ? 7 : sl == 6 ? 2 : 6;
                           t0 = (sl == 5 || sl == 7) ? 20 : 0;
                           t1 = sl < 4 ? 20 : sl == 4 ? 16 : sl == 5 ? 32 : sl == 6 ? 12 : 28; }
            else { qb = sl == 5 ? 5 : sl == 6 ? 0 : 1; t0 = sl == 5 ? 20 : 0; t1 = sl == 5 ? 24 : sl == 6 ? 4 : 8; }
            const bool split = qb >= 5; const int me = t0 ? 1 : 0, sid = bh * 4 + (qb - 4);
            fox::BlockRef cur; cur.P0 = qb * 256 - t0 * 64;
            cur.Q = Z + (rowb + qb * 256) * NZ + 2048 + h * 128; cur.K = Z + (rowb + t0 * 64) * NZ + 3072 + h * 128; cur.V = Z + (rowb + t0 * 64) * NZ + 4096 + h * 128;
            cur.O = split ? (bf16*)(ws + WS_PART) + (rowb + qb * 256) * 2048 + me * 1024 + h * 128 : OAB + (rowb + qb * 256) * 2048 + 1024 + h * 128;
            float* cumL = (float*)(lds + fox::LDS_CUM);
            {
              float* wsum = (float*)(lds + fox::LDS_WS);
              int tq; asm volatile("v_mov_b32 %0, %1" : "=v"(tq) : "v"(tid));
              const int nk = t1 * 64; const bool act = 4 * tq < nk;
              float v[4];
              { f32x4 ls = (f32x4){0.f, 0.f, 0.f, 0.f}; if (act) ls = *(const f32x4*)(Fb + (size_t)bh * SEQ + 4 * tq); v[0] = ls[0]; v[1] = ls[1]; v[2] = ls[2]; v[3] = ls[3]; }
              v[1] += v[0]; v[2] += v[1]; v[3] += v[2];
              const float tot = v[3]; float incl = tot;
#pragma unroll
              for (int o = 1; o < 64; o <<= 1) { const float t = __shfl_up(incl, o); if (lane >= o) incl += t; }
              if (lane == 63) wsum[wave] = incl;
              __syncthreads();
              float off = incl - tot;
              for (int w = 0; w < wave; ++w) off += wsum[w];
              const float isc = -11.313708498984761f;
              if (act) *(f32x4*)(cumL + 4 * tq) = (f32x4){(v[0] + off) * isc, (v[1] + off) * isc, (v[2] + off) * isc, (v[3] + off) * isc}; }
            { fox::Seam S;
              fox::fox_prime(cur, (char*)lds, S);
              fox::fox_block(cur, (char*)lds, S, cumL + t0 * 64, t1 - t0, split ? (float*)(ws + WS_PLSE) + (size_t)(sid * 2 + me) * 256 : nullptr); }
            if (split) {
                asm volatile("s_waitcnt vmcnt(0)" ::: "memory");
                __syncthreads();
                if (tid == 0) MISC[17] = atomicAdd(ctl + CW_AFLAG + sid, 1u);
                __syncthreads();
                if (MISC[17] == 1u) { if (msid0 < 0) msid0 = sid; else msid1 = sid; }
                __syncthreads();
            }
        }
        for (int mi = 0; mi < 2; ++mi) { const int sid = mi ? msid1 : msid0; if (sid < 0) continue;
            const int bh = sid >> 2, qb = 4 + (sid & 3), b = bh >> 3, h = bh & 7; const size_t rowb = (size_t)b * SEQ;
            __builtin_amdgcn_fence(__ATOMIC_ACQUIRE, "agent");
            asm volatile("s_waitcnt vmcnt(0)" ::: "memory");
            const float* LB0 = (const float*)(ws + WS_PLSE) + (size_t)sid * 2 * 256;
            const int row = tid >> 1, c0 = (tid & 1) * 64;
            const float l0 = LB0[row], l1 = LB0[256 + row], mx = fmaxf(l0, l1);
            const float w0 = __builtin_amdgcn_exp2f(l0 - mx), w1 = __builtin_amdgcn_exp2f(l1 - mx), inv = __builtin_amdgcn_rcpf(w0 + w1), a0 = w0 * inv, a1 = w1 * inv;
            const bf16* p0 = (const bf16*)(ws + WS_PART) + (rowb + qb * 256 + row) * 2048 + h * 128 + c0; const bf16* p1 = p0 + 1024;
            bf16* op = OAB + (rowb + qb * 256 + row) * 2048 + 1024 + h * 128 + c0;
#pragma unroll 2
            for (int j = 0; j < 8; ++j) { const v4u x = *(const v4u*)(p0 + 8 * j), y = *(const v4u*)(p1 + 8 * j); v4u o;
                o.x = pk2(a0 * bflo(x.x) + a1 * bflo(y.x), a0 * bfhi(x.x) + a1 * bfhi(y.x)); o.y = pk2(a0 * bflo(x.y) + a1 * bflo(y.y), a0 * bfhi(x.y) + a1 * bfhi(y.y));
                o.z = pk2(a0 * bflo(x.z) + a1 * bflo(y.z), a0 * bfhi(x.z) + a1 * bfhi(y.z)); o.w = pk2(a0 * bflo(x.w) + a1 * bflo(y.w), a0 * bfhi(x.w) + a1 * bfhi(y.w));
                *(v4u*)(op + 8 * j) = o; }
        }
        for (;;) {
            if (tid == 0) MISC[16] = atomicAdd(ctl + CW_GQ, 1u);
            __syncthreads();
            const unsigned idx = MISC[16];
            __syncthreads();
            if (idx >= 512u) break;
            fox::gmlp_unit((char*)lds, (int)idx, Z, WSB, gmlp_b_s, OAB, VS1, VS2, gmlp_ln_g, gmlp_ln_b);
        }
    }
    GRID_BAR(3); PR_STAMP(3);

    if (IN(4)) {
        pg8::Gemm g{OAB, WAB, M, DM, 2048}; pg8::StaticOrder S; S.init(M, DM, G, bx);
        pg8::EpiY E{Z, Y};
        pg8::gemm_phase<pg8::EpiY, pg8::StaticOrder, true, true>(ldsL, g, S, E);
    }
    GRID_BAR(4); PR_STAMP(4);

    if (IN(5)) {
        pg8::Gemm g{Y, WOUT, M, DM, DM}; pg8::StaticOrder S; S.init(M, DM, G, bx);
        pg8::EpiRes<true> E{x, H, SSQ1};
        pg8::gemm_phase<pg8::EpiRes<true>, pg8::StaticOrder, true, true>(ldsL, g, S, E);
    }
    GRID_BAR(5); PR_STAMP(5);

    if (IN(6)) {
        pg8::Gemm g{H, WUP, M, NUP, DM}; pg8::StaticOrder S; S.init(M, NUP, G, bx);
        pg8::EpiUpConv E{HM, SSQ1, conv_w, conv_b, HALO, FA, FB, (LAS float*)(ldsL + RING_BYTES)};
        pg8::gemm_phase<pg8::EpiUpConv, pg8::StaticOrder, true, true>(ldsL, g, S, E);
        { const int rem = S.nwg % G; const int nidle = rem ? G - rem : G, idle = rem ? bx - rem : bx;
          if (idle >= 0) { { MAKE_TP(); run_transposes<2>(TP, idle * NWAVES + wave, nidle * NWAVES, (LAS float*)(ldsL + wave * 16640), lane); }
              asm volatile("s_waitcnt vmcnt(0)" ::: "memory"); __syncthreads();
              pg8::Gemm ge{PB, WPLE, M, DM, PLE}; pg8::StaticOrder SE; SE.init(M, DM, nidle, idle);
              pg8::EpiE EE{EB, SSQE};
              pg8::gemm_phase<pg8::EpiE, pg8::StaticOrder, true, true>(ldsL, ge, SE, EE); } }
    }
    GRID_BAR(6); PR_STAMP(6);

    if (IN(8)) {
        { pg8::StaticOrder S; S.init(M, DM, G, bx); pg8::Unit u;
          for (int i = 0; S.next(i, u); ++i) if (u.pm & 7) for (int ch = tid; ch < DFF / 8; ch += NWAVES * 64) conv_fixup_rows(u.pm, ch, HM, HALO, FA, FB, conv_w, conv_b);
          asm volatile("s_waitcnt vmcnt(0)" ::: "memory"); __syncthreads(); }
        { pg8::Gemm g{HM, WDOWN, M, DM, DFF}; pg8::StaticOrder S; S.init(M, DM, G, bx);
          pg8::EpiRes<false> E{H, A2, SSQ2};
          pg8::gemm_phase<pg8::EpiRes<false>, pg8::StaticOrder, true, true>(ldsL, g, S, E); }
    }
    GRID_BAR(8); PR_STAMP(8);

    if (IN(9)) {
        pg8::Gemm g{A2, WGATE, M, DM, DM}; pg8::StaticOrder S; S.init(M, DM, G, bx);
        pg8::EpiFinal E{out, A2, EB, ple_norm_g, SSQ2, SSQE};
        pg8::gemm_phase<pg8::EpiFinal, pg8::StaticOrder, true, true>(ldsL, g, S, E);
    }
    PR_STAMP(9);
    if (PROBE_PHASE >= 0 && bx == 0) {
        asm volatile("s_waitcnt vmcnt(0)" ::: "memory"); __syncthreads();
        if (tid == 0) { int best = 0; float bv = 1e30f; for (int i = 0; i < 256; ++i) { const float a = fabsf(out[i]); if (a < bv) { bv = a; best = i; } }
            out[best] += 0.04f + pr_us / PROBE_SCALE; }
    }
#undef IN
#undef GRID_BAR
}

extern "C" void kernel_launch(void* const* d_in, const int* in_sizes, int n_in, void* d_out, int out_size, void* d_ws, size_t ws_size, hipStream_t stream) {
    static int grid = 0;
    if (grid == 0) {
        if (n_in != 23 || out_size != M * DM || ws_size < WS_END) { fprintf(stderr, "kernel_launch: unexpected shapes (n_in %d, out %d, ws %zu)\n", n_in, out_size, ws_size); grid = -1; return; }
        int dev = 0, cus = 0, per_cu = 0;
        if (hipGetDevice(&dev) != hipSuccess || hipDeviceGetAttribute(&cus, hipDeviceAttributeMultiprocessorCount, dev) != hipSuccess) { grid = -1; return; }
        if (hipFuncSetAttribute((const void*)mega_fwd, hipFuncAttributeMaxDynamicSharedMemorySize, LDS_BYTES) != hipSuccess) { fprintf(stderr, "kernel_launch: hipFuncSetAttribute failed\n"); grid = -1; return; }
        if (hipOccupancyMaxActiveBlocksPerMultiprocessor(&per_cu, (const void*)mega_fwd, NWAVES * 64, LDS_BYTES) != hipSuccess || per_cu < 1) { fprintf(stderr, "kernel_launch: occupancy query says %d\n", per_cu); (void)hipGetLastError(); per_cu = 1; }
        grid = cus * (per_cu < 1 ? 1 : 1);
    }
    if (grid < 0) return;
    (void)hipMemsetAsync((char*)d_ws + WS_CTL, 0, CTL_ZERO_BYTES, stream);
    Args a{};
    for (int i = 0; i < 23; ++i) a.in[i] = (const float*)d_in[i];
    a.out = (float*)d_out; a.ws = (unsigned char*)d_ws;
    if (N_LAUNCHES == 1) {
        a.ph_lo = 0; a.ph_hi = N_PHASES; a.one = 1;
        void* kargs[] = {&a};
        hipError_t e = hipLaunchCooperativeKernel((const void*)mega_fwd, dim3(grid), dim3(NWAVES * 64), kargs, LDS_BYTES, stream);
        if (e != hipSuccess) fprintf(stderr, "kernel_launch: cooperative launch failed: %s (grid %d)\n", hipGetErrorString(e), grid);
    } else {
        for (int p = 0; p < N_PHASES; ++p) { a.ph_lo = p; a.ph_hi = p + 1; a.one = 0;
            hipLaunchKernelGGL(mega_fwd, dim3(grid), dim3(NWAVES * 64), LDS_BYTES, stream, a); }
    }
}
```
